# Optimizing an MI355X kernel written in HIP

```python
import math
import jax, jax.numpy as jnp
from jax import lax
import numpy as np


D_MODEL = 1024
BATCH = 16
SEQ = 2048
DEPTH = 1
DEC_BATCH = 128
DEC_SEQ = 1
PAST_LEN = 8192
PAGE_SIZE = 128

MIX_WIDTH = D_MODEL
MLA_HEADS = 8
MLA_HEAD_DIM = 64
ROPE_DIM = 32
KV_LORA = D_MODEL // 4
ATTN_WIDTH = MLA_HEADS * MLA_HEAD_DIM
CONV_CH = MIX_WIDTH - ATTN_WIDTH
CONV_K = 31
CONV_STATE = CONV_K - 1
MEM_TOKENS = 256
MEM_HEADS = 4
MEM_HEAD_DIM = D_MODEL // MEM_HEADS
D_FF = 4 * D_MODEL
Q_BLOCK = 128
ROPE_BASE = 10000.0
LN_EPS = 1e-5
ALPHA = (2.0 * DEPTH) ** 0.25
BETA = (8.0 * DEPTH) ** -0.25
Q_COLS = MLA_HEADS * (MLA_HEAD_DIM + ROPE_DIM)
IN_COLS = Q_COLS + KV_LORA + ROPE_DIM + 2 * CONV_CH
MLA_SCALE = (MLA_HEAD_DIM + ROPE_DIM) ** -0.5
MEM_SCALE = MEM_HEAD_DIM ** -0.5

kernel_name = 'hymba_mla_conformer_deepnorm_decoder_step'


def layer_norm(x, g, b):
    xf = x.astype(jnp.float32)
    mu = jnp.mean(xf, axis=-1, keepdims=True)
    var = jnp.mean(jnp.square(xf - mu), axis=-1, keepdims=True)
    y = (xf - mu) * lax.rsqrt(var + LN_EPS) * g.astype(jnp.float32) + b.astype(jnp.float32)
    return y.astype(x.dtype)


def rms_norm(x, g):
    xf = x.astype(jnp.float32)
    y = xf * lax.rsqrt(jnp.mean(jnp.square(xf), axis=-1, keepdims=True) + LN_EPS) * g.astype(jnp.float32)
    return y.astype(x.dtype)


def rope(x, pos):
    half = ROPE_DIM // 2
    inv_freq = jnp.exp(-math.log(ROPE_BASE) * jnp.arange(half, dtype=jnp.float32) / half)
    ang = pos.astype(jnp.float32)[:, None] * inv_freq[None, :]
    shape = (ang.shape[0],) + (1,) * (x.ndim - 3) + (half,)
    cos = jnp.cos(ang).reshape(shape).astype(x.dtype)
    sin = jnp.sin(ang).reshape(shape).astype(x.dtype)
    x1, x2 = x[..., :half], x[..., half:]
    return jnp.concatenate([x1 * cos - x2 * sin, x2 * cos + x1 * sin], axis=-1)


def mixer_inputs(x, pos, w_in, kv_norm_g):
    B, T, _ = x.shape
    z = jnp.einsum('btd,dc->btc', x, w_in)
    q = z[..., :Q_COLS].reshape(B, T, MLA_HEADS, MLA_HEAD_DIM + ROPE_DIM)
    q_nope = q[..., :MLA_HEAD_DIM]
    q_rope = rope(q[..., MLA_HEAD_DIM:], pos)
    c_kv = rms_norm(z[..., Q_COLS:Q_COLS + KV_LORA], kv_norm_g)
    k_rope = rope(z[..., Q_COLS + KV_LORA:Q_COLS + KV_LORA + ROPE_DIM], pos)
    glu = z[..., Q_COLS + KV_LORA + ROPE_DIM:]
    u = glu[..., :CONV_CH] * jax.nn.sigmoid(glu[..., CONV_CH:])
    return q_nope, q_rope, c_kv, k_rope, u


def mla_prompt(q_nope, q_rope, c_kv, k_rope, w_uk, w_uv):
    B, S, H, _ = q_nope.shape
    nb = S // Q_BLOCK
    k_nope = jnp.einsum('bsl,lhd->bshd', c_kv, w_uk)
    v = jnp.einsum('bsl,lhd->bshd', c_kv, w_uv)
    qn_b = q_nope.reshape(B, nb, Q_BLOCK, H, MLA_HEAD_DIM).transpose(1, 0, 2, 3, 4)
    qr_b = q_rope.reshape(B, nb, Q_BLOCK, H, ROPE_DIM).transpose(1, 0, 2, 3, 4)
    k_pos = jnp.arange(S, dtype=jnp.int32)

    def block(args):
        qn, qr, i = args
        s = jnp.einsum('bqhd,bkhd->bhqk', qn, k_nope) + jnp.einsum('bqhr,bkr->bhqk', qr, k_rope)
        q_pos = i * Q_BLOCK + jnp.arange(Q_BLOCK, dtype=jnp.int32)
        mask = k_pos[None, :] <= q_pos[:, None]
        s = jnp.where(mask, s.astype(jnp.float32) * MLA_SCALE, -jnp.inf)
        p = jax.nn.softmax(s, axis=-1).astype(v.dtype)
        return jnp.einsum('bhqk,bkhd->bqhd', p, v)

    o = lax.map(block, (qn_b, qr_b, jnp.arange(nb, dtype=jnp.int32)))
    return o.transpose(1, 0, 2, 3, 4).reshape(B, S, H * MLA_HEAD_DIM)


def mla_sample(q_nope, q_rope, c_new, kr_new, pool_ckv, pool_krope, page_table, w_uk, w_uv):
    Bd, T, H, _ = q_nope.shape
    q_lat = jnp.einsum('bthd,lhd->bthl', q_nope, w_uk)
    past_c = pool_ckv[page_table].reshape(Bd, -1, KV_LORA)
    past_r = pool_krope[page_table].reshape(Bd, -1, ROPE_DIM)
    P = past_c.shape[1]
    s_past = jnp.einsum('bthl,bkl->bhtk', q_lat, past_c) + jnp.einsum('bthr,bkr->bhtk', q_rope, past_r)
    s_new = jnp.einsum('bthl,bkl->bhtk', q_lat, c_new) + jnp.einsum('bthr,bkr->bhtk', q_rope, kr_new)
    causal = jnp.arange(T)[None, :] <= jnp.arange(T)[:, None]
    s_new = jnp.where(causal, s_new.astype(jnp.float32) * MLA_SCALE, -jnp.inf)
    s = jnp.concatenate([s_past.astype(jnp.float32) * MLA_SCALE, s_new], axis=-1)
    p = jax.nn.softmax(s, axis=-1).astype(c_new.dtype)
    o_lat = jnp.einsum('bhtk,bkl->bthl', p[..., :P], past_c) + jnp.einsum('bhtk,bkl->bthl', p[..., P:], c_new)
    return jnp.einsum('bthl,lhd->bthd', o_lat, w_uv).reshape(Bd, T, H * MLA_HEAD_DIM)


def depthwise_causal_conv(u_ext, conv_w):
    return lax.conv_general_dilated(u_ext, conv_w[:, None, :].astype(u_ext.dtype), window_strides=(1,),
                                    padding='VALID', dimension_numbers=('NWC', 'WIO', 'NWC'),
                                    feature_group_count=CONV_CH)


def conv_tail(y, conv_b, g, b):
    return jax.nn.silu(layer_norm(y + conv_b.astype(y.dtype), g, b))


def mem_kv(mem, w_xk, w_xv):
    B, M, _ = mem.shape
    k = jnp.einsum('bmd,de->bme', mem, w_xk).reshape(B, M, MEM_HEADS, MEM_HEAD_DIM)
    v = jnp.einsum('bmd,de->bme', mem, w_xv).reshape(B, M, MEM_HEADS, MEM_HEAD_DIM)
    return k, v


def post_sublayers(x, mix, mem_k, mem_v, ln1_g, ln1_b, w_xq, w_xo, ln2_g, ln2_b, w_up, w_down, ln3_g, ln3_b):
    x = layer_norm(ALPHA * x + mix, ln1_g, ln1_b)
    B, T, _ = x.shape
    q = jnp.einsum('btd,de->bte', x, w_xq).reshape(B, T, MEM_HEADS, MEM_HEAD_DIM)
    s = jnp.einsum('bthd,bmhd->bhtm', q, mem_k).astype(jnp.float32) * MEM_SCALE
    p = jax.nn.softmax(s, axis=-1).astype(mem_v.dtype)
    o = jnp.einsum('bhtm,bmhd->bthd', p, mem_v).reshape(B, T, D_MODEL)
    x = layer_norm(ALPHA * x + o @ w_xo, ln2_g, ln2_b)
    h = jnp.square(jax.nn.relu(x @ w_up))
    return layer_norm(ALPHA * x + h @ w_down, ln3_g, ln3_b)


def setup_inputs(seed: int = 0) -> dict:
    key = jax.random.key(seed)
    k = jax.random.split(key, 30)
    f32 = jnp.float32

    def nrm(i, shape, scale):
        return jax.random.normal(k[i], shape, f32) * scale

    n_pages = PAST_LEN // PAGE_SIZE
    n_used = DEC_BATCH * n_pages
    n_pool = n_used + n_used // 4
    page_table = jax.random.permutation(k[7], n_pool)[:n_used].reshape(DEC_BATCH, n_pages).astype(jnp.int32)
    return {
        'x_prompt': nrm(0, (BATCH, SEQ, D_MODEL), 1.0),
        'x_sample': nrm(1, (DEC_BATCH, DEC_SEQ, D_MODEL), 1.0),
        'cache_ckv': nrm(2, (DEPTH, n_pool, PAGE_SIZE, KV_LORA), 1.0),
        'cache_krope': nrm(3, (DEPTH, n_pool, PAGE_SIZE, ROPE_DIM), 1.0),
        'state_conv': nrm(4, (DEPTH, DEC_BATCH, CONV_STATE, CONV_CH), 0.5),
        'cache_mem_k': nrm(5, (DEPTH, DEC_BATCH, MEM_TOKENS, MEM_HEADS, MEM_HEAD_DIM), 1.0),
        'cache_mem_v': nrm(6, (DEPTH, DEC_BATCH, MEM_TOKENS, MEM_HEADS, MEM_HEAD_DIM), BETA),
        'page_table': page_table,
        'mem_prompt': nrm(8, (BATCH, MEM_TOKENS, D_MODEL), 1.0),
        'w_in': nrm(9, (DEPTH, D_MODEL, IN_COLS), D_MODEL ** -0.5),
        'kv_norm_g': 1.0 + nrm(10, (DEPTH, KV_LORA), 0.01),
        'w_uk': nrm(11, (DEPTH, KV_LORA, MLA_HEADS, MLA_HEAD_DIM), KV_LORA ** -0.5),
        'w_uv': nrm(12, (DEPTH, KV_LORA, MLA_HEADS, MLA_HEAD_DIM), BETA * KV_LORA ** -0.5),
        'conv_w': nrm(13, (DEPTH, CONV_K, CONV_CH), CONV_K ** -0.5),
        'conv_b': nrm(14, (DEPTH, CONV_CH), 0.01),
        'conv_ln_g': 1.0 + nrm(15, (DEPTH, CONV_CH), 0.01),
        'conv_ln_b': nrm(16, (DEPTH, CONV_CH), 0.01),
        'w_o': nrm(17, (DEPTH, MIX_WIDTH, D_MODEL), BETA * MIX_WIDTH ** -0.5),
        'ln1_g': 1.0 + nrm(18, (DEPTH, D_MODEL), 0.01),
        'ln1_b': nrm(19, (DEPTH, D_MODEL), 0.01),
        'w_xq': nrm(20, (DEPTH, D_MODEL, D_MODEL), D_MODEL ** -0.5),
        'w_xk': nrm(21, (DEPTH, D_MODEL, D_MODEL), D_MODEL ** -0.5),
        'w_xv': nrm(22, (DEPTH, D_MODEL, D_MODEL), BETA * D_MODEL ** -0.5),
        'w_xo': nrm(23, (DEPTH, D_MODEL, D_MODEL), BETA * D_MODEL ** -0.5),
        'ln2_g': 1.0 + nrm(24, (DEPTH, D_MODEL), 0.01),
        'ln2_b': nrm(25, (DEPTH, D_MODEL), 0.01),
        'w_up': nrm(26, (DEPTH, D_MODEL, D_FF), D_MODEL ** -0.5),
        'w_down': nrm(27, (DEPTH, D_FF, D_MODEL), BETA * D_FF ** -0.5),
        'ln3_g': 1.0 + nrm(28, (DEPTH, D_MODEL), 0.01),
        'ln3_b': nrm(29, (DEPTH, D_MODEL), 0.01),
    }


def reference(x_prompt, x_sample, cache_ckv, cache_krope, state_conv, cache_mem_k, cache_mem_v, page_table,
              mem_prompt, w_in, kv_norm_g, w_uk, w_uv, conv_w, conv_b, conv_ln_g, conv_ln_b, w_o, ln1_g, ln1_b,
              w_xq, w_xk, w_xv, w_xo, ln2_g, ln2_b, w_up, w_down, ln3_g, ln3_b):
    B, S, _ = x_prompt.shape
    T = x_sample.shape[1]
    past_len = page_table.shape[1] * cache_ckv.shape[2]
    pos_p = jnp.arange(S, dtype=jnp.int32)
    pos_s = past_len + jnp.arange(T, dtype=jnp.int32)

    xp, xs = x_prompt, x_sample
    ckv_p, kr_p, cs_p, mk_p, mv_p = [], [], [], [], []
    ckv_s, kr_s, cs_s = [], [], []
    for l in range(DEPTH):
        qn, qr, c_kv, k_r, u = mixer_inputs(xp, pos_p, w_in[l], kv_norm_g[l])
        attn = mla_prompt(qn, qr, c_kv, k_r, w_uk[l], w_uv[l])
        u_ext = jnp.concatenate([jnp.zeros((B, CONV_STATE, CONV_CH), u.dtype), u], axis=1)
        conv = conv_tail(depthwise_causal_conv(u_ext, conv_w[l]), conv_b[l], conv_ln_g[l], conv_ln_b[l])
        mix = jnp.concatenate([attn, conv], axis=-1) @ w_o[l]
        mk, mv = mem_kv(mem_prompt, w_xk[l], w_xv[l])
        xp = post_sublayers(xp, mix, mk, mv, ln1_g[l], ln1_b[l], w_xq[l], w_xo[l], ln2_g[l], ln2_b[l],
                            w_up[l], w_down[l], ln3_g[l], ln3_b[l])
        ckv_p.append(c_kv)
        kr_p.append(k_r)
        cs_p.append(u_ext[:, -CONV_STATE:])
        mk_p.append(mk)
        mv_p.append(mv)
        qn, qr, c_kv, k_r, u = mixer_inputs(xs, pos_s, w_in[l], kv_norm_g[l])
        attn = mla_sample(qn, qr, c_kv, k_r, cache_ckv[l], cache_krope[l], page_table, w_uk[l], w_uv[l])
        u_ext = jnp.concatenate([state_conv[l].astype(u.dtype), u], axis=1)
        conv = conv_tail(depthwise_causal_conv(u_ext, conv_w[l]), conv_b[l], conv_ln_g[l], conv_ln_b[l])
        mix = jnp.concatenate([attn, conv], axis=-1) @ w_o[l]
        xs = post_sublayers(xs, mix, cache_mem_k[l], cache_mem_v[l], ln1_g[l], ln1_b[l], w_xq[l], w_xo[l],
                            ln2_g[l], ln2_b[l], w_up[l], w_down[l], ln3_g[l], ln3_b[l])
        ckv_s.append(c_kv)
        kr_s.append(k_r)
        cs_s.append(u_ext[:, -CONV_STATE:])

    return (xp, xs, jnp.stack(ckv_p), jnp.stack(kr_p), jnp.stack(cs_p), jnp.stack(mk_p), jnp.stack(mv_p),
            jnp.stack(ckv_s), jnp.stack(kr_s), jnp.stack(cs_s))
```

```cpp
#include <hip/hip_runtime.h>
#include <cstdio>
#include <cstdint>
namespace pg8 {
#define PG8_LAS __attribute__((address_space(3)))
typedef unsigned short bf16_t;
typedef short bf16x8 __attribute__((ext_vector_type(8)));
typedef float f32x4 __attribute__((ext_vector_type(4)));
typedef unsigned u32x4 __attribute__((ext_vector_type(4)));
constexpr int BM = 256, BK = 64, HALF = 128, HTB = HALF * BK * 2  , STAGE_BYTES = 8 * HTB, NXCD = 8, WGM = 8;

__host__ __device__ __forceinline__ int lds_byte(int r, int c) { const int st = (r >> 4) * 2 + (c >> 5), rr = r & 15, cc = c & 31, ob = rr * 64 + cc * 2; return st * 1024 + (ob ^ (((ob >> 9) & 1) << 5)); }
__host__ __device__ __forceinline__ void stage_rc(int b, int& R, int& C) { const int st = b / 1024, sb = b % 1024, swz = sb ^ (((sb >> 9) & 1) << 5); R = (st >> 1) * 16 + swz / 64; C = (st & 1) * 32 + (swz % 64) / 2; }
__host__ __device__ __forceinline__ int perm32(int rho) { const int n = rho >> 4, i = rho & 15; return 8 * (i >> 2) + 4 * n + (i & 3); }

struct Unit { int pm, pn; };
struct Gemm { const bf16_t* A; const bf16_t* Bt; int M, N, K; };

struct StaticOrder {
    int nM, nN, nwg, G, c;
    __host__ __device__ void init(int M, int N, int G_, int c_) { nM = M / BM; nN = N / BM; nwg = nM * nN; G = G_; c = c_; }
    __host__ __device__ bool next(int i, Unit& u) const {
        const long L = (long)i * G + c; if (L >= nwg) return false;
        int wgid = (int)L; { const int q = nwg / NXCD, r = nwg % NXCD, xcd = wgid % NXCD, off = wgid / NXCD; wgid = (xcd < r ? xcd * (q + 1) : r * (q + 1) + (xcd - r) * q) + off; }
        const int nig = WGM * nN, gid = wgid / nig, fm = gid * WGM, gsz = (nM - fm) < WGM ? (nM - fm) : WGM;
        u.pm = fm + ((wgid % nig) % gsz); u.pn = (wgid % nig) / gsz; return true;
    }
    __device__ __forceinline__ void a_ready(const Unit&) const {}
    __device__ __forceinline__ void done(const Unit&) const {}
};


template <class Epi, class Sched, bool ALIGN_EPI = false, bool SP2 = false>
__device__ __forceinline__ void gemm_phase(PG8_LAS unsigned char* lds, const Gemm g, const Sched& S, const Epi& E) {
    const int tid = threadIdx.x, wid = __builtin_amdgcn_readfirstlane(tid >> 6), lane = tid & 63, wr = wid >> 2, wc = wid & 3, fr = lane & 15, fq = lane >> 4;
    const int K = g.K, nt = K / BK;
    unsigned voffA[2], voffB[2];
#pragma unroll
    for (int i = 0; i < 2; ++i) { int R, C; stage_rc(tid * 16 + i * 8192, R, C); const int Rb = Epi::PERM ? ((R & ~31) + perm32(R & 31)) : R;
        voffA[i] = (unsigned)(R * K + C) * 2u; voffB[i] = (unsigned)(Rb * K + C) * 2u; }
    const size_t kstep = (size_t)(BK * 2);
    const size_t hstep = (size_t)HALF * K * 2;
    const size_t tstep = 2 * hstep;
    const unsigned ldsw = (unsigned)wid * 1024u;
    const int aoff = lds_byte(wr * 64 + fr, fq * 8), boff = lds_byte(wc * 32 + fr, fq * 8);
#define PG8_SA(b, h) (((b) * 2 + (h)) * HTB)
#define PG8_SB(b, h) ((4 + (b) * 2 + (h)) * HTB)
#define PG8_STAGE(bufoff, gbase, voff) do { _Pragma("unroll") for (int _i = 0; _i < 2; ++_i) \
        __builtin_amdgcn_global_load_lds((const unsigned*)((const char*)(gbase) + (voff)[_i]), (PG8_LAS unsigned*)(lds + (bufoff) + ldsw + _i * 8192), 16, 0, 0); } while (0)
#define PG8_LDA(dst, b, h) do { _Pragma("unroll") for (int m = 0; m < 4; ++m) _Pragma("unroll") for (int k = 0; k < 2; ++k) dst[m][k] = *(const PG8_LAS bf16x8*)(lds + PG8_SA(b, h) + aoff + m * 2048 + k * 1024); } while (0)
#define PG8_LDB(dst, b, h) do { _Pragma("unroll") for (int n = 0; n < 2; ++n) _Pragma("unroll") for (int k = 0; k < 2; ++k) dst[n][k] = *(const PG8_LAS bf16x8*)(lds + PG8_SB(b, h) + boff + n * 2048 + k * 1024); } while (0)
#define PG8_MMA(ai, bj, At, Bt) do { __builtin_amdgcn_s_setprio(1); _Pragma("unroll") for (int m = 0; m < 4; ++m) _Pragma("unroll") for (int n = 0; n < 2; ++n) _Pragma("unroll") for (int k = 0; k < 2; ++k) \
        acc[ai][bj][m][n] = __builtin_amdgcn_mfma_f32_16x16x32_bf16(Bt[n][k], At[m][k], acc[ai][bj][m][n], 0, 0, 0); __builtin_amdgcn_s_setprio(0); } while (0)
#define PG8_WAIT_V(n) asm volatile("s_waitcnt vmcnt(" #n ")" ::: "memory")
#define PG8_WAIT_L(n) asm volatile("s_waitcnt lgkmcnt(" #n ")" ::: "memory")
#define PG8_BAR __builtin_amdgcn_s_barrier()
#define PG8_SCHED __builtin_amdgcn_sched_barrier(0)
    Unit cur, nxt; int ui = 0;
    if (!S.next(0, cur)) return;
    f32x4 acc[2][2][4][2];
#pragma unroll
    for (int a = 0; a < 2; ++a)
#pragma unroll
        for (int b = 0; b < 2; ++b)
#pragma unroll
            for (int m = 0; m < 4; ++m)
#pragma unroll
                for (int n = 0; n < 2; ++n) acc[a][b][m][n] = (f32x4){0.f, 0.f, 0.f, 0.f};
    bf16x8 At[4][2], B0[2][2], B1[2][2];
    const char* cA = (const char*)g.A + (size_t)cur.pm * tstep; const char* cB = (const char*)g.Bt + (size_t)cur.pn * tstep;
    S.a_ready(cur);
    if constexpr (SP2) {
        PG8_STAGE(PG8_SB(0, 0), cB, voffB); PG8_STAGE(PG8_SB(0, 1), cB + hstep, voffB); PG8_STAGE(PG8_SA(0, 0), cA, voffA); PG8_STAGE(PG8_SA(0, 1), cA + hstep, voffA);
        if (wr == 1) PG8_BAR;
        PG8_WAIT_V(2); PG8_BAR;
        PG8_STAGE(PG8_SB(1, 0), cB + kstep, voffB); PG8_STAGE(PG8_SA(1, 0), cA + kstep, voffA); PG8_STAGE(PG8_SB(1, 1), cB + hstep + kstep, voffB);
        PG8_WAIT_V(6); PG8_BAR;
    } else {
        PG8_STAGE(PG8_SB(0, 0), cB, voffB); PG8_STAGE(PG8_SA(0, 0), cA, voffA); PG8_STAGE(PG8_SB(0, 1), cB + hstep, voffB); PG8_STAGE(PG8_SA(0, 1), cA + hstep, voffA);
        if (wr == 1) PG8_BAR;
        PG8_WAIT_V(4); PG8_BAR;
        PG8_STAGE(PG8_SB(1, 0), cB + kstep, voffB); PG8_STAGE(PG8_SA(1, 0), cA + kstep, voffA); PG8_STAGE(PG8_SB(1, 1), cB + hstep + kstep, voffB);
        PG8_WAIT_V(6); PG8_BAR;
    }
    for (;;) {
        const bool has_next = S.next(ui + 1, nxt);
        const char* nA = has_next ? (const char*)g.A + (size_t)nxt.pm * tstep : cA; const char* nB = has_next ? (const char*)g.Bt + (size_t)nxt.pn * tstep : cB;
        for (int t = 0; t < nt; t += 2) {
            const bool last = (t == nt - 2);
            const char* a1 = cA + (size_t)(t + 1) * kstep;
            const char* a2 = last ? nA : cA + (size_t)(t + 2) * kstep; const char* b2 = last ? nB : cB + (size_t)(t + 2) * kstep;
            const char* a3 = a2 + kstep; const char* b3 = b2 + kstep;
            if (last && has_next) S.a_ready(nxt);
            if constexpr (SP2) {
            PG8_LDB(B0, 0, 0); PG8_LDB(B1, 0, 1); PG8_SCHED; PG8_LDA(At, 0, 0); PG8_STAGE(PG8_SA(1, 1), a1 + hstep, voffA);
            PG8_WAIT_V(8); PG8_WAIT_L(0); PG8_BAR; PG8_MMA(0, 0, At, B0); PG8_MMA(0, 1, At, B1); PG8_BAR; PG8_SCHED;
            PG8_LDA(At, 0, 1); PG8_STAGE(PG8_SB(0, 0), b2, voffB); PG8_STAGE(PG8_SB(0, 1), b2 + hstep, voffB); PG8_STAGE(PG8_SA(0, 0), a2, voffA);
            PG8_WAIT_V(8); PG8_WAIT_L(0); PG8_BAR; PG8_MMA(1, 0, At, B0); PG8_MMA(1, 1, At, B1); PG8_BAR; PG8_SCHED;
            PG8_LDB(B0, 1, 0); PG8_LDB(B1, 1, 1); PG8_SCHED; PG8_LDA(At, 1, 0); PG8_STAGE(PG8_SA(0, 1), a2 + hstep, voffA);
            PG8_WAIT_V(8); PG8_WAIT_L(0); PG8_BAR; PG8_MMA(0, 0, At, B0); PG8_MMA(0, 1, At, B1); PG8_BAR; PG8_SCHED;
            PG8_LDA(At, 1, 1); PG8_STAGE(PG8_SB(1, 0), b3, voffB); PG8_STAGE(PG8_SB(1, 1), b3 + hstep, voffB); PG8_STAGE(PG8_SA(1, 0), a3, voffA);
            PG8_WAIT_V(8); PG8_WAIT_L(0); PG8_BAR; PG8_MMA(1, 0, At, B0); PG8_MMA(1, 1, At, B1); PG8_BAR; PG8_SCHED;
            } else {
            PG8_LDB(B0, 0, 0); PG8_SCHED; PG8_LDA(At, 0, 0); PG8_STAGE(PG8_SA(1, 1), a1 + hstep, voffA);
            PG8_WAIT_L(8); PG8_BAR; PG8_WAIT_L(0); PG8_MMA(0, 0, At, B0); PG8_BAR; PG8_SCHED;
            PG8_LDB(B1, 0, 1); PG8_STAGE(PG8_SB(0, 0), b2, voffB);
            PG8_BAR; PG8_WAIT_L(0); PG8_MMA(0, 1, At, B1); PG8_BAR;
            PG8_LDA(At, 0, 1); PG8_STAGE(PG8_SA(0, 0), a2, voffA);
            PG8_BAR; PG8_WAIT_L(0); PG8_MMA(1, 0, At, B0); PG8_BAR; PG8_SCHED;
            PG8_STAGE(PG8_SB(0, 1), b2 + hstep, voffB);
            PG8_WAIT_V(6); PG8_BAR; PG8_MMA(1, 1, At, B1); PG8_BAR;
            PG8_LDB(B0, 1, 0); PG8_SCHED; PG8_LDA(At, 1, 0); PG8_STAGE(PG8_SA(0, 1), a2 + hstep, voffA);
            PG8_WAIT_L(8); PG8_BAR; PG8_WAIT_L(0); PG8_MMA(0, 0, At, B0); PG8_BAR; PG8_SCHED;
            PG8_LDB(B1, 1, 1); PG8_STAGE(PG8_SB(1, 0), b3, voffB);
            PG8_BAR; PG8_WAIT_L(0); PG8_MMA(0, 1, At, B1); PG8_BAR;
            PG8_LDA(At, 1, 1); PG8_STAGE(PG8_SA(1, 0), a3, voffA);
            PG8_BAR; PG8_WAIT_L(0); PG8_MMA(1, 0, At, B0); PG8_BAR; PG8_SCHED;
            PG8_STAGE(PG8_SB(1, 1), b3 + hstep, voffB);
            PG8_WAIT_V(6); PG8_BAR; PG8_MMA(1, 1, At, B1); PG8_BAR;
            }
        }
        if constexpr (ALIGN_EPI) { if (wr == 0) PG8_BAR; }
        if constexpr (!Epi::AFTER_DRAIN) { E(acc, cur, wr, wc, fr, fq); S.done(cur); }
        if (!has_next) break;
#pragma unroll
        for (int a = 0; a < 2; ++a)
#pragma unroll
            for (int b = 0; b < 2; ++b)
#pragma unroll
                for (int m = 0; m < 4; ++m)
#pragma unroll
                    for (int n = 0; n < 2; ++n) acc[a][b][m][n] = (f32x4){0.f, 0.f, 0.f, 0.f};
        cur = nxt; cA = nA; cB = nB; ++ui;
        if constexpr (ALIGN_EPI) { if (wr == 1) PG8_BAR; }
    }
    PG8_WAIT_V(0);
    if constexpr (!ALIGN_EPI) { if (wr == 0) PG8_BAR; }
    PG8_BAR;
    if constexpr (Epi::AFTER_DRAIN) { E.fused(acc, cur, wr, wc, fr, fq, lds, wid, lane); S.done(cur); }
#undef PG8_SA
#undef PG8_SB
#undef PG8_STAGE
#undef PG8_LDA
#undef PG8_LDB
#undef PG8_MMA
#undef PG8_WAIT_V
#undef PG8_WAIT_L
#undef PG8_BAR
#undef PG8_SCHED
}
}

constexpr int DM = 1024, NBATCH = 16, SEQ = 2048, MP = NBATCH * SEQ, NS = 128, MT = 33024  , MREAL = MP + NS;
constexpr int MMEM = 4096, MEMT = 256;
constexpr int QC = 768, KVL = 256, RD = 32, CCH = 512, NIN = 2304, FF = 4096, INC = 2080;
constexpr int NPG = 64;
constexpr float LN_EPS = 1e-5f;
constexpr float ALPHA = 1.189207115002721f;
constexpr float LOG2E = 1.4426950408889634f;
constexpr float QS_MLA = 0.10206207261596577f * LOG2E;
constexpr float QS_MEM = 0.0625f * LOG2E;
constexpr size_t O_YP = 0, O_YS = O_YP + (size_t)MP * DM, O_CKVP = O_YS + (size_t)NS * DM, O_KRP = O_CKVP + (size_t)MP * KVL, O_CONVP = O_KRP + (size_t)MP * RD,
                 O_MKP = O_CONVP + (size_t)NBATCH * 30 * CCH, O_MVP = O_MKP + (size_t)MMEM * DM, O_CKVS = O_MVP + (size_t)MMEM * DM, O_KRS = O_CKVS + (size_t)NS * KVL,
                 O_CONVS = O_KRS + (size_t)NS * RD, O_END = O_CONVS + (size_t)NS * 30 * CCH;
static_assert(O_END == 53760000, "output size");

constexpr size_t MiB = 1u << 20;
constexpr size_t WS_CTL = 0, CTL_ZERO_BYTES = 128 * 1024;
constexpr size_t WS_WIN = 2 * MiB;
constexpr size_t WS_WXKV = WS_WIN + (size_t)NIN * DM * 2;
constexpr size_t WS_WUKV = 11 * MiB, WS_WO = 12 * MiB, WS_WXQ = 14 * MiB, WS_WXO = 16 * MiB, WS_WUP = 18 * MiB, WS_WDN = 26 * MiB;
constexpr size_t WS_ROPE = 34 * MiB;
constexpr size_t WS_PART = 35 * MiB, WS_PML = 37 * MiB, WS_QLAT = 38 * MiB;
constexpr size_t WS_VEC = 39 * MiB;
constexpr int VO_CSQ = 0, VO_BWQ = 1024, VO_CSU = 2048, VO_BWU = 6144, VO_PCSQ = 10240, VO_PBWQ = VO_PCSQ + 16 * 1024, VO_PCSU = VO_PBWQ + 16 * 1024, VO_PBWU = VO_PCSU + 16 * 4096, VO_END = VO_PBWU + 16 * 4096;
static_assert(VO_END * 4 <= (int)MiB, "vector region");
constexpr size_t WS_XB = 40 * MiB;
constexpr size_t WS_Q = 113 * MiB, WS_CKV = 162 * MiB, WS_KR = 179 * MiB, WS_U = 182 * MiB, WS_KN = 215 * MiB, WS_VV = 247 * MiB, WS_MKB = 279 * MiB, WS_MVB = 287 * MiB;
constexpr size_t WS_AC = 295 * MiB, WS_V = 360 * MiB, WS_X1 = 489 * MiB, WS_X1B = 618 * MiB, WS_QX = 683 * MiB, WS_OX = 748 * MiB, WS_X2 = 813 * MiB, WS_X2B = 942 * MiB, WS_H = 1007 * MiB;
constexpr size_t WS_SL1 = 1266 * MiB, WS_SL2 = 1268 * MiB;
constexpr size_t WS_SSL1 = 1270 * MiB, WS_SSL2 = 1271 * MiB;
constexpr size_t WS_ZS = 1272 * MiB, WS_XCH = 1274 * MiB, WS_END = 1276 * MiB;
static_assert(WS_WXKV + (size_t)2048 * DM * 2 <= WS_WUKV && WS_XB + (size_t)(MT + MMEM) * DM * 2 <= WS_Q && WS_Q + (size_t)MT * QC * 2 <= WS_CKV && WS_CKV + (size_t)MT * KVL * 2 <= WS_KR &&
              WS_KR + (size_t)MT * RD * 2 <= WS_U && WS_U + (size_t)MT * CCH * 2 <= WS_KN && WS_AC + (size_t)MT * DM * 2 <= WS_V && WS_V + (size_t)MT * DM * 4 <= WS_X1 && WS_X1 + (size_t)MT * DM * 4 <= WS_X1B &&
              WS_X1B + (size_t)MT * DM * 2 <= WS_QX && WS_X2 + (size_t)MT * DM * 4 <= WS_X2B && WS_H + (size_t)MT * FF * 2 <= WS_END, "d_ws map");
constexpr int CW_TMO = 0, CW_CODE = 1, CW_BAR = 4096, CW_CMB = 8192  , CW_SEAM = 16384;

constexpr int RING_OFF = 0, RING_BYTES = 131072;
constexpr int XL_OFF = 131072;
constexpr int LDS_BYTES = 147456, MISC_OFF = LDS_BYTES - 128;
constexpr int NWAVES = 8;

#define GAS __attribute__((address_space(1)))
#define LAS __attribute__((address_space(3)))
typedef unsigned short bf16;
typedef unsigned v4u __attribute__((ext_vector_type(4)));
typedef unsigned v2u __attribute__((ext_vector_type(2)));
typedef float f32x4 __attribute__((ext_vector_type(4)));
typedef float f32x2 __attribute__((ext_vector_type(2)));
typedef float f32x16 __attribute__((ext_vector_type(16)));
typedef short bf16x8 __attribute__((ext_vector_type(8)));
typedef short s16x4 __attribute__((ext_vector_type(4)));
typedef __bf16 bf16x2_t __attribute__((ext_vector_type(2)));
typedef GAS unsigned gu32;
#define RLX_AGENT __ATOMIC_RELAXED, __HIP_MEMORY_SCOPE_AGENT
#define LDS_WAIT() asm volatile("s_waitcnt lgkmcnt(0)" ::: "memory")
#define VM_WAIT() asm volatile("s_waitcnt vmcnt(0)" ::: "memory")
__device__ __forceinline__ unsigned pk2(float lo, float hi) { f32x2 v = {lo, hi}; bf16x2_t b = __builtin_convertvector(v, bf16x2_t); return __builtin_bit_cast(unsigned, b); }
__device__ __forceinline__ float bf2f(unsigned short h) { return __builtin_bit_cast(float, (unsigned)h << 16); }
__device__ __forceinline__ float bflo(unsigned w) { return __builtin_bit_cast(float, w << 16); }
__device__ __forceinline__ float bfhi(unsigned w) { return __builtin_bit_cast(float, w & 0xffff0000u); }
__device__ __forceinline__ float ex2(float x) { return __builtin_amdgcn_exp2f(x); }
__device__ __forceinline__ float wave_sum(float v) {
#pragma unroll
    for (int o = 1; o < 64; o <<= 1) v += __shfl_xor(v, o);
    return v;
}
__device__ __forceinline__ float wave_max(float v) {
#pragma unroll
    for (int o = 1; o < 64; o <<= 1) v = fmaxf(v, __shfl_xor(v, o));
    return v;
}
__device__ __forceinline__ s16x4 tr_read(const LAS unsigned char* p) { return __builtin_bit_cast(s16x4, __builtin_amdgcn_ds_read_tr16_b64_v4i16((LAS s16x4*)p)); }

#define XB_TMO      128
#define XB_XCNT(j)  (256  + 64 * (j))
#define XB_XSUB(j)  (1280 + 64 * (j))
#define XB_XGEN(j)  (2304 + 64 * (j))
#define XB_TOP      3328
#define XB_TOPGEN   3392
#define XCD_BAR_WORDS 3456
#define XB_SPIN_CAP (1u << 18)

__device__ __forceinline__ unsigned xb_ld(unsigned* p)              { return __hip_atomic_load(p, __ATOMIC_RELAXED, __HIP_MEMORY_SCOPE_AGENT); }
__device__ __forceinline__ unsigned xb_add(unsigned* p, unsigned v) { return __hip_atomic_fetch_add(p, v, __ATOMIC_RELAXED, __HIP_MEMORY_SCOPE_AGENT); }
__device__ __forceinline__ unsigned xb_xcc_id() { return (unsigned)__builtin_amdgcn_s_getreg((3 << 11) | 20) & 0xFu; }
#define XB_SPIN(cond, bar) do { unsigned _sp = 0; while (cond) { __builtin_amdgcn_s_sleep(1); \
    if ((++_sp & 255u) == 0u) { if (xb_ld(&(bar)[XB_TMO])) break; if (_sp > XB_SPIN_CAP) { atomicAdd(&(bar)[XB_TMO], 1u); break; } } } } while (0)

struct XcdBarrier {
    unsigned* bar; unsigned x;
    volatile LAS unsigned* st;
};

__device__ __forceinline__ XcdBarrier xcd_barrier_post(unsigned* bar, volatile LAS unsigned* st) {
    XcdBarrier b; b.bar = bar; b.x = xb_xcc_id(); b.st = st;
    if (threadIdx.x == 0) (void)xb_add(&bar[XB_XCNT(b.x)], 1u);
    return b;
}
__device__ __forceinline__ void xcd_barrier_complete(unsigned* bar, unsigned x, unsigned& nloc, unsigned& nx) {
    const unsigned G = gridDim.x * gridDim.y * gridDim.z;
    unsigned sum, cnt, mine, sp = 0u;
    for (;;) {
        sum = 0u; cnt = 0u; mine = 0u;
#pragma unroll
        for (unsigned j = 0; j < 16; ++j) { const unsigned c = xb_ld(&bar[XB_XCNT(j)]); sum += c; cnt += (c > 0u) ? 1u : 0u; mine = (j == x) ? c : mine; }
        if (sum == G) break;
        __builtin_amdgcn_s_sleep(1);
        if ((++sp & 255u) == 0u) { if (xb_ld(&bar[XB_TMO])) break; if (sp > XB_SPIN_CAP) { atomicAdd(&bar[XB_TMO], 1u); break; } }
    }
    nloc = mine > 0u ? mine : 1u; nx = cnt > 0u ? cnt : 1u;
}

__device__ __forceinline__ void xcd_barrier(const XcdBarrier& b) {
    asm volatile("s_waitcnt vmcnt(0)" ::: "memory");
    __syncthreads();
    if (threadIdx.x == 0) {
        unsigned* bar = b.bar;
        __builtin_amdgcn_s_waitcnt(0);
        unsigned nloc = b.st[0], nx = b.st[1];
        if (nloc == 0u) { xcd_barrier_complete(bar, b.x, nloc, nx); b.st[0] = nloc; b.st[1] = nx; }
        const unsigned old = xb_add(&bar[XB_XSUB(b.x)], 1u);
        const unsigned gen = old / nloc;
        if (old + 1u == (gen + 1u) * nloc) {
            __builtin_amdgcn_fence(__ATOMIC_RELEASE, "agent");
            asm volatile("s_waitcnt vmcnt(0)" ::: "memory");
            const unsigned og = xb_add(&bar[XB_TOP], 1u);
            const unsigned tg = og / nx;
            if (og + 1u == (tg + 1u) * nx) xb_add(&bar[XB_TOPGEN], 1u);
            else XB_SPIN(xb_ld(&bar[XB_TOPGEN]) == tg, bar);
            __builtin_amdgcn_fence(__ATOMIC_ACQUIRE, "agent");
            xb_add(&bar[XB_XGEN(b.x)], 1u);
            asm volatile("s_waitcnt vmcnt(0)" ::: "memory");
        } else {
            XB_SPIN(xb_ld(&bar[XB_XGEN(b.x)]) == gen, bar);
            __builtin_amdgcn_fence(__ATOMIC_ACQUIRE, "agent");
            asm volatile("s_waitcnt vmcnt(0)" ::: "memory");
        }
    }
    __syncthreads();
}

struct Args { const float* in[30]; float* out; unsigned char* ws; int ph_lo, ph_hi; };
static_assert(sizeof(Args) == 30 * 8 + 8 + 8 + 8, "Args has no padding");
enum { I_XP = 0, I_XS, I_CKV, I_KROPE, I_SCONV, I_MEMK, I_MEMV, I_PT, I_MEMP, I_WIN, I_KVG, I_WUK, I_WUV, I_CONVW, I_CONVB, I_CLNG, I_CLNB, I_WO, I_LN1G, I_LN1B,
       I_WXQ, I_WXK, I_WXV, I_WXO, I_LN2G, I_LN2B, I_WUP, I_WDN, I_LN3G, I_LN3B };
struct Frame {
    LAS unsigned char* lds;
    volatile LAS unsigned* MISC;
    gu32* ctl;
    int tid, lane, wave, vcu, G;
};

template <bool FOLD>
__device__ __forceinline__ void transpose_item(const float* W, int N, int K, bf16* WT, int k0, int n0, int dst_row0, LAS float* scr, int lane, const float* g = nullptr, const float* b = nullptr, float* pcs = nullptr, float* pbw = nullptr) {
    float pc = 0.f, pb = 0.f;
#pragma unroll 8
    for (int i = 0; i < 32; ++i) { const int kk = 2 * i + (lane >> 5); float v = W[(size_t)(k0 + kk) * N + n0 + (lane & 31)];
        if (FOLD) { pb += v * b[k0 + kk]; v *= g[k0 + kk]; pc += v; }
        scr[kk * 33 + (lane & 31)] = v; }
    if (FOLD) { pc += __shfl_xor(pc, 32); pb += __shfl_xor(pb, 32); if (lane < 32) { pcs[n0 + lane] = pc; pbw[n0 + lane] = pb; } }
    LDS_WAIT(); asm volatile("" ::: "memory");
    const int c = lane & 7;
#pragma unroll
    for (int j = 0; j < 4; ++j) { const int n = (lane >> 3) + 8 * j; const LAS float* s = scr + (8 * c) * 33 + n;
        v4u o; o.x = pk2(s[0 * 33], s[1 * 33]); o.y = pk2(s[2 * 33], s[3 * 33]); o.z = pk2(s[4 * 33], s[5 * 33]); o.w = pk2(s[6 * 33], s[7 * 33]);
        *(GAS v4u*)(WT + (size_t)(dst_row0 + n) * K + k0 + 8 * c) = o; }
    LDS_WAIT(); asm volatile("" ::: "memory");
}
__device__ __forceinline__ int win_dst_row(int n0) {
    if (n0 < 1024) return n0;
    if (n0 < 1056) return 2048 + (n0 - 1024);
    if (n0 < 1568) { const int a = n0 - 1056; return 1024 + 256 * (a >> 7) + (a & 127); }
    const int g = n0 - 1568; return 1024 + 256 * (g >> 7) + 128 + (g & 127);
}
__device__ __forceinline__ void p0_prologue(Frame& F, const Args& a) {
    LAS float* scr = (LAS float*)(F.lds + F.wave * 16384);
    const int gw = F.vcu * NWAVES + F.wave, NGW = F.G * NWAVES;
    unsigned char* ws = a.ws; float* vec = (float*)(ws + WS_VEC);
    constexpr int C0 = 1040, C1 = C0 + 512, C2 = C1 + 512, C3 = C2 + 64, C4 = C3 + 64, C5 = C4 + 512, C6 = C5 + 512, C7 = C6 + 512, C8 = C7 + 2048, C9 = C8 + 2048;
    for (int it = gw; it < C9; it += NGW) {
        if (it < C0) { const int kb = it / 65, nb = it % 65; transpose_item<false>(a.in[I_WIN], INC, DM, (bf16*)(ws + WS_WIN), kb * 64, nb * 32, win_dst_row(nb * 32), scr, F.lane); }
        else if (it < C1) { const int r = it - C0; transpose_item<false>(a.in[I_WXK], DM, DM, (bf16*)(ws + WS_WXKV), (r >> 5) * 64, (r & 31) * 32, (r & 31) * 32, scr, F.lane); }
        else if (it < C2) { const int r = it - C1; transpose_item<false>(a.in[I_WXV], DM, DM, (bf16*)(ws + WS_WXKV), (r >> 5) * 64, (r & 31) * 32, 1024 + (r & 31) * 32, scr, F.lane); }
        else if (it < C3) { const int r = it - C2; transpose_item<false>(a.in[I_WUK], 512, KVL, (bf16*)(ws + WS_WUKV), (r >> 4) * 64, (r & 15) * 32, (r & 15) * 32, scr, F.lane); }
        else if (it < C4) { const int r = it - C3; transpose_item<false>(a.in[I_WUV], 512, KVL, (bf16*)(ws + WS_WUKV), (r >> 4) * 64, (r & 15) * 32, 512 + (r & 15) * 32, scr, F.lane); }
        else if (it < C5) { const int r = it - C4; transpose_item<false>(a.in[I_WO], DM, DM, (bf16*)(ws + WS_WO), (r >> 5) * 64, (r & 31) * 32, (r & 31) * 32, scr, F.lane); }
        else if (it < C6) { const int r = it - C5; transpose_item<true>(a.in[I_WXQ], DM, DM, (bf16*)(ws + WS_WXQ), (r >> 5) * 64, (r & 31) * 32, (r & 31) * 32, scr, F.lane, a.in[I_LN1G], a.in[I_LN1B], vec + VO_PCSQ + (r >> 5) * 1024, vec + VO_PBWQ + (r >> 5) * 1024); }
        else if (it < C7) { const int r = it - C6; transpose_item<false>(a.in[I_WXO], DM, DM, (bf16*)(ws + WS_WXO), (r >> 5) * 64, (r & 31) * 32, (r & 31) * 32, scr, F.lane); }
        else if (it < C8) { const int r = it - C7; transpose_item<true>(a.in[I_WUP], FF, DM, (bf16*)(ws + WS_WUP), (r >> 7) * 64, (r & 127) * 32, (r & 127) * 32, scr, F.lane, a.in[I_LN2G], a.in[I_LN2B], vec + VO_PCSU + (r >> 7) * 4096, vec + VO_PBWU + (r >> 7) * 4096); }
        else { const int r = it - C8; transpose_item<false>(a.in[I_WDN], DM, FF, (bf16*)(ws + WS_WDN), (r >> 5) * 64, (r & 31) * 32, (r & 31) * 32, scr, F.lane); }
    }
    { GAS v4u* z = (GAS v4u*)(ws + WS_WIN + (size_t)INC * DM * 2); const int n16 = (NIN - INC) * DM * 2 / 16;
      for (int i = F.vcu * 512 + F.tid; i < n16; i += F.G * 512) z[i] = (v4u){0u, 0u, 0u, 0u}; }
    bf16* XB = (bf16*)(ws + WS_XB);
    for (int rbase = gw; rbase < MT + MMEM; rbase += 4 * NGW) {
        f32x4 v[4][4];
#pragma unroll
        for (int q = 0; q < 4; ++q) { const int r = rbase + q * NGW;
            if (r < MT + MMEM && !(r >= MREAL && r < MT)) {
                const float* src = r < MP ? a.in[I_XP] + (size_t)r * DM : (r < MREAL ? a.in[I_XS] + (size_t)(r - MP) * DM : a.in[I_MEMP] + (size_t)(r - MT) * DM);
                const GAS f32x4* xr = (const GAS f32x4*)src + F.lane;
#pragma unroll
                for (int j = 0; j < 4; ++j) v[q][j] = xr[64 * j]; }
            else {
#pragma unroll
                for (int j = 0; j < 4; ++j) v[q][j] = (f32x4){0.f, 0.f, 0.f, 0.f}; } }
#pragma unroll
        for (int q = 0; q < 4; ++q) { const int r = rbase + q * NGW; if (r < MT + MMEM) { GAS unsigned long long* o8 = (GAS unsigned long long*)(XB + (size_t)r * DM) + F.lane;
#pragma unroll
            for (int j = 0; j < 4; ++j) o8[64 * j] = (unsigned long long)pk2(v[q][j].x, v[q][j].y) | ((unsigned long long)pk2(v[q][j].z, v[q][j].w) << 32); } }
    }
    float* rope = (float*)(ws + WS_ROPE);
    for (int idx = F.vcu * 512 + F.tid; idx < 2049 * 16; idx += F.G * 512) {
        const int p = idx >> 4, i = idx & 15; const double pos = (p == 2048) ? 8192.0 : (double)p;
        double f = 1.0; for (int k = 0; k < i; ++k) f *= 0.5623413251903491;
        const double x = pos * f; const double kq = __builtin_rint(x * 0.6366197723675814);
        double y = __builtin_fma(-kq, 1.5707963267948966, x); y = __builtin_fma(-kq, 6.123233995736766e-17, y);
        const int q = (int)((long long)kq & 3ll); const double y2 = y * y;
        const double sn = y * (1.0 + y2 * (-1.0 / 6 + y2 * (1.0 / 120 + y2 * (-1.0 / 5040 + y2 * (1.0 / 362880 + y2 * (-1.0 / 39916800 + y2 * (1.0 / 6227020800.0 + y2 * (-1.0 / 1307674368000.0))))))));
        const double cs = 1.0 + y2 * (-0.5 + y2 * (1.0 / 24 + y2 * (-1.0 / 720 + y2 * (1.0 / 40320 + y2 * (-1.0 / 3628800 + y2 * (1.0 / 479001600.0 + y2 * (-1.0 / 87178291200.0 + y2 * (1.0 / 20922789888000.0))))))));
        const double s = (q == 0) ? sn : (q == 1) ? cs : (q == 2) ? -sn : -cs;
        const double c = (q == 0) ? cs : (q == 1) ? -sn : (q == 2) ? -cs : sn;
        rope[p * 32 + i] = (float)c; rope[p * 32 + 16 + i] = (float)s;
    }
}

struct InOrder {
    pg8::StaticOrder s1, s2; int G, c;
    __device__ __forceinline__ void init(int G_, int c_) { s1.init(MP, NIN, 1, 0); s2.init(MMEM, 2048, 1, 0); G = G_; c = c_; }
    __device__ __forceinline__ bool next(int i, pg8::Unit& u) const {
        const int L = i * G + c;
        if (L < s1.nwg) return s1.next(L, u);
        if (!s2.next(L - s1.nwg, u)) return false;
        u.pm += MT / 256; u.pn += NIN / 256; return true;
    }
    __device__ __forceinline__ void a_ready(const pg8::Unit&) const {}
    __device__ __forceinline__ void done(const pg8::Unit&) const {}
};

__device__ __forceinline__ void st_bf4(bf16* p, f32x4 v) { v2u w; w.x = pk2(v[0], v[1]); w.y = pk2(v[2], v[3]); *(v2u*)p = w; }

struct EpiIn {
    static constexpr bool PERM = false, AFTER_DRAIN = false;
    bf16 *Q, *CKV, *KR, *U, *MKB, *MVB; float* out; const float* rope; const float* kvg; LAS float* xl;
    __device__ __forceinline__ void operator()(const pg8::f32x4 (&acc)[2][2][4][2], const pg8::Unit& u, int wr, int wc, int fr, int fq) const {
        const int row0 = u.pm * 256 + wr * 64 + fr;
        if (u.pm >= MT / 256) {
            const int cb = (u.pn - NIN / 256) * 256; const bool isv = cb >= 1024; const int c0 = (isv ? cb - 1024 : cb) + wc * 32 + 4 * fq;
            float* of = out + (isv ? O_MVP : O_MKP); bf16* ob = isv ? MVB : MKB;
#pragma unroll
            for (int ai = 0; ai < 2; ++ai)
#pragma unroll
                for (int m = 0; m < 4; ++m) { const size_t ro = (size_t)(row0 - MT + ai * 128 + m * 16) * DM;
#pragma unroll
                    for (int bj = 0; bj < 2; ++bj)
#pragma unroll
                        for (int n = 0; n < 2; ++n) { const int c = c0 + bj * 128 + n * 16; const f32x4 v = acc[ai][bj][m][n]; *(f32x4*)(of + ro + c) = v; st_bf4(ob + ro + c, v); } }
        } else if (u.pn < 3) {
#pragma unroll
            for (int bj = 0; bj < 2; ++bj) { const int grp = u.pn * 8 + bj * 4 + wc; const bool isr = (grp % 3) == 2; const int colb = grp * 32 + 4 * fq;
#pragma unroll
                for (int ai = 0; ai < 2; ++ai)
#pragma unroll
                    for (int m = 0; m < 4; ++m) { const int row = row0 + ai * 128 + m * 16; f32x4 v0 = acc[ai][bj][m][0], v1 = acc[ai][bj][m][1];
                        if (isr) { const int pidx = row >= MP ? 2048 : (row & 2047); const f32x4 cs = *(const f32x4*)(rope + pidx * 32 + 4 * fq), sn = *(const f32x4*)(rope + pidx * 32 + 16 + 4 * fq);
                            const f32x4 o0 = v0 * cs - v1 * sn, o1 = v1 * cs + v0 * sn; v0 = o0; v1 = o1; }
                        st_bf4(Q + (size_t)row * QC + colb, v0 * QS_MLA); st_bf4(Q + (size_t)row * QC + colb + 16, v1 * QS_MLA); } }
        } else if (u.pn == 3) {
#pragma unroll
            for (int ai = 0; ai < 2; ++ai)
#pragma unroll
                for (int m = 0; m < 4; ++m) { float ss = 0.f;
#pragma unroll
                    for (int bj = 0; bj < 2; ++bj)
#pragma unroll
                        for (int n = 0; n < 2; ++n) { const f32x4 v = acc[ai][bj][m][n]; ss += (v[0] * v[0] + v[1] * v[1]) + (v[2] * v[2] + v[3] * v[3]); }
                    ss += __shfl_xor(ss, 16); ss += __shfl_xor(ss, 32);
                    if (fq == 0) xl[(ai * 128 + wr * 64 + m * 16 + fr) * 4 + wc] = ss; }
            asm volatile("s_waitcnt lgkmcnt(0)" ::: "memory"); __builtin_amdgcn_s_barrier(); asm volatile("" ::: "memory");
#pragma unroll
            for (int ai = 0; ai < 2; ++ai)
#pragma unroll
                for (int m = 0; m < 4; ++m) { const int rl = ai * 128 + wr * 64 + m * 16 + fr, row = u.pm * 256 + rl; const f32x4 p = *(const LAS f32x4*)(xl + rl * 4);
                    const float rs = 1.0f / sqrtf(((p[0] + p[1]) + (p[2] + p[3])) * (1.0f / 256.0f) + LN_EPS);
                    float* of = row < MP ? out + O_CKVP + (size_t)row * KVL : out + O_CKVS + (size_t)(row - MP) * KVL;
#pragma unroll
                    for (int bj = 0; bj < 2; ++bj)
#pragma unroll
                        for (int n = 0; n < 2; ++n) { const int c = bj * 128 + wc * 32 + n * 16 + 4 * fq; const f32x4 o = acc[ai][bj][m][n] * rs * *(const f32x4*)(kvg + c);
                            st_bf4(CKV + (size_t)row * KVL + c, o); if (row < MREAL) *(f32x4*)(of + c) = o; } }
            asm volatile("s_waitcnt lgkmcnt(0)" ::: "memory"); __builtin_amdgcn_s_barrier(); asm volatile("" ::: "memory");
        } else if (u.pn < 8) {
            const int cb = (u.pn - 4) * 128 + wc * 32 + 4 * fq;
#pragma unroll
            for (int ai = 0; ai < 2; ++ai)
#pragma unroll
                for (int m = 0; m < 4; ++m) { const int row = row0 + ai * 128 + m * 16, t = row & 2047;
#pragma unroll
                    for (int n = 0; n < 2; ++n) { const f32x4 av = acc[ai][0][m][n], gv = acc[ai][1][m][n]; f32x4 o;
#pragma unroll
                        for (int j = 0; j < 4; ++j) o[j] = av[j] / (1.0f + __expf(-gv[j]));
                        const int c = cb + n * 16; st_bf4(U + (size_t)row * CCH + c, o);
                        if (row < MP) { if (t >= SEQ - 30) *(f32x4*)(out + O_CONVP + ((size_t)(row >> 11) * 30 + (t - (SEQ - 30))) * CCH + c) = o; }
                        else if (row < MREAL) *(f32x4*)(out + O_CONVS + ((size_t)(row - MP) * 30 + 29) * CCH + c) = o; } }
        } else {
            if (wc == 0) {
#pragma unroll
                for (int ai = 0; ai < 2; ++ai)
#pragma unroll
                    for (int m = 0; m < 4; ++m) { const int row = row0 + ai * 128 + m * 16; const f32x4 v0 = acc[ai][0][m][0], v1 = acc[ai][0][m][1];
                        const int pidx = row >= MP ? 2048 : (row & 2047); const f32x4 cs = *(const f32x4*)(rope + pidx * 32 + 4 * fq), sn = *(const f32x4*)(rope + pidx * 32 + 16 + 4 * fq);
                        const f32x4 o0 = v0 * cs - v1 * sn, o1 = v1 * cs + v0 * sn;
                        st_bf4(KR + (size_t)row * RD + 4 * fq, o0); st_bf4(KR + (size_t)row * RD + 16 + 4 * fq, o1);
                        if (row < MREAL) { float* of = row < MP ? out + O_KRP + (size_t)row * RD : out + O_KRS + (size_t)(row - MP) * RD; *(f32x4*)(of + 4 * fq) = o0; *(f32x4*)(of + 16 + 4 * fq) = o1; } }
            }
        }
    }
};

template <int ACT  > struct EpiB {
    static constexpr bool PERM = true, AFTER_DRAIN = false;
    bf16* O; int ldc; int split_cols; size_t split_stride; float scale;
    __device__ __forceinline__ void operator()(const pg8::f32x4 (&acc)[2][2][4][2], const pg8::Unit& u, int wr, int wc, int fr, int fq) const {
        const int row0 = u.pm * 256 + wr * 64 + fr; int colt = u.pn * 256; bf16* base = O;
        if (split_cols) { const int t = colt / split_cols; base += (size_t)t * split_stride; colt -= t * split_cols; }
        const int col0 = colt + wc * 32 + 8 * fq;
#pragma unroll
        for (int ai = 0; ai < 2; ++ai)
#pragma unroll
            for (int m = 0; m < 4; ++m) { bf16* rowp = base + (size_t)(row0 + ai * 128 + m * 16) * ldc + col0;
#pragma unroll
                for (int bj = 0; bj < 2; ++bj) { f32x4 v0 = acc[ai][bj][m][0], v1 = acc[ai][bj][m][1];
                    if (ACT == 1) {
#pragma unroll
                        for (int j = 0; j < 4; ++j) { const float a0 = fmaxf(v0[j], 0.f), a1 = fmaxf(v1[j], 0.f); v0[j] = a0 * a0; v1[j] = a1 * a1; } }
                    v0 = v0 * scale; v1 = v1 * scale; v4u w; w.x = pk2(v0[0], v0[1]); w.y = pk2(v0[2], v0[3]); w.z = pk2(v1[0], v1[1]); w.w = pk2(v1[2], v1[3]);
                    *(v4u*)(rowp + bj * 128) = w; } }
    }
};
__device__ __forceinline__ f32x2 row_stats4(const float* slot, int row) {
    const f32x4 a = *(const f32x4*)(slot + (size_t)row * 8), b = *(const f32x4*)(slot + (size_t)row * 8 + 4);
    const float mean = ((a[0] + a[2]) + (b[0] + b[2])) * (1.0f / DM), var = ((a[1] + a[3]) + (b[1] + b[3])) * (1.0f / DM) - mean * mean;
    return (f32x2){mean, 1.0f / sqrtf(var + LN_EPS)};
}
template <int MODE> struct EpiV {
    static constexpr bool PERM = true, AFTER_DRAIN = false;
    bf16* VB; float* slot; const bf16* r0; const float* pslot; const float* pg; const float* pb; LAS float* xl;
    __device__ __forceinline__ void operator()(const pg8::f32x4 (&acc)[2][2][4][2], const pg8::Unit& u, int wr, int wc, int fr, int fq) const {
        const int row0 = u.pm * 256 + wr * 64 + fr, col0 = u.pn * 256 + wc * 32 + 8 * fq;
        f32x4 gv[2][2], bv[2][2];
        if (MODE == 1) {
#pragma unroll
            for (int bj = 0; bj < 2; ++bj)
#pragma unroll
                for (int n = 0; n < 2; ++n) { gv[bj][n] = *(const f32x4*)(pg + col0 + bj * 128 + 4 * n); bv[bj][n] = *(const f32x4*)(pb + col0 + bj * 128 + 4 * n); } }
#pragma unroll
        for (int ai = 0; ai < 2; ++ai)
#pragma unroll
            for (int m = 0; m < 4; ++m) { const int row = row0 + ai * 128 + m * 16; const size_t ro = (size_t)row * DM + col0; float s1 = 0.f, s2 = 0.f;
                f32x2 st = {0.f, 0.f}; if (MODE == 1) st = row_stats4(pslot, row);
#pragma unroll
                for (int bj = 0; bj < 2; ++bj) { const v4u rw = *(const v4u*)(r0 + ro + bj * 128);
                    f32x4 ra = (f32x4){bflo(rw.x), bfhi(rw.x), bflo(rw.y), bfhi(rw.y)}, rb = (f32x4){bflo(rw.z), bfhi(rw.z), bflo(rw.w), bfhi(rw.w)};
                    if (MODE == 1) { ra = (ra - st[0]) * st[1] * gv[bj][0] + bv[bj][0]; rb = (rb - st[0]) * st[1] * gv[bj][1] + bv[bj][1]; }
                    const f32x4 v0 = acc[ai][bj][m][0] + ALPHA * ra, v1 = acc[ai][bj][m][1] + ALPHA * rb;
                    v4u w; w.x = pk2(v0[0], v0[1]); w.y = pk2(v0[2], v0[3]); w.z = pk2(v1[0], v1[1]); w.w = pk2(v1[2], v1[3]); *(v4u*)(VB + ro + bj * 128) = w;
                    s1 += ((v0[0] + v0[1]) + (v0[2] + v0[3])) + ((v1[0] + v1[1]) + (v1[2] + v1[3]));
                    s2 += ((v0[0] * v0[0] + v0[1] * v0[1]) + (v0[2] * v0[2] + v0[3] * v0[3])) + ((v1[0] * v1[0] + v1[1] * v1[1]) + (v1[2] * v1[2] + v1[3] * v1[3])); }
                if (slot) { s1 += __shfl_xor(s1, 16); s1 += __shfl_xor(s1, 32); s2 += __shfl_xor(s2, 16); s2 += __shfl_xor(s2, 32);
                    if (fq == 0) *(LAS f32x2*)(xl + ((ai * 128 + wr * 64 + m * 16 + fr) * 4 + wc) * 2) = (f32x2){s1, s2}; } }
        if (slot) {
            asm volatile("s_waitcnt lgkmcnt(0)" ::: "memory"); __builtin_amdgcn_s_barrier(); asm volatile("" ::: "memory");
            if (wc == 0 && fq == 0) {
#pragma unroll
                for (int ai = 0; ai < 2; ++ai)
#pragma unroll
                    for (int m = 0; m < 4; ++m) { const int rl = ai * 128 + wr * 64 + m * 16 + fr; const f32x4 a = *(const LAS f32x4*)(xl + rl * 8), b = *(const LAS f32x4*)(xl + rl * 8 + 4);
                        *(f32x2*)(slot + ((size_t)(u.pm * 256 + rl) * 4 + u.pn) * 2) = (f32x2){(a[0] + a[2]) + (b[0] + b[2]), (a[1] + a[3]) + (b[1] + b[3])}; } }
            asm volatile("s_waitcnt lgkmcnt(0)" ::: "memory"); __builtin_amdgcn_s_barrier(); asm volatile("" ::: "memory");
        }
    }
};
template <int ACT  > struct EpiFold {
    static constexpr bool PERM = true, AFTER_DRAIN = false;
    bf16* O; int ldc; const float* pslot; const float* cs; const float* bw; float scale;
    __device__ __forceinline__ void operator()(const pg8::f32x4 (&acc)[2][2][4][2], const pg8::Unit& u, int wr, int wc, int fr, int fq) const {
        const int row0 = u.pm * 256 + wr * 64 + fr, col0 = u.pn * 256 + wc * 32 + 8 * fq;
        f32x4 cv[2][2], bv[2][2];
#pragma unroll
        for (int bj = 0; bj < 2; ++bj)
#pragma unroll
            for (int n = 0; n < 2; ++n) { cv[bj][n] = *(const f32x4*)(cs + col0 + bj * 128 + 4 * n); bv[bj][n] = *(const f32x4*)(bw + col0 + bj * 128 + 4 * n); }
#pragma unroll
        for (int ai = 0; ai < 2; ++ai)
#pragma unroll
            for (int m = 0; m < 4; ++m) { const int row = row0 + ai * 128 + m * 16; const f32x2 st = row_stats4(pslot, row); bf16* rowp = O + (size_t)row * ldc + col0;
#pragma unroll
                for (int bj = 0; bj < 2; ++bj) { f32x4 v0 = (acc[ai][bj][m][0] - st[0] * cv[bj][0]) * st[1] + bv[bj][0], v1 = (acc[ai][bj][m][1] - st[0] * cv[bj][1]) * st[1] + bv[bj][1];
                    if (ACT == 1) {
#pragma unroll
                        for (int j = 0; j < 4; ++j) { const float a0 = fmaxf(v0[j], 0.f), a1 = fmaxf(v1[j], 0.f); v0[j] = a0 * a0; v1[j] = a1 * a1; } }
                    v0 = v0 * scale; v1 = v1 * scale; v4u w; w.x = pk2(v0[0], v0[1]); w.y = pk2(v0[2], v0[3]); w.z = pk2(v1[0], v1[1]); w.w = pk2(v1[2], v1[3]);
                    *(v4u*)(rowp + bj * 128) = w; } }
    }
};

__device__ __forceinline__ void ln_final(Frame& F, const bf16* V, const float* g, const float* b, float* out, int r_lo, int r_hi) {
    const int gw = F.vcu * NWAVES + F.wave, NGW = F.G * NWAVES;
    f32x4 gv[4], bv[4];
#pragma unroll
    for (int j = 0; j < 4; ++j) { gv[j] = *((const GAS f32x4*)g + F.lane + 64 * j); bv[j] = *((const GAS f32x4*)b + F.lane + 64 * j); }
    for (int rbase = r_lo + gw; rbase < r_hi; rbase += 4 * NGW) {
        v2u w[4][4];
#pragma unroll
        for (int q = 0; q < 4; ++q) { const int r = rbase + q * NGW; if (r < r_hi) { const GAS v2u* xr = (const GAS v2u*)(V + (size_t)r * DM) + F.lane;
#pragma unroll
            for (int j = 0; j < 4; ++j) w[q][j] = xr[64 * j]; } }
#pragma unroll
        for (int q = 0; q < 4; ++q) { const int r = rbase + q * NGW; if (r < r_hi) {
            f32x4 v[4]; float s = 0.f;
#pragma unroll
            for (int j = 0; j < 4; ++j) { v[j] = (f32x4){bflo(w[q][j].x), bfhi(w[q][j].x), bflo(w[q][j].y), bfhi(w[q][j].y)}; s += (v[j].x + v[j].y) + (v[j].z + v[j].w); }
            const float mean = wave_sum(s) * (1.f / DM); float s2 = 0.f;
#pragma unroll
            for (int j = 0; j < 4; ++j) { v[j] = v[j] - mean; s2 += (v[j].x * v[j].x + v[j].y * v[j].y) + (v[j].z * v[j].z + v[j].w * v[j].w); }
            const float rstd = 1.f / sqrtf(wave_sum(s2) * (1.f / DM) + LN_EPS);
            float* of = r < MP ? out + O_YP + (size_t)r * DM : out + O_YS + (size_t)(r - MP) * DM;
#pragma unroll
            for (int j = 0; j < 4; ++j) *((GAS f32x4*)of + F.lane + 64 * j) = v[j] * rstd * gv[j] + bv[j]; } }
    }
}

constexpr int CX_KSTR = 528, CX_VSTR = 544;
static_assert(256 * CX_VSTR <= MISC_OFF, "cross-attention LDS");
__device__ __forceinline__ void cross_unit32(Frame& F, const Args& a, int bh, int qblk) {
    const bf16* QX = (const bf16*)(a.ws + WS_QX); const bf16* MKB = (const bf16*)(a.ws + WS_MKB); const bf16* MVB = (const bf16*)(a.ws + WS_MVB); bf16* OX = (bf16*)(a.ws + WS_OX);
    const int b = bh >> 2, h = bh & 3, tid = F.tid, lane = F.lane, w = F.wave, q32 = lane & 31, hh = lane >> 5, gi = lane >> 4, i16 = lane & 15;
    const size_t qrow = (size_t)b * SEQ + qblk * 256 + 32 * w + q32;
    const int lr = tid >> 5, lc = tid & 31;
    { const bf16* ksrc = MKB + ((size_t)b * MEMT + lr) * DM + h * 256 + lc * 8;
      v4u rk[16];
#pragma unroll
      for (int i = 0; i < 16; ++i) rk[i] = *(const v4u*)(ksrc + (size_t)(16 * i) * DM);
#pragma unroll
      for (int i = 0; i < 16; ++i) *(LAS v4u*)(F.lds + (lr + 16 * i) * CX_KSTR + lc * 16) = rk[i]; }
    __syncthreads();
    f32x16 s[8];
#pragma unroll
    for (int kb = 0; kb < 8; ++kb)
#pragma unroll
        for (int r = 0; r < 16; ++r) s[kb][r] = 0.f;
    const LAS unsigned char* kp = F.lds + q32 * CX_KSTR + 16 * hh;
#pragma unroll
    for (int half = 0; half < 4; ++half) { bf16x8 qf[4];
#pragma unroll
        for (int k8 = 0; k8 < 4; ++k8) qf[k8] = *(const bf16x8*)(QX + qrow * DM + h * 256 + 16 * (4 * half + k8) + 8 * hh);
#pragma unroll
        for (int k8 = 0; k8 < 4; ++k8) {
#pragma unroll
            for (int kb = 0; kb < 8; ++kb) { const bf16x8 kf = *(const LAS bf16x8*)(kp + (32 * kb) * CX_KSTR + 32 * (4 * half + k8)); s[kb] = __builtin_amdgcn_mfma_f32_32x32x16_bf16(kf, qf[k8], s[kb], 0, 0, 0); if (kb == 3) __builtin_amdgcn_sched_barrier(0); }
            __builtin_amdgcn_sched_barrier(0); } }
    float mx = s[0][0];
#pragma unroll
    for (int kb = 0; kb < 8; ++kb)
#pragma unroll
        for (int r = 0; r < 16; ++r) mx = fmaxf(mx, s[kb][r]);
    mx = fmaxf(mx, __shfl_xor(mx, 32));
    unsigned pp[8][8]; float ps = 0.f;
#pragma unroll
    for (int kb = 0; kb < 8; ++kb)
#pragma unroll
        for (int j = 0; j < 8; ++j) { const float e0 = ex2(s[kb][2 * j] - mx), e1 = ex2(s[kb][2 * j + 1] - mx); ps += e0 + e1; pp[kb][j] = pk2(e0, e1); }
    ps += __shfl_xor(ps, 32);
    const float il = 1.0f / ps;
    { const bf16* vsrc = MVB + ((size_t)b * MEMT + lr) * DM + h * 256 + lc * 8;
      v4u rv[16];
#pragma unroll
      for (int i = 0; i < 16; ++i) rv[i] = *(const v4u*)(vsrc + (size_t)(16 * i) * DM);
      __syncthreads();
#pragma unroll
      for (int i = 0; i < 16; ++i) *(LAS v4u*)(F.lds + (lr + 16 * i) * CX_VSTR + lc * 16) = rv[i]; }
    __syncthreads();
    const LAS unsigned char* vb = F.lds + (4 * (gi >> 1) + (i16 >> 2)) * CX_VSTR + (16 * (gi & 1) + 4 * (i16 & 3)) * 2;
#pragma unroll 1
    for (int dh = 0; dh < 2; ++dh) {
        f32x16 o[4];
#pragma unroll
        for (int db = 0; db < 4; ++db)
#pragma unroll
            for (int r = 0; r < 16; ++r) o[db][r] = 0.f;
#pragma unroll
        for (int kb = 0; kb < 8; ++kb)
#pragma unroll
            for (int st = 0; st < 2; ++st) {
                const v4u pw = (v4u){pp[kb][4 * st], pp[kb][4 * st + 1], pp[kb][4 * st + 2], pp[kb][4 * st + 3]};
                const bf16x8 pf = __builtin_bit_cast(bf16x8, pw);
                const LAS unsigned char* vk = vb + (32 * kb + 16 * st) * CX_VSTR + dh * 256;
#pragma unroll
                for (int db = 0; db < 4; ++db) { const s16x4 lo = tr_read(vk + db * 64), hi = tr_read(vk + 8 * CX_VSTR + db * 64);
                    const bf16x8 av = (bf16x8){lo[0], lo[1], lo[2], lo[3], hi[0], hi[1], hi[2], hi[3]};
                    o[db] = __builtin_amdgcn_mfma_f32_32x32x16_bf16(av, pf, o[db], 0, 0, 0); }
                __builtin_amdgcn_sched_barrier(0); }
#pragma unroll
        for (int db = 0; db < 4; ++db)
#pragma unroll
            for (int rg = 0; rg < 4; ++rg) st_bf4(OX + qrow * DM + h * 256 + 128 * dh + 32 * db + 8 * rg + 4 * hh, (f32x4){o[db][4 * rg], o[db][4 * rg + 1], o[db][4 * rg + 2], o[db][4 * rg + 3]} * il);
    }
    __syncthreads();
}

__device__ __forceinline__ void scross_unit(Frame& F, const Args& a, int b, int hp) {
    const bf16* QX = (const bf16*)(a.ws + WS_QX); bf16* OX = (bf16*)(a.ws + WS_OX);
    const int lane = F.lane, w = F.wave, tid = F.tid;
    LAS float* SC = (LAS float*)F.lds;
    LAS float* OP = (LAS float*)(F.lds + 2048);
    const size_t qrow = (size_t)MP + b;
    f32x4 q[2];
#pragma unroll
    for (int j = 0; j < 2; ++j) { const v2u qq = *(const v2u*)(QX + qrow * DM + (2 * hp + j) * 256 + 4 * lane); q[j] = (f32x4){bflo(qq.x), bfhi(qq.x), bflo(qq.y), bfhi(qq.y)}; }
    const float* kb = a.in[I_MEMK] + ((size_t)b * MEMT) * DM + (2 * hp) * 256 + 4 * lane; const float* vb = a.in[I_MEMV] + ((size_t)b * MEMT) * DM + (2 * hp) * 256 + 4 * lane;
#pragma unroll 8
    for (int i = 0; i < 32; ++i) { const int mt = w * 32 + i;
        const f32x4 k0 = __builtin_nontemporal_load((const f32x4*)(kb + (size_t)mt * DM)), k1 = __builtin_nontemporal_load((const f32x4*)(kb + (size_t)mt * DM + 256));
        float d0 = (k0[0] * q[0][0] + k0[1] * q[0][1]) + (k0[2] * q[0][2] + k0[3] * q[0][3]), d1 = (k1[0] * q[1][0] + k1[1] * q[1][1]) + (k1[2] * q[1][2] + k1[3] * q[1][3]);
        d0 = wave_sum(d0); d1 = wave_sum(d1);
        if (lane == 0) { SC[mt] = d0; SC[256 + mt] = d1; } }
    __syncthreads();
    if (w < 2) { f32x4 s = *(const LAS f32x4*)(SC + w * 256 + 4 * lane); const float mx = wave_max(fmaxf(fmaxf(s[0], s[1]), fmaxf(s[2], s[3])));
#pragma unroll
        for (int j = 0; j < 4; ++j) s[j] = ex2(s[j] - mx);
        const float inv = 1.0f / wave_sum((s[0] + s[1]) + (s[2] + s[3]));
        *(LAS f32x4*)(SC + w * 256 + 4 * lane) = s * inv; }
    __syncthreads();
    f32x4 o0 = (f32x4){0.f, 0.f, 0.f, 0.f}, o1 = o0;
#pragma unroll 8
    for (int i = 0; i < 32; ++i) { const int mt = w * 32 + i; const float p0 = SC[mt], p1 = SC[256 + mt];
        const f32x4 v0 = __builtin_nontemporal_load((const f32x4*)(vb + (size_t)mt * DM)), v1 = __builtin_nontemporal_load((const f32x4*)(vb + (size_t)mt * DM + 256));
        o0 += p0 * v0; o1 += p1 * v1; }
    *(LAS f32x4*)(OP + w * 512 + 4 * lane) = o0; *(LAS f32x4*)(OP + w * 512 + 256 + 4 * lane) = o1;
    __syncthreads();
    { float s = 0.f;
#pragma unroll
      for (int k = 0; k < 8; ++k) s += OP[k * 512 + tid];
      OX[qrow * DM + (2 * hp) * 256 + tid] = (bf16)(pk2(s, 0.f) & 0xffffu); }
    __syncthreads();
}

constexpr int MLA_KSTR = 208, MLA_VSTR = 144, MLA_KT = 64 * MLA_KSTR, MLA_BUF = MLA_KT + 64 * MLA_VSTR;
constexpr int DT_STR = 592, DT_BYTES = 16 * DT_STR, P3_T = 2 * MLA_BUF, P3_QL = P3_T + 8 * DT_BYTES, P3_QN = P3_QL + 16 * DT_STR, P3_CTL = P3_QN + 2048, P3_QS0 = P3_CTL + 128;
static_assert(P3_QS0 + 4 * 3072 <= MISC_OFF && P3_T % 16 == 0 && P3_QS0 % 16 == 0, "phase-3 LDS map");
__device__ __forceinline__ void bar4(LAS unsigned* ctr, unsigned& target, int lane) {
    target += 4u;
    asm volatile("s_waitcnt lgkmcnt(0)" ::: "memory");
    if (lane == 0) __hip_atomic_fetch_add(ctr, 1u, __ATOMIC_RELAXED, __HIP_MEMORY_SCOPE_WORKGROUP);
    while (__hip_atomic_load(ctr, __ATOMIC_RELAXED, __HIP_MEMORY_SCOPE_WORKGROUP) < target) __builtin_amdgcn_s_sleep(1);
    asm volatile("" ::: "memory");
}
__device__ __forceinline__ void mla_unit4(Frame& F, const Args& a, int bh, int qblk, LAS unsigned* bctr, unsigned& btgt) {
    const bf16* Q = (const bf16*)(a.ws + WS_Q); const bf16* KN = (const bf16*)(a.ws + WS_KN); const bf16* VV = (const bf16*)(a.ws + WS_VV); const bf16* KR = (const bf16*)(a.ws + WS_KR); bf16* AC = (bf16*)(a.ws + WS_AC);
    const int b = bh >> 3, h = bh & 7, lane = F.lane, aw = F.wave, q32 = lane & 31, hh = lane >> 5, t4 = aw * 64 + lane;
    const size_t rb = (size_t)b * SEQ; const int q0 = qblk * 256, NT = 4 * (qblk + 1);
    const size_t qrow = rb + q0 + 64 * aw + q32;
    bf16x8 qf[3];
    LAS unsigned char* qst = F.lds + P3_T + aw * DT_BYTES + lane * 16; LAS unsigned char* qs0 = F.lds + P3_QS0 + aw * 3072 + lane * 16;
#pragma unroll
    for (int s = 0; s < 6; ++s) { const bf16x8 q0v = *(const bf16x8*)(Q + qrow * QC + h * 96 + 16 * s + 8 * hh); if (s < 3) qf[s] = q0v; else *(LAS bf16x8*)(qs0 + (s - 3) * 1024) = q0v;
        *(LAS bf16x8*)(qst + s * 1024) = *(const bf16x8*)(Q + (qrow + 32) * QC + h * 96 + 16 * s + 8 * hh); }
    f32x16 o[2][2];
#pragma unroll
    for (int r = 0; r < 16; ++r) { o[0][0][r] = 0.f; o[0][1][r] = 0.f; o[1][0][r] = 0.f; o[1][1][r] = 0.f; }
    float m[2] = {-1e30f, -1e30f}, l[2] = {0.f, 0.f};
    const int r0 = t4 >> 3, c0 = t4 & 7, rr = t4 >> 2, cr = t4 & 3;
    const bf16* vsrc = VV + (rb + r0) * 512 + h * 64 + c0 * 8; const bf16* nsrc = KN + (rb + r0) * 512 + h * 64 + c0 * 8; const bf16* rsrc = KR + (rb + rr) * RD + cr * 8;
    const int vdst = MLA_KT + r0 * MLA_VSTR + c0 * 16, ndst = r0 * MLA_KSTR + c0 * 16, rdst = rr * MLA_KSTR + 128 + cr * 16;
    v4u pv0, pv1, pn0, pn1, pr;
#define MLA_LOAD(t_) do { const size_t off_ = (size_t)(t_) * 64; pv0 = *(const v4u*)(vsrc + off_ * 512); pv1 = *(const v4u*)(vsrc + (off_ + 32) * 512); pn0 = *(const v4u*)(nsrc + off_ * 512); pn1 = *(const v4u*)(nsrc + (off_ + 32) * 512); pr = *(const v4u*)(rsrc + off_ * RD); } while (0)
#define MLA_STORE(buf_) do { LAS unsigned char* nb_ = (buf_); *(LAS v4u*)(nb_ + vdst) = pv0; *(LAS v4u*)(nb_ + vdst + 32 * MLA_VSTR) = pv1; *(LAS v4u*)(nb_ + ndst) = pn0; *(LAS v4u*)(nb_ + ndst + 32 * MLA_KSTR) = pn1; *(LAS v4u*)(nb_ + rdst) = pr; } while (0)
    MLA_LOAD(0); MLA_STORE(F.lds);
    bar4(bctr, btgt, lane);
    const int qmin = q0 + 64 * aw, qpos = qmin + q32;
    const int gi = lane >> 4, i16 = lane & 15;
    for (int t = 0; t < NT; ++t) {
        const LAS unsigned char* Kt = F.lds + (t & 1) * MLA_BUF; const LAS unsigned char* Vt = Kt + MLA_KT;
        const bool more = t + 1 < NT;
        if (more) MLA_LOAD(t + 1);
        if (64 * t <= qmin + 63) {
            const bool diag = 64 * t + 63 > qmin;
            const LAS unsigned char* vb = Vt + (4 * (gi >> 1) + (i16 >> 2)) * MLA_VSTR + (16 * (gi & 1) + 4 * (i16 & 3)) * 2;
#pragma unroll
            for (int kb = 0; kb < 2; ++kb) {
                f32x16 s[2];
#pragma unroll
                for (int r = 0; r < 16; ++r) { s[0][r] = 0.f; s[1][r] = 0.f; }
#pragma unroll
                for (int ks = 0; ks < 6; ++ks) { const bf16x8 kf = *(const LAS bf16x8*)(Kt + (32 * kb + q32) * MLA_KSTR + (16 * ks + 8 * hh) * 2); const bf16x8 q1 = *(const LAS bf16x8*)(qst + ks * 1024);
                    const bf16x8 q0 = ks < 3 ? qf[ks < 3 ? ks : 0] : *(const LAS bf16x8*)(qs0 + (ks - 3) * 1024);
                    s[0] = __builtin_amdgcn_mfma_f32_32x32x16_bf16(kf, q0, s[0], 0, 0, 0); s[1] = __builtin_amdgcn_mfma_f32_32x32x16_bf16(kf, q1, s[1], 0, 0, 0);
                    if (ks & 1) __builtin_amdgcn_sched_barrier(0); }
                s16x4 vlo[2][2], vhi[2][2];
#pragma unroll
                for (int st = 0; st < 2; ++st)
#pragma unroll
                    for (int db = 0; db < 2; ++db) { const LAS unsigned char* vk = vb + (32 * kb + 16 * st) * MLA_VSTR + db * 64; vlo[st][db] = tr_read(vk); vhi[st][db] = tr_read(vk + 8 * MLA_VSTR); }
#pragma unroll
                for (int u = 0; u < 2; ++u) {
                    if (diag) {
#pragma unroll
                        for (int r = 0; r < 16; ++r) { const int key = 64 * t + 32 * kb + (r & 3) + 8 * (r >> 2) + 4 * hh; if (key > qpos + 32 * u) s[u][r] = -INFINITY; } }
                    float mx = fmaxf(s[u][0], s[u][1]);
#pragma unroll
                    for (int r = 2; r < 16; ++r) mx = fmaxf(mx, s[u][r]);
                    mx = fmaxf(mx, __shfl_xor(mx, 32));
                    if (__any(mx > m[u])) { const float mn = fmaxf(m[u], mx), al = ex2(m[u] - mn); m[u] = mn; l[u] *= al;
#pragma unroll
                        for (int r = 0; r < 16; ++r) { o[u][0][r] *= al; o[u][1][r] *= al; } }
                    float ps = 0.f; unsigned pp[8];
#pragma unroll
                    for (int j = 0; j < 8; ++j) { const float e0 = ex2(s[u][2 * j] - m[u]), e1 = ex2(s[u][2 * j + 1] - m[u]); ps += e0 + e1; pp[j] = pk2(e0, e1); }
                    l[u] += ps;
#pragma unroll
                    for (int st = 0; st < 2; ++st) {
                        const v4u pw = (v4u){pp[4 * st], pp[4 * st + 1], pp[4 * st + 2], pp[4 * st + 3]};
                        const bf16x8 pf = __builtin_bit_cast(bf16x8, pw);
#pragma unroll
                        for (int db = 0; db < 2; ++db) { const s16x4 lo = vlo[st][db], hi = vhi[st][db];
                            const bf16x8 av = (bf16x8){lo[0], lo[1], lo[2], lo[3], hi[0], hi[1], hi[2], hi[3]};
                            o[u][db] = __builtin_amdgcn_mfma_f32_32x32x16_bf16(av, pf, o[u][db], 0, 0, 0); } }
                }
            }
        }
        if (more) MLA_STORE(F.lds + ((t + 1) & 1) * MLA_BUF);
        bar4(bctr, btgt, lane);
    }
#undef MLA_LOAD
#undef MLA_STORE
#pragma unroll
    for (int u = 0; u < 2; ++u) { const float lt = l[u] + __shfl_xor(l[u], 32), il = 1.0f / lt;
#pragma unroll
        for (int db = 0; db < 2; ++db)
#pragma unroll
            for (int rg = 0; rg < 4; ++rg) st_bf4(AC + (qrow + 32 * u) * DM + h * 64 + 32 * db + 8 * rg + 4 * hh, (f32x4){o[u][db][4 * rg], o[u][db][4 * rg + 1], o[u][db][4 * rg + 2], o[u][db][4 * rg + 3]} * il); }
}

__device__ __forceinline__ void decode_setup(Frame& F, const Args& a, int b, int half) {
    const bf16* Q = (const bf16*)(a.ws + WS_Q); float* QLAT = (float*)(a.ws + WS_QLAT);
    const int tid = F.tid;
    LAS float* qn = (LAS float*)(F.lds + P3_QN); LAS unsigned char* QL = F.lds + P3_QL;
    const size_t qrow = (size_t)MP + b;
    { const int h = tid >> 6, d = tid & 63; qn[tid] = bf2f(Q[qrow * QC + h * 96 + d]); }
    for (int i = tid; i < 8 * DT_STR / 4; i += 512) ((LAS unsigned*)(QL + 8 * DT_STR))[i] = 0u;
    if (tid < 256) { const int h = tid >> 5, r = tid & 31; *(LAS bf16*)(QL + h * DT_STR + (256 + r) * 2) = Q[qrow * QC + h * 96 + 64 + r]; }
    __syncthreads();
    { const int h = tid >> 6, l4 = (tid & 63) * 4; const float* wuk = a.in[I_WUK]; f32x4 ql;
#pragma unroll
      for (int li = 0; li < 4; ++li) { const float* wp = wuk + ((size_t)(l4 + li) * 8 + h) * 64; float acc = 0.f;
#pragma unroll
          for (int d4 = 0; d4 < 16; ++d4) { const f32x4 wv = *(const f32x4*)(wp + 4 * d4); const f32x4 qv = *(const LAS f32x4*)(qn + h * 64 + 4 * d4); acc += (wv[0] * qv[0] + wv[1] * qv[1]) + (wv[2] * qv[2] + wv[3] * qv[3]); }
          ql[li] = acc; }
      v2u pw; pw.x = pk2(ql[0], ql[1]); pw.y = pk2(ql[2], ql[3]); *(LAS v2u*)(QL + h * DT_STR + l4 * 2) = pw;
      if (half == 0) *(f32x4*)(QLAT + ((size_t)b * 8 + h) * 256 + l4) = ql; }
    __syncthreads();
}
__device__ __forceinline__ void decode_stream(Frame& F, const Args& a, int b, int half, LAS unsigned* pctr, f32x4 (&o)[16], float& m, float& l) {
    const int lane = F.lane, w = F.wave, r16 = lane & 15, g = lane >> 4;
    const LAS unsigned char* QL = F.lds + P3_QL; LAS unsigned char* T = F.lds + P3_T + w * DT_BYTES;
    const LAS unsigned char* qlp = QL + r16 * DT_STR + 16 * g;
    const int* pt = (const int*)a.in[I_PT] + b * NPG + half * 32;
    const float* cck = a.in[I_CKV]; const float* ckr = a.in[I_KROPE];
    f32x4 cl[16], rp[2];
#define DEC_LOAD(blk_, pgi_) do { const float* cb_ = cck + ((size_t)(pgi_) * 128 + (blk_) * 16) * KVL + 4 * lane; const float* rb_ = ckr + ((size_t)(pgi_) * 128 + (blk_) * 16 + (lane >> 2)) * RD + (lane & 3) * 8; \
        _Pragma("unroll") for (int i_ = 0; i_ < 16; ++i_) cl[i_] = __builtin_nontemporal_load((const f32x4*)(cb_ + i_ * KVL)); \
        rp[0] = __builtin_nontemporal_load((const f32x4*)rb_); rp[1] = __builtin_nontemporal_load((const f32x4*)(rb_ + 4)); } while (0)
#define DEC_GRAB(dst_) do { unsigned v_ = 0u; if (lane == 0) v_ = __hip_atomic_fetch_add(pctr, 1u, __ATOMIC_RELAXED, __HIP_MEMORY_SCOPE_WORKGROUP); dst_ = (int)__builtin_amdgcn_readfirstlane(v_); } while (0)
    int pcur; DEC_GRAB(pcur);
    bool valid = pcur < 32; int pg = 0, blk = 0;
    if (valid) { pg = __builtin_amdgcn_readfirstlane(pt[pcur]); DEC_LOAD(0, pg); }
#pragma unroll 1
    while (valid) {
#pragma unroll
        for (int i = 0; i < 16; ++i) { v2u pw; pw.x = pk2(cl[i][0], cl[i][1]); pw.y = pk2(cl[i][2], cl[i][3]); *(LAS v2u*)(T + i * DT_STR + lane * 8) = pw; }
        { v4u pw; pw.x = pk2(rp[0][0], rp[0][1]); pw.y = pk2(rp[0][2], rp[0][3]); pw.z = pk2(rp[1][0], rp[1][1]); pw.w = pk2(rp[1][2], rp[1][3]); *(LAS v4u*)(T + (lane >> 2) * DT_STR + 512 + (lane & 3) * 16) = pw; }
        ++blk;
        if (blk == 8) { blk = 0; DEC_GRAB(pcur); valid = pcur < 32; if (valid) pg = __builtin_amdgcn_readfirstlane(pt[pcur]); }
        if (valid) DEC_LOAD(blk, pg);
        f32x4 sa = (f32x4){0.f, 0.f, 0.f, 0.f};
#pragma unroll
        for (int s = 0; s < 9; ++s) { const bf16x8 av = *(const LAS bf16x8*)(T + r16 * DT_STR + (32 * s + 8 * g) * 2); const bf16x8 qv = *(const LAS bf16x8*)(qlp + 64 * s); sa = __builtin_amdgcn_mfma_f32_16x16x32_bf16(av, qv, sa, 0, 0, 0); if (s % 3 == 2) __builtin_amdgcn_sched_barrier(0); }
        float mx = fmaxf(fmaxf(sa[0], sa[1]), fmaxf(sa[2], sa[3])); mx = fmaxf(mx, __shfl_xor(mx, 16)); mx = fmaxf(mx, __shfl_xor(mx, 32));
        if (__any(mx > m)) { const float mn = fmaxf(m, mx), al = ex2(m - mn); m = mn; l *= al;
#pragma unroll
            for (int lb = 0; lb < 16; ++lb) o[lb] = o[lb] * al; }
        float p[4];
#pragma unroll
        for (int r = 0; r < 4; ++r) p[r] = ex2(sa[r] - m);
        l += (p[0] + p[1]) + (p[2] + p[3]);
        v2u pw; pw.x = pk2(p[0], p[1]); pw.y = pk2(p[2], p[3]); const s16x4 pb = __builtin_bit_cast(s16x4, pw);
        const LAS unsigned char* tb = T + (4 * g + (r16 >> 2)) * DT_STR + (4 * (r16 & 3)) * 2;
#pragma unroll
        for (int lb = 0; lb < 16; ++lb) { const s16x4 av = tr_read(tb + lb * 32); o[lb] = __builtin_amdgcn_mfma_f32_16x16x16bf16_1k(av, pb, o[lb], 0, 0, 0); if ((lb & 3) == 3) __builtin_amdgcn_sched_barrier(0); }
    }
#undef DEC_LOAD
#undef DEC_GRAB
}
__device__ __forceinline__ void decode_finish(Frame& F, const Args& a, int b, int half, const f32x4 (&o)[16], float m, float l) {
    float* PART = (float*)(a.ws + WS_PART); float* PML = (float*)(a.ws + WS_PML);
    const int tid = F.tid, lane = F.lane, w = F.wave, r16 = lane & 15, g = lane >> 4;
    l += __shfl_xor(l, 16); l += __shfl_xor(l, 32);
    LAS float* CB = (LAS float*)F.lds;
    LAS float* ML = (LAS float*)(F.lds + 65536);
    if (r16 < 8) {
#pragma unroll
        for (int lb = 0; lb < 16; ++lb) *(LAS f32x4*)(CB + (w * 8 + r16) * 256 + 16 * lb + 4 * g) = o[lb];
        if (g == 0) { ML[(w * 8 + r16) * 2] = m; ML[(w * 8 + r16) * 2 + 1] = l; } }
    __syncthreads();
    { const int h = tid >> 6, l4 = (tid & 63) * 4; float M = -1e30f;
#pragma unroll
      for (int k = 0; k < 8; ++k) M = fmaxf(M, ML[(k * 8 + h) * 2]);
      float L = 0.f; f32x4 acc = (f32x4){0.f, 0.f, 0.f, 0.f};
#pragma unroll
      for (int k = 0; k < 8; ++k) { const float sc = ex2(ML[(k * 8 + h) * 2] - M); L += ML[(k * 8 + h) * 2 + 1] * sc; acc += sc * *(const LAS f32x4*)(CB + (k * 8 + h) * 256 + l4); }
      const size_t pu = ((size_t)(b * 2 + half) * 8 + h);
      *(f32x4*)(PART + pu * 256 + l4) = acc;
      if ((tid & 63) == 0) { PML[pu * 2] = M; PML[pu * 2 + 1] = L; } }
    __syncthreads();
}
__device__ __forceinline__ void combine_unit(Frame& F, const Args& a, int b);
__device__ __forceinline__ void p3_phase(Frame& F, const Args& a) {
    LAS unsigned* ctl = (LAS unsigned*)(F.lds + P3_CTL);
    bool first = true;
    for (int du = F.vcu; first || du < NS * 2; du += F.G) {
        const bool has_dec = du < NS * 2; const int b = du >> 1, half = du & 1;
        if (F.tid == 0) { ctl[0] = 0u; ctl[16] = 0u; }
        if (has_dec) decode_setup(F, a, b, half); else __syncthreads();
        asm volatile("" : "+v"(F.tid)); F.lane = F.tid & 63;
        if (first && F.wave < 4) { unsigned btgt = 0u; __builtin_amdgcn_s_setprio(2);
            for (int i = 0;; ++i) { const int n = i * F.G + F.vcu; if (n >= 1024) break;
                const int r = n >> 8, v = n & 255, bh = v >> 1, s = v & 1, qa = 2 * s + (r >> 1), qblk = (r & 1) ? 7 - qa : qa;
                mla_unit4(F, a, bh, qblk, ctl, btgt); }
            __builtin_amdgcn_s_setprio(0); }
        asm volatile("" : "+v"(F.tid)); F.lane = F.tid & 63;
        f32x4 o[16];
#pragma unroll
        for (int lb = 0; lb < 16; ++lb) o[lb] = (f32x4){0.f, 0.f, 0.f, 0.f};
        float m = -1e30f, l = 0.f;
        if (has_dec) decode_stream(F, a, b, half, ctl + 16, o, m, l);
        __syncthreads();
        asm volatile("" : "+v"(F.tid)); F.lane = F.tid & 63;
        if (has_dec) { decode_finish(F, a, b, half, o, m, l);
            asm volatile("s_waitcnt vmcnt(0)" ::: "memory"); __syncthreads();
            if (F.tid == 0) { __builtin_amdgcn_fence(__ATOMIC_RELEASE, "agent"); asm volatile("s_waitcnt vmcnt(0)" ::: "memory");
                const unsigned old = __hip_atomic_fetch_add((unsigned*)(F.ctl + CW_CMB) + b, 1u, __ATOMIC_RELAXED, __HIP_MEMORY_SCOPE_AGENT);
                if (old == 1u) { __builtin_amdgcn_fence(__ATOMIC_ACQUIRE, "agent"); asm volatile("s_waitcnt vmcnt(0)" ::: "memory"); }
                ctl[24] = old; }
            __syncthreads();
            if (ctl[24] == 1u) combine_unit(F, a, b);
            __syncthreads(); }
        first = false;
    }
}

__device__ __forceinline__ void combine_unit(Frame& F, const Args& a, int b) {
    const bf16* Q = (const bf16*)(a.ws + WS_Q); const float* PART = (const float*)(a.ws + WS_PART); const float* PML = (const float*)(a.ws + WS_PML); const float* QLAT = (const float*)(a.ws + WS_QLAT); bf16* AC = (bf16*)(a.ws + WS_AC);
    const int tid = F.tid, h = tid >> 6, j = tid & 63;
    LAS float* OL = (LAS float*)F.lds;
    const float* cn = a.out + O_CKVS + (size_t)b * KVL; const float* kn = a.out + O_KRS + (size_t)b * RD;
    const f32x4 c4 = *(const f32x4*)(cn + 4 * j); const f32x4 q4 = *(const f32x4*)(QLAT + ((size_t)b * 8 + h) * 256 + 4 * j);
    float sp = (q4[0] * c4[0] + q4[1] * c4[1]) + (q4[2] * c4[2] + q4[3] * c4[3]);
    if (j < 32) sp += bf2f(Q[((size_t)MP + b) * QC + h * 96 + 64 + j]) * kn[j];
    const float sn = wave_sum(sp);
    const size_t p0 = ((size_t)(b * 2) * 8 + h), p1 = ((size_t)(b * 2 + 1) * 8 + h);
    const float M0 = PML[p0 * 2], L0 = PML[p0 * 2 + 1], M1 = PML[p1 * 2], L1 = PML[p1 * 2 + 1];
    const float M = fmaxf(fmaxf(M0, M1), sn), w0 = ex2(M0 - M), w1 = ex2(M1 - M), wn = ex2(sn - M), il = 1.0f / (L0 * w0 + L1 * w1 + wn);
    const f32x4 a0 = *(const f32x4*)(PART + p0 * 256 + 4 * j), a1 = *(const f32x4*)(PART + p1 * 256 + 4 * j);
    *(LAS f32x4*)(OL + h * 256 + 4 * j) = (a0 * w0 + a1 * w1 + c4 * wn) * il;
    __syncthreads();
    const float* wuv = a.in[I_WUV] + h * 64 + j; float acc = 0.f, acc2 = 0.f;
#pragma unroll 1
    for (int l0 = 0; l0 < 256; l0 += 64) {
        float wv[64];
#pragma unroll
        for (int i = 0; i < 64; ++i) wv[i] = wuv[(size_t)(l0 + i) * 512];
#pragma unroll
        for (int i = 0; i < 64; i += 2) { acc += OL[h * 256 + l0 + i] * wv[i]; acc2 += OL[h * 256 + l0 + i + 1] * wv[i + 1]; } }
    acc += acc2;
    AC[((size_t)MP + b) * DM + h * 64 + j] = (bf16)(pk2(acc, 0.f) & 0xffffu);
    __syncthreads();
}

constexpr int CV_UB = 62 * CCH * 2, CV_CB = 32 * CCH * 4;
__device__ __forceinline__ void conv_phase(Frame& F, const Args& a) {
    const bf16* U = (const bf16*)(a.ws + WS_U); bf16* AC = (bf16*)(a.ws + WS_AC);
    const int tid = F.tid, lane = F.lane, w = F.wave;
    LAS unsigned char* ub = F.lds;
    LAS float* cb = (LAS float*)(F.lds + CV_UB);
    const int cp = tid & 255, th = tid >> 8;
    f32x2 wt[31];
#pragma unroll
    for (int jj = 0; jj < 31; ++jj) wt[jj] = *(const f32x2*)(a.in[I_CONVW] + jj * CCH + 2 * cp);
    const f32x2 bias = *(const f32x2*)(a.in[I_CONVB] + 2 * cp);
    const f32x4 g0 = *(const f32x4*)(a.in[I_CLNG] + 8 * lane), g1 = *(const f32x4*)(a.in[I_CLNG] + 8 * lane + 4), b0 = *(const f32x4*)(a.in[I_CLNB] + 8 * lane), b1 = *(const f32x4*)(a.in[I_CLNB] + 8 * lane + 4);
    v4u tv[8];
#define CONV_LOAD(n_) do { const int b_ = (n_) >> 6, t0_ = ((n_) & 63) * 32; _Pragma("unroll") for (int i = 0; i < 8; ++i) { const int c = tid + 512 * i, r = c >> 6, ch = c & 63, t = t0_ - 30 + r; tv[i] = (v4u){0u, 0u, 0u, 0u}; \
        if (c < 62 * 64 && t >= 0) tv[i] = *(const v4u*)(U + ((size_t)b_ * SEQ + t) * CCH + ch * 8); } } while (0)
    int n = F.vcu;
    if (n < NBATCH * 64) CONV_LOAD(n);
    while (n < NBATCH * 64) {
        const int b = n >> 6, t0 = (n & 63) * 32;
#pragma unroll
        for (int i = 0; i < 8; ++i) { const int c = tid + 512 * i; if (c < 62 * 64) *(LAS v4u*)(ub + (c >> 6) * 1024 + (c & 63) * 16) = tv[i]; }
        const int nn = n + F.G;
        if (nn < NBATCH * 64) CONV_LOAD(nn);
        __syncthreads();
        {
            const int tb0 = th * 16;
            f32x2 acc[16];
#pragma unroll
            for (int tt = 0; tt < 16; ++tt) acc[tt] = bias;
#pragma unroll
            for (int i = 0; i < 46; ++i) { const unsigned uw = *(const LAS unsigned*)(ub + (tb0 + i) * 1024 + cp * 4); const f32x2 uv = {bflo(uw), bfhi(uw)};
#pragma unroll
                for (int tt = 0; tt < 16; ++tt) { const int jj = i - tt; if (jj >= 0 && jj < 31) acc[tt] += wt[jj] * uv; }
                }
#pragma unroll
            for (int tt = 0; tt < 16; ++tt) *(LAS f32x2*)(cb + (tb0 + tt) * CCH + 2 * cp) = acc[tt];
        }
        __syncthreads();
#pragma unroll
        for (int k = 0; k < 4; ++k) { const int tt = w * 4 + k; f32x4 v0 = *(const LAS f32x4*)(cb + tt * CCH + 8 * lane), v1 = *(const LAS f32x4*)(cb + tt * CCH + 8 * lane + 4);
            const float mean = wave_sum((v0[0] + v0[1]) + (v0[2] + v0[3]) + (v1[0] + v1[1]) + (v1[2] + v1[3])) * (1.0f / CCH);
            v0 = v0 - mean; v1 = v1 - mean;
            const float var = wave_sum((v0[0] * v0[0] + v0[1] * v0[1]) + (v0[2] * v0[2] + v0[3] * v0[3]) + (v1[0] * v1[0] + v1[1] * v1[1]) + (v1[2] * v1[2] + v1[3] * v1[3])) * (1.0f / CCH);
            const float rstd = 1.0f / sqrtf(var + LN_EPS);
            f32x4 y0 = v0 * rstd * g0 + b0, y1 = v1 * rstd * g1 + b1;
#pragma unroll
            for (int e = 0; e < 4; ++e) { y0[e] = y0[e] / (1.0f + __expf(-y0[e])); y1[e] = y1[e] / (1.0f + __expf(-y1[e])); }
            v4u o; o.x = pk2(y0[0], y0[1]); o.y = pk2(y0[2], y0[3]); o.z = pk2(y1[0], y1[1]); o.w = pk2(y1[2], y1[3]);
            *(v4u*)(AC + ((size_t)b * SEQ + t0 + tt) * DM + CCH + 8 * lane) = o; }
        __syncthreads();
        n = nn;
    }
#undef CONV_LOAD
}
__device__ __forceinline__ void srow_wave(Frame& F, const Args& a, int b) {
    bf16* __restrict__ AC = (bf16*)(a.ws + WS_AC); bf16* __restrict__ Q = (bf16*)(a.ws + WS_Q); const float* __restrict__ z = (const float*)(a.ws + WS_ZS) + (size_t)b * NIN; const float* __restrict__ rope = (const float*)(a.ws + WS_ROPE) + 2048 * 32;
    float* __restrict__ out = a.out;
    const int lane = F.lane, rl = lane & 15; const size_t qrow = (size_t)MP + b;
    float qn[8], x1[8], x2[8];
#pragma unroll
    for (int h = 0; h < 8; ++h) { qn[h] = z[h * 96 + lane]; x1[h] = z[h * 96 + 64 + rl]; x2[h] = z[h * 96 + 80 + rl]; }
    const float cs = rope[rl], sn = rope[16 + rl], k1 = z[2048 + rl], k2 = z[2064 + rl];
    const f32x4 c = *(const f32x4*)(z + 768 + 4 * lane), kg = *(const f32x4*)(a.in[I_KVG] + 4 * lane);
    const int c0 = 8 * lane, zb = 1024 + 256 * (c0 >> 7) + (c0 & 127);
    const f32x4 ga0 = *(const f32x4*)(z + zb), ga1 = *(const f32x4*)(z + zb + 4), gg0 = *(const f32x4*)(z + zb + 128), gg1 = *(const f32x4*)(z + zb + 132);
#pragma unroll
    for (int h = 0; h < 8; ++h) { Q[qrow * QC + h * 96 + lane] = (bf16)(pk2(qn[h] * QS_MLA, 0.f) & 0xffffu);
        if (lane < 16) { Q[qrow * QC + h * 96 + 64 + lane] = (bf16)(pk2((x1[h] * cs - x2[h] * sn) * QS_MLA, 0.f) & 0xffffu); Q[qrow * QC + h * 96 + 80 + lane] = (bf16)(pk2((x2[h] * cs + x1[h] * sn) * QS_MLA, 0.f) & 0xffffu); } }
    { const float ss = wave_sum((c[0] * c[0] + c[1] * c[1]) + (c[2] * c[2] + c[3] * c[3]));
      const float rs = 1.0f / sqrtf(ss * (1.0f / 256.0f) + LN_EPS); *(f32x4*)(out + O_CKVS + (size_t)b * KVL + 4 * lane) = c * rs * kg; }
    if (lane < 16) { out[O_KRS + (size_t)b * RD + lane] = k1 * cs - k2 * sn; out[O_KRS + (size_t)b * RD + 16 + lane] = k2 * cs + k1 * sn; }
    f32x4 u0, u1;
#pragma unroll
    for (int e = 0; e < 4; ++e) { u0[e] = ga0[e] / (1.0f + __expf(-gg0[e])); u1[e] = ga1[e] / (1.0f + __expf(-gg1[e])); }
    const float* __restrict__ st = a.in[I_SCONV] + (size_t)b * 30 * CCH + c0; const float* __restrict__ cw = a.in[I_CONVW] + c0; float* __restrict__ os = out + O_CONVS + (size_t)b * 30 * CCH + c0;
    *(f32x4*)(os + 29 * CCH) = u0; *(f32x4*)(os + 29 * CCH + 4) = u1;
    f32x4 a0 = *(const f32x4*)(a.in[I_CONVB] + c0), a1 = *(const f32x4*)(a.in[I_CONVB] + c0 + 4);
#pragma unroll 10
    for (int jj = 0; jj < 30; ++jj) { const f32x4 s0 = *(const f32x4*)(st + jj * CCH), s1 = *(const f32x4*)(st + jj * CCH + 4);
        a0 += s0 * *(const f32x4*)(cw + jj * CCH); a1 += s1 * *(const f32x4*)(cw + jj * CCH + 4); }
#pragma unroll 10
    for (int jj = 1; jj < 30; ++jj) { *(f32x4*)(os + (jj - 1) * CCH) = *(const f32x4*)(st + jj * CCH); *(f32x4*)(os + (jj - 1) * CCH + 4) = *(const f32x4*)(st + jj * CCH + 4); }
    a0 += u0 * *(const f32x4*)(cw + 30 * CCH); a1 += u1 * *(const f32x4*)(cw + 30 * CCH + 4);
    const float mean = wave_sum((a0[0] + a0[1]) + (a0[2] + a0[3]) + (a1[0] + a1[1]) + (a1[2] + a1[3])) * (1.0f / CCH);
    a0 = a0 - mean; a1 = a1 - mean;
    const float var = wave_sum((a0[0] * a0[0] + a0[1] * a0[1]) + (a0[2] * a0[2] + a0[3] * a0[3]) + (a1[0] * a1[0] + a1[1] * a1[1]) + (a1[2] * a1[2] + a1[3] * a1[3])) * (1.0f / CCH);
    const float rstd = 1.0f / sqrtf(var + LN_EPS);
    f32x4 y0 = a0 * rstd * *(const f32x4*)(a.in[I_CLNG] + c0) + *(const f32x4*)(a.in[I_CLNB] + c0), y1 = a1 * rstd * *(const f32x4*)(a.in[I_CLNG] + c0 + 4) + *(const f32x4*)(a.in[I_CLNB] + c0 + 4);
#pragma unroll
    for (int e = 0; e < 4; ++e) { y0[e] = y0[e] / (1.0f + __expf(-y0[e])); y1[e] = y1[e] / (1.0f + __expf(-y1[e])); }
    v4u o; o.x = pk2(y0[0], y0[1]); o.y = pk2(y0[2], y0[3]); o.z = pk2(y1[0], y1[1]); o.w = pk2(y1[2], y1[3]);
    *(v4u*)(AC + qrow * DM + CCH + c0) = o;
}

__device__ __forceinline__ f32x4 skinny_tile(Frame& F, const bf16* A, int lda, const bf16* Bt, int K, int n0) {
    const int lane = F.lane, w = F.wave, r16 = lane & 15, g = lane >> 4, kw = K >> 3;
    f32x4 acc[8];
#pragma unroll
    for (int mt = 0; mt < 8; ++mt) acc[mt] = (f32x4){0.f, 0.f, 0.f, 0.f};
    const bf16* ap = A + (size_t)r16 * lda + w * kw + 8 * g; const bf16* bp = Bt + (size_t)(n0 + r16) * K + w * kw + 8 * g;
#pragma unroll 1
    for (int kb = 0; kb < kw; kb += 128) {
        bf16x8 bf[4], af[4][8];
#pragma unroll
        for (int ks = 0; ks < 4; ++ks) { bf[ks] = *(const bf16x8*)(bp + kb + 32 * ks);
#pragma unroll
            for (int mt = 0; mt < 8; ++mt) af[ks][mt] = *(const bf16x8*)(ap + (size_t)(16 * mt) * lda + kb + 32 * ks); }
        __builtin_amdgcn_sched_barrier(0);
#pragma unroll
        for (int ks = 0; ks < 4; ++ks)
#pragma unroll
            for (int mt = 0; mt < 8; ++mt) acc[mt] = __builtin_amdgcn_mfma_f32_16x16x32_bf16(af[ks][mt], bf[ks], acc[mt], 0, 0, 0);
    }
    LAS float* red = (LAS float*)F.lds;
#pragma unroll
    for (int mt = 0; mt < 8; ++mt) *(LAS f32x4*)(red + (w * 16 + r16) * 128 + 16 * mt + 4 * g) = acc[mt];
    __syncthreads();
    const int row = F.tid >> 2, c4 = (F.tid & 3) * 4; f32x4 v = (f32x4){0.f, 0.f, 0.f, 0.f};
#pragma unroll
    for (int k = 0; k < 8; ++k)
#pragma unroll
        for (int j = 0; j < 4; ++j) v[j] += red[(k * 16 + c4 + j) * 128 + row];
    return v;
}
__device__ __forceinline__ void sample_stats(Frame& F, const float* sslot) {
    const int row = F.tid >> 2, part = F.tid & 3; float s1 = 0.f, s2 = 0.f;
#pragma unroll
    for (int i = 0; i < 16; ++i) { const f32x2 p = *(const f32x2*)(sslot + ((size_t)row * 64 + part * 16 + i) * 2); s1 += p[0]; s2 += p[1]; }
    s1 += __shfl_xor(s1, 1); s1 += __shfl_xor(s1, 2); s2 += __shfl_xor(s2, 1); s2 += __shfl_xor(s2, 2);
    const float mean = s1 * (1.0f / DM), var = s2 * (1.0f / DM) - mean * mean;
    if (part == 0) *(LAS f32x2*)(F.lds + 65536 + row * 8) = (f32x2){mean, 1.0f / sqrtf(var + LN_EPS)};
}
__device__ __forceinline__ void slice_stats_store(Frame& F, float* sslot, int unit, f32x4 v) {
    float s1 = (v[0] + v[1]) + (v[2] + v[3]), s2 = (v[0] * v[0] + v[1] * v[1]) + (v[2] * v[2] + v[3] * v[3]);
    s1 += __shfl_xor(s1, 1); s1 += __shfl_xor(s1, 2); s2 += __shfl_xor(s2, 1); s2 += __shfl_xor(s2, 2);
    if ((F.tid & 3) == 0) *(f32x2*)(sslot + ((size_t)(F.tid >> 2) * 64 + unit) * 2) = (f32x2){s1, s2};
}
template <int WHICH> __device__ __forceinline__ void sample_gemm(Frame& F, const Args& a) {
    unsigned char* ws = a.ws; const float* vec = (const float*)(ws + WS_VEC);
    constexpr int NU = WHICH == 1 ? INC / 16 : (WHICH == 9 ? FF / 16 : DM / 16);
    for (int u = F.vcu; u < NU; u += F.G) {
        const int n0 = 16 * u, row = F.tid >> 2, col = n0 + (F.tid & 3) * 4; const size_t ro = (size_t)(MP + row) * DM + col;
        if (WHICH == 1) { const f32x4 v = skinny_tile(F, (const bf16*)(ws + WS_XB) + (size_t)MP * DM, DM, (const bf16*)(ws + WS_WIN), DM, n0); *(f32x4*)((float*)(ws + WS_ZS) + (size_t)row * NIN + col) = v; }
        if (WHICH == 5) { const f32x4 xs = *(const f32x4*)(a.in[I_XS] + (size_t)row * DM + col);
            f32x4 v = skinny_tile(F, (const bf16*)(ws + WS_AC) + (size_t)MP * DM, DM, (const bf16*)(ws + WS_WO), DM, n0);
            v += ALPHA * xs;
            st_bf4((bf16*)(ws + WS_X1B) + ro, v); slice_stats_store(F, (float*)(ws + WS_SSL1), u, v); }
        if (WHICH == 6) { sample_stats(F, (const float*)(ws + WS_SSL1)); const f32x4 cs = *(const f32x4*)(vec + VO_CSQ + col), bw = *(const f32x4*)(vec + VO_BWQ + col);
            f32x4 v = skinny_tile(F, (const bf16*)(ws + WS_X1B) + (size_t)MP * DM, DM, (const bf16*)(ws + WS_WXQ), DM, n0);
            const f32x2 st = *(const LAS f32x2*)(F.lds + 65536 + row * 8);
            v = ((v - st[0] * cs) * st[1] + bw) * QS_MEM; st_bf4((bf16*)(ws + WS_QX) + ro, v); }
        if (WHICH == 8) { sample_stats(F, (const float*)(ws + WS_SSL1)); const v2u pw = *(const v2u*)((const bf16*)(ws + WS_X1B) + ro); const f32x4 g1 = *(const f32x4*)(a.in[I_LN1G] + col), b1 = *(const f32x4*)(a.in[I_LN1B] + col);
            f32x4 v = skinny_tile(F, (const bf16*)(ws + WS_OX) + (size_t)MP * DM, DM, (const bf16*)(ws + WS_WXO), DM, n0);
            const f32x2 st = *(const LAS f32x2*)(F.lds + 65536 + row * 8);
            const f32x4 pv = (f32x4){bflo(pw.x), bfhi(pw.x), bflo(pw.y), bfhi(pw.y)};
            const f32x4 x1 = (pv - st[0]) * st[1] * g1 + b1;
            v += ALPHA * x1; st_bf4((bf16*)(ws + WS_X2B) + ro, v); slice_stats_store(F, (float*)(ws + WS_SSL2), u, v); }
        if (WHICH == 9) { sample_stats(F, (const float*)(ws + WS_SSL2)); const f32x4 cs = *(const f32x4*)(vec + VO_CSU + col), bw = *(const f32x4*)(vec + VO_BWU + col);
            f32x4 v = skinny_tile(F, (const bf16*)(ws + WS_X2B) + (size_t)MP * DM, DM, (const bf16*)(ws + WS_WUP), DM, n0);
            const f32x2 st = *(const LAS f32x2*)(F.lds + 65536 + row * 8);
            v = (v - st[0] * cs) * st[1] + bw;
#pragma unroll
            for (int j = 0; j < 4; ++j) { const float t = fmaxf(v[j], 0.f); v[j] = t * t; }
            st_bf4((bf16*)(ws + WS_H) + (size_t)(MP + row) * FF + col, v); }
        if (WHICH == 10) { sample_stats(F, (const float*)(ws + WS_SSL2)); const v2u pw = *(const v2u*)((const bf16*)(ws + WS_X2B) + ro); const f32x4 g2 = *(const f32x4*)(a.in[I_LN2G] + col), b2 = *(const f32x4*)(a.in[I_LN2B] + col);
            f32x4 v = skinny_tile(F, (const bf16*)(ws + WS_H) + (size_t)MP * FF, FF, (const bf16*)(ws + WS_WDN), FF, n0);
            const f32x2 st = *(const LAS f32x2*)(F.lds + 65536 + row * 8);
            const f32x4 pv = (f32x4){bflo(pw.x), bfhi(pw.x), bflo(pw.y), bfhi(pw.y)};
            const f32x4 x2 = (pv - st[0]) * st[1] * g2 + b2;
            v += ALPHA * x2; st_bf4((bf16*)(ws + WS_OX) + ro, v); }
        __syncthreads();
    }
}

constexpr int N_PHASES = 11;
#ifndef REP_P0
#define REP_P0 1
#endif
#ifndef REP_CONV
#define REP_CONV 1
#endif
#ifndef REP_SK
#define REP_SK 1
#endif
#ifndef REP_LN
#define REP_LN 1
#endif
#define REPEAT_1(...) __VA_ARGS__
#define REPEAT_2(...) __VA_ARGS__ __VA_ARGS__
#define REPEAT_X(n, ...) REPEAT_##n(__VA_ARGS__)
#define REPEAT(n, ...) REPEAT_X(n, __VA_ARGS__)
#ifndef REP_G1
#define REP_G1 1
#endif
#ifndef REP_G2
#define REP_G2 1
#endif
#ifndef REP_G4
#define REP_G4 1
#endif
#ifndef REP_G5
#define REP_G5 1
#endif
#ifndef REP_G7
#define REP_G7 1
#endif
#ifndef REP_G8
#define REP_G8 1
#endif
#ifndef REP_G9
#define REP_G9 1
#endif

#ifndef REP_DEC
#define REP_DEC 1
#endif
#ifndef REP_MLA
#define REP_MLA 1
#endif
#ifndef REP_CR
#define REP_CR 1
#endif
#ifndef REP_SCR
#define REP_SCR 1
#endif
__global__ void __launch_bounds__(NWAVES * 64, 2) fwd_kernel(Args args) {
    extern __shared__ __attribute__((aligned(16))) unsigned char lds[];
    Frame F;
    F.lds = (LAS unsigned char*)lds;
    F.MISC = (volatile LAS unsigned*)(F.lds + MISC_OFF);
    F.tid = threadIdx.x; F.lane = F.tid & 63; F.wave = __builtin_amdgcn_readfirstlane(F.tid >> 6);
    F.G = gridDim.x; { const int bx = blockIdx.x; F.vcu = (F.G % 8 == 0) ? (bx % 8) * (F.G / 8) + bx / 8 : bx; }
    unsigned char* ws = args.ws;
    F.ctl = (gu32*)(ws + WS_CTL);
    if (F.tid < 32) F.MISC[F.tid] = 0u;
    __syncthreads();
    XcdBarrier bar = xcd_barrier_post((unsigned*)(F.ctl + CW_BAR), F.MISC + 8);
    const int lo = args.ph_lo, hi = args.ph_hi;
#ifndef PHMASK
#define PHMASK 0x7ff
#endif
#define IN(k) (((PHMASK >> (k)) & 1) && lo <= (k) && (k) < hi)
#define SEAM(k) do { if (IN(k) && IN((k) + 1)) xcd_barrier(bar); asm volatile("" : "+v"(F.tid)); F.lane = F.tid & 63; } while (0)
    typedef pg8::bf16_t pb;

    if (IN(0)) { REPEAT(REP_P0, p0_prologue(F, args);) }
    SEAM(0);
    if (IN(1)) {
        pg8::Gemm g{(const pb*)(ws + WS_XB), (const pb*)(ws + WS_WIN), MT + MMEM, NIN + 2048, DM}; InOrder S; S.init(F.G, (int)blockIdx.x);
        EpiIn E{(bf16*)(ws + WS_Q), (bf16*)(ws + WS_CKV), (bf16*)(ws + WS_KR), (bf16*)(ws + WS_U), (bf16*)(ws + WS_MKB), (bf16*)(ws + WS_MVB), args.out, (const float*)(ws + WS_ROPE), args.in[I_KVG], (LAS float*)(F.lds + XL_OFF)};
        REPEAT(REP_G1, pg8::gemm_phase<EpiIn, InOrder, true, true>(F.lds + RING_OFF, g, S, E);)
        __syncthreads();
        REPEAT(REP_SK, sample_gemm<1>(F, args);)
        { float* vec = (float*)(ws + WS_VEC);
          for (int i = F.vcu * 512 + F.tid; i < 2 * 1024 + 2 * 4096; i += F.G * 512) {
              const float* p; int n, ld; float* o;
              if (i < 1024) { p = vec + VO_PCSQ; n = i; ld = 1024; o = vec + VO_CSQ; } else if (i < 2048) { p = vec + VO_PBWQ; n = i - 1024; ld = 1024; o = vec + VO_BWQ; }
              else if (i < 6144) { p = vec + VO_PCSU; n = i - 2048; ld = 4096; o = vec + VO_CSU; } else { p = vec + VO_PBWU; n = i - 6144; ld = 4096; o = vec + VO_BWU; }
              float sacc = 0.f;
#pragma unroll
              for (int k = 0; k < 16; ++k) sacc += p[k * ld + n];
              o[n] = sacc; } }
    }
    SEAM(1);
    if (IN(2)) {
        int kk_ = KVL; asm volatile("" : "+s"(kk_));
        pg8::Gemm g{(const pb*)(ws + WS_CKV), (const pb*)(ws + WS_WUKV), MP, 1024, kk_}; pg8::StaticOrder S; S.init(MP, 1024, F.G, (int)blockIdx.x);
        EpiB<0> E{(bf16*)(ws + WS_KN), 512, 512, (size_t)(WS_VV - WS_KN) / 2, 1.0f};
        REPEAT(REP_G2, pg8::gemm_phase<EpiB<0>, pg8::StaticOrder, true, true>(F.lds + RING_OFF, g, S, E);)
        __syncthreads();
        REPEAT(REP_CONV, conv_phase(F, args);)
        for (int n = F.vcu + F.G * F.wave; n < NS; n += F.G * NWAVES) srow_wave(F, args, n);
    }
    SEAM(2);
    if (IN(3)) {
        for (int rep_ = 0; rep_ < REP_MLA; ++rep_) p3_phase(F, args);
    }
    SEAM(3);
    if (IN(4)) {
        pg8::Gemm g{(const pb*)(ws + WS_AC), (const pb*)(ws + WS_WO), MP, DM, DM}; pg8::StaticOrder S; S.init(MP, DM, F.G, (int)blockIdx.x);
        EpiV<0> E{(bf16*)(ws + WS_X1B), (float*)(ws + WS_SL1), (const bf16*)(ws + WS_XB), nullptr, nullptr, nullptr, (LAS float*)(F.lds + XL_OFF)};
        REPEAT(REP_G4, pg8::gemm_phase<EpiV<0>, pg8::StaticOrder, true, true>(F.lds + RING_OFF, g, S, E);)
        __syncthreads();
        REPEAT(REP_SK, sample_gemm<5>(F, args);)
    }
    SEAM(4);
    if (IN(5)) {
        pg8::Gemm g{(const pb*)(ws + WS_X1B), (const pb*)(ws + WS_WXQ), MP, DM, DM}; pg8::StaticOrder S; S.init(MP, DM, F.G, (int)blockIdx.x);
        EpiFold<0> E{(bf16*)(ws + WS_QX), DM, (const float*)(ws + WS_SL1), (const float*)(ws + WS_VEC) + VO_CSQ, (const float*)(ws + WS_VEC) + VO_BWQ, QS_MEM};
        REPEAT(REP_G5, pg8::gemm_phase<EpiFold<0>, pg8::StaticOrder, true, true>(F.lds + RING_OFF, g, S, E);)
        __syncthreads();
        REPEAT(REP_SK, sample_gemm<6>(F, args);)
    }
    SEAM(5);
    if (IN(6)) {
        for (int rep_ = 0; rep_ < REP_CR; ++rep_) for (int n = F.vcu; n < NBATCH * 4 * 8; n += F.G) cross_unit32(F, args, n >> 3, n & 7);
        for (int rep_ = 0; rep_ < REP_SCR; ++rep_) for (int n = F.vcu; n < NS * 2; n += F.G) scross_unit(F, args, n >> 1, n & 1);
    }
    SEAM(6);
    if (IN(7)) {
        pg8::Gemm g{(const pb*)(ws + WS_OX), (const pb*)(ws + WS_WXO), MP, DM, DM}; pg8::StaticOrder S; S.init(MP, DM, F.G, (int)blockIdx.x);
        EpiV<1> E{(bf16*)(ws + WS_X2B), (float*)(ws + WS_SL2), (const bf16*)(ws + WS_X1B), (const float*)(ws + WS_SL1), args.in[I_LN1G], args.in[I_LN1B], (LAS float*)(F.lds + XL_OFF)};
        REPEAT(REP_G7, pg8::gemm_phase<EpiV<1>, pg8::StaticOrder, true, true>(F.lds + RING_OFF, g, S, E);)
        __syncthreads();
        REPEAT(REP_SK, sample_gemm<8>(F, args);)
    }
    SEAM(7);
    if (IN(8)) {
        pg8::Gemm g{(const pb*)(ws + WS_X2B), (const pb*)(ws + WS_WUP), MP, FF, DM}; pg8::StaticOrder S; S.init(MP, FF, F.G, (int)blockIdx.x);
        EpiFold<1> E{(bf16*)(ws + WS_H), FF, (const float*)(ws + WS_SL2), (const float*)(ws + WS_VEC) + VO_CSU, (const float*)(ws + WS_VEC) + VO_BWU, 1.0f};
        REPEAT(REP_G8, pg8::gemm_phase<EpiFold<1>, pg8::StaticOrder, true, true>(F.lds + RING_OFF, g, S, E);)
        __syncthreads();
        REPEAT(REP_SK, sample_gemm<9>(F, args);)
    }
    SEAM(8);
    if (IN(9)) {
        pg8::Gemm g{(const pb*)(ws + WS_H), (const pb*)(ws + WS_WDN), MP, DM, FF}; pg8::StaticOrder S; S.init(MP, DM, F.G, (int)blockIdx.x);
        EpiV<1> E{(bf16*)(ws + WS_OX), nullptr, (const bf16*)(ws + WS_X2B), (const float*)(ws + WS_SL2), args.in[I_LN2G], args.in[I_LN2B], (LAS float*)(F.lds + XL_OFF)};
        REPEAT(REP_G9, pg8::gemm_phase<EpiV<1>, pg8::StaticOrder, true, true>(F.lds + RING_OFF, g, S, E);)
        __syncthreads();
        REPEAT(REP_SK, sample_gemm<10>(F, args);)
    }
    SEAM(9);
    if (IN(10)) {
        REPEAT(REP_LN, ln_final(F, (const bf16*)(ws + WS_OX), args.in[I_LN3G], args.in[I_LN3B], args.out, 0, MREAL);)
    }
#undef IN
#undef SEAM
}

#ifndef MK_PER_PHASE
#define MK_PER_PHASE 0
#endif
extern "C" void kernel_launch(void* const* d_in, const int* in_sizes, int n_in, void* d_out, int out_size, void* d_ws, size_t ws_size, hipStream_t stream) {
    static int grid = 0;
    if (grid == 0) {
        if (n_in != 30 || out_size != (int)O_END || ws_size < WS_END) { fprintf(stderr, "kernel_launch: unexpected problem (n_in %d, out %d, ws %zu); nothing launched\n", n_in, out_size, ws_size); grid = -1; return; }
        int dev = 0, cus = 0, per_cu = 0;
        if (hipGetDevice(&dev) != hipSuccess || hipDeviceGetAttribute(&cus, hipDeviceAttributeMultiprocessorCount, dev) != hipSuccess) { grid = -1; return; }
        if (hipFuncSetAttribute((const void*)fwd_kernel, hipFuncAttributeMaxDynamicSharedMemorySize, LDS_BYTES) != hipSuccess) { fprintf(stderr, "kernel_launch: hipFuncSetAttribute failed\n"); grid = -1; return; }
        if (hipOccupancyMaxActiveBlocksPerMultiprocessor(&per_cu, (const void*)fwd_kernel, NWAVES * 64, LDS_BYTES) != hipSuccess || per_cu < 1) { fprintf(stderr, "kernel_launch: occupancy query says %d\n", per_cu); }
        (void)hipGetLastError();
        grid = cus;
    }
    if (grid < 0) return;
    if (hipMemsetAsync((char*)d_ws + WS_CTL, 0, CTL_ZERO_BYTES, stream) != hipSuccess) return;
    Args a{};
    for (int i = 0; i < 30; ++i) a.in[i] = (const float*)d_in[i];
    a.out = (float*)d_out; a.ws = (unsigned char*)d_ws;
#if MK_PER_PHASE
    for (int p = 0; p < N_PHASES; ++p) { a.ph_lo = p; a.ph_hi = p + 1; hipLaunchKernelGGL(fwd_kernel, dim3(grid), dim3(NWAVES * 64), LDS_BYTES, stream, a); }
#else
    a.ph_lo = 0; a.ph_hi = N_PHASES;
    hipLaunchKernelGGL(fwd_kernel, dim3(grid), dim3(NWAVES * 64), LDS_BYTES, stream, a);
#endif
    (void)in_sizes;
}
```

```cpp
#include <hip/hip_runtime.h>
#include <cstdio>
#include <cstdint>
namespace pg8 {
#define PG8_LAS __attribute__((address_space(3)))
typedef unsigned short bf16_t;
typedef short bf16x8 __attribute__((ext_vector_type(8)));
typedef float f32x4 __attribute__((ext_vector_type(4)));
typedef unsigned u32x4 __attribute__((ext_vector_type(4)));
constexpr int BM = 256, BK = 64, HALF = 128, HTB = HALF * BK * 2  , STAGE_BYTES = 8 * HTB, NXCD = 8, WGM = 8;

__host__ __device__ __forceinline__ int lds_byte(int r, int c) { const int st = (r >> 4) * 2 + (c >> 5), rr = r & 15, cc = c & 31, ob = rr * 64 + cc * 2; return st * 1024 + (ob ^ (((ob >> 9) & 1) << 5)); }
__host__ __device__ __forceinline__ void stage_rc(int b, int& R, int& C) { const int st = b / 1024, sb = b % 1024, swz = sb ^ (((sb >> 9) & 1) << 5); R = (st >> 1) * 16 + swz / 64; C = (st & 1) * 32 + (swz % 64) / 2; }
__host__ __device__ __forceinline__ int perm32(int rho) { const int n = rho >> 4, i = rho & 15; return 8 * (i >> 2) + 4 * n + (i & 3); }

struct Unit { int pm, pn; };
struct Gemm { const bf16_t* A; const bf16_t* Bt; int M, N, K; };

struct StaticOrder {
    int nM, nN, nwg, G, c;
    __host__ __device__ void init(int M, int N, int G_, int c_) { nM = M / BM; nN = N / BM; nwg = nM * nN; G = G_; c = c_; }
    __host__ __device__ bool next(int i, Unit& u) const {
        const long L = (long)i * G + c; if (L >= nwg) return false;
        int wgid = (int)L; { const int q = nwg / NXCD, r = nwg % NXCD, xcd = wgid % NXCD, off = wgid / NXCD; wgid = (xcd < r ? xcd * (q + 1) : r * (q + 1) + (xcd - r) * q) + off; }
        const int nig = WGM * nN, gid = wgid / nig, fm = gid * WGM, gsz = (nM - fm) < WGM ? (nM - fm) : WGM;
        u.pm = fm + ((wgid % nig) % gsz); u.pn = (wgid % nig) / gsz; return true;
    }
    __device__ __forceinline__ void a_ready(const Unit&) const {}
    __device__ __forceinline__ void done(const Unit&) const {}
};


template <class Epi, class Sched, bool ALIGN_EPI = false, bool SP2 = false>
__device__ __forceinline__ void gemm_phase(PG8_LAS unsigned char* lds, const Gemm g, const Sched& S, const Epi& E) {
    const int tid = threadIdx.x, wid = __builtin_amdgcn_readfirstlane(tid >> 6), lane = tid & 63, wr = wid >> 2, wc = wid & 3, fr = lane & 15, fq = lane >> 4;
    const int K = g.K, nt = K / BK;
    unsigned voffA[2], voffB[2];
#pragma unroll
    for (int i = 0; i < 2; ++i) { int R, C; stage_rc(tid * 16 + i * 8192, R, C); const int Rb = Epi::PERM ? ((R & ~31) + perm32(R & 31)) : R;
        voffA[i] = (unsigned)(R * K + C) * 2u; voffB[i] = (unsigned)(Rb * K + C) * 2u; }
    const size_t kstep = (size_t)(BK * 2);
    const size_t hstep = (size_t)HALF * K * 2;
    const size_t tstep = 2 * hstep;
    const unsigned ldsw = (unsigned)wid * 1024u;
    const int aoff = lds_byte(wr * 64 + fr, fq * 8), boff = lds_byte(wc * 32 + fr, fq * 8);
#define PG8_SA(b, h) (((b) * 2 + (h)) * HTB)
#define PG8_SB(b, h) ((4 + (b) * 2 + (h)) * HTB)
#define PG8_STAGE(bufoff, gbase, voff) do { _Pragma("unroll") for (int _i = 0; _i < 2; ++_i) \
        __builtin_amdgcn_global_load_lds((const unsigned*)((const char*)(gbase) + (voff)[_i]), (PG8_LAS unsigned*)(lds + (bufoff) + ldsw + _i * 8192), 16, 0, 0); } while (0)
#define PG8_LDA(dst, b, h) do { _Pragma("unroll") for (int m = 0; m < 4; ++m) _Pragma("unroll") for (int k = 0; k < 2; ++k) dst[m][k] = *(const PG8_LAS bf16x8*)(lds + PG8_SA(b, h) + aoff + m * 2048 + k * 1024); } while (0)
#define PG8_LDB(dst, b, h) do { _Pragma("unroll") for (int n = 0; n < 2; ++n) _Pragma("unroll") for (int k = 0; k < 2; ++k) dst[n][k] = *(const PG8_LAS bf16x8*)(lds + PG8_SB(b, h) + boff + n * 2048 + k * 1024); } while (0)
#define PG8_MMA(ai, bj, At, Bt) do { __builtin_amdgcn_s_setprio(1); _Pragma("unroll") for (int m = 0; m < 4; ++m) _Pragma("unroll") for (int n = 0; n < 2; ++n) _Pragma("unroll") for (int k = 0; k < 2; ++k) \
        acc[ai][bj][m][n] = __builtin_amdgcn_mfma_f32_16x16x32_bf16(Bt[n][k], At[m][k], acc[ai][bj][m][n], 0, 0, 0); __builtin_amdgcn_s_setprio(0); } while (0)
#define PG8_WAIT_V(n) asm volatile("s_waitcnt vmcnt(" #n ")" ::: "memory")
#define PG8_WAIT_L(n) asm volatile("s_waitcnt lgkmcnt(" #n ")" ::: "memory")
#define PG8_BAR __builtin_amdgcn_s_barrier()
#define PG8_SCHED __builtin_amdgcn_sched_barrier(0)
    Unit cur, nxt; int ui = 0;
    if (!S.next(0, cur)) return;
    f32x4 acc[2][2][4][2];
#pragma unroll
    for (int a = 0; a < 2; ++a)
#pragma unroll
        for (int b = 0; b < 2; ++b)
#pragma unroll
            for (int m = 0; m < 4; ++m)
#pragma unroll
                for (int n = 0; n < 2; ++n) acc[a][b][m][n] = (f32x4){0.f, 0.f, 0.f, 0.f};
    bf16x8 At[4][2], B0[2][2], B1[2][2];
    const char* cA = (const char*)g.A + (size_t)cur.pm * tstep; const char* cB = (const char*)g.Bt + (size_t)cur.pn * tstep;
    S.a_ready(cur);
    if constexpr (SP2) {
        PG8_STAGE(PG8_SB(0, 0), cB, voffB); PG8_STAGE(PG8_SB(0, 1), cB + hstep, voffB); PG8_STAGE(PG8_SA(0, 0), cA, voffA); PG8_STAGE(PG8_SA(0, 1), cA + hstep, voffA);
        if (wr == 1) PG8_BAR;
        PG8_WAIT_V(2); PG8_BAR;
        PG8_STAGE(PG8_SB(1, 0), cB + kstep, voffB); PG8_STAGE(PG8_SA(1, 0), cA + kstep, voffA); PG8_STAGE(PG8_SB(1, 1), cB + hstep + kstep, voffB);
        PG8_WAIT_V(6); PG8_BAR;
    } else {
        PG8_STAGE(PG8_SB(0, 0), cB, voffB); PG8_STAGE(PG8_SA(0, 0), cA, voffA); PG8_STAGE(PG8_SB(0, 1), cB + hstep, voffB); PG8_STAGE(PG8_SA(0, 1), cA + hstep, voffA);
        if (wr == 1) PG8_BAR;
        PG8_WAIT_V(4); PG8_BAR;
        PG8_STAGE(PG8_SB(1, 0), cB + kstep, voffB); PG8_STAGE(PG8_SA(1, 0), cA + kstep, voffA); PG8_STAGE(PG8_SB(1, 1), cB + hstep + kstep, voffB);
        PG8_WAIT_V(6); PG8_BAR;
    }
    for (;;) {
        const bool has_next = S.next(ui + 1, nxt);
        const char* nA = has_next ? (const char*)g.A + (size_t)nxt.pm * tstep : cA; const char* nB = has_next ? (const char*)g.Bt + (size_t)nxt.pn * tstep : cB;
        for (int t = 0; t < nt; t += 2) {
            const bool last = (t == nt - 2);
            const char* a1 = cA + (size_t)(t + 1) * kstep;
            const char* a2 = last ? nA : cA + (size_t)(t + 2) * kstep; const char* b2 = last ? nB : cB + (size_t)(t + 2) * kstep;
            const char* a3 = a2 + kstep; const char* b3 = b2 + kstep;
            if (last && has_next) S.a_ready(nxt);
            if constexpr (SP2) {
            PG8_LDB(B0, 0, 0); PG8_LDB(B1, 0, 1); PG8_SCHED; PG8_LDA(At, 0, 0); PG8_STAGE(PG8_SA(1, 1), a1 + hstep, voffA);
            PG8_WAIT_V(8); PG8_WAIT_L(0); PG8_BAR; PG8_MMA(0, 0, At, B0); PG8_MMA(0, 1, At, B1); PG8_BAR; PG8_SCHED;
            PG8_LDA(At, 0, 1); PG8_STAGE(PG8_SB(0, 0), b2, voffB); PG8_STAGE(PG8_SB(0, 1), b2 + hstep, voffB); PG8_STAGE(PG8_SA(0, 0), a2, voffA);
            PG8_WAIT_V(8); PG8_WAIT_L(0); PG8_BAR; PG8_MMA(1, 0, At, B0); PG8_MMA(1, 1, At, B1); PG8_BAR; PG8_SCHED;
            PG8_LDB(B0, 1, 0); PG8_LDB(B1, 1, 1); PG8_SCHED; PG8_LDA(At, 1, 0); PG8_STAGE(PG8_SA(0, 1), a2 + hstep, voffA);
            PG8_WAIT_V(8); PG8_WAIT_L(0); PG8_BAR; PG8_MMA(0, 0, At, B0); PG8_MMA(0, 1, At, B1); PG8_BAR; PG8_SCHED;
            PG8_LDA(At, 1, 1); PG8_STAGE(PG8_SB(1, 0), b3, voffB); PG8_STAGE(PG8_SB(1, 1), b3 + hstep, voffB); PG8_STAGE(PG8_SA(1, 0), a3, voffA);
            PG8_WAIT_V(8); PG8_WAIT_L(0); PG8_BAR; PG8_MMA(1, 0, At, B0); PG8_MMA(1, 1, At, B1); PG8_BAR; PG8_SCHED;
            } else {
            PG8_LDB(B0, 0, 0); PG8_SCHED; PG8_LDA(At, 0, 0); PG8_STAGE(PG8_SA(1, 1), a1 + hstep, voffA);
            PG8_WAIT_L(8); PG8_BAR; PG8_WAIT_L(0); PG8_MMA(0, 0, At, B0); PG8_BAR; PG8_SCHED;
            PG8_LDB(B1, 0, 1); PG8_STAGE(PG8_SB(0, 0), b2, voffB);
            PG8_BAR; PG8_WAIT_L(0); PG8_MMA(0, 1, At, B1); PG8_BAR;
            PG8_LDA(At, 0, 1); PG8_STAGE(PG8_SA(0, 0), a2, voffA);
            PG8_BAR; PG8_WAIT_L(0); PG8_MMA(1, 0, At, B0); PG8_BAR; PG8_SCHED;
            PG8_STAGE(PG8_SB(0, 1), b2 + hstep, voffB);
            PG8_WAIT_V(6); PG8_BAR; PG8_MMA(1, 1, At, B1); PG8_BAR;
            PG8_LDB(B0, 1, 0); PG8_SCHED; PG8_LDA(At, 1, 0); PG8_STAGE(PG8_SA(0, 1), a2 + hstep, voffA);
            PG8_WAIT_L(8); PG8_BAR; PG8_WAIT_L(0); PG8_MMA(0, 0, At, B0); PG8_BAR; PG8_SCHED;
            PG8_LDB(B1, 1, 1); PG8_STAGE(PG8_SB(1, 0), b3, voffB);
            PG8_BAR; PG8_WAIT_L(0); PG8_MMA(0, 1, At, B1); PG8_BAR;
            PG8_LDA(At, 1, 1); PG8_STAGE(PG8_SA(1, 0), a3, voffA);
            PG8_BAR; PG8_WAIT_L(0); PG8_MMA(1, 0, At, B0); PG8_BAR; PG8_SCHED;
            PG8_STAGE(PG8_SB(1, 1), b3 + hstep, voffB);
            PG8_WAIT_V(6); PG8_BAR; PG8_MMA(1, 1, At, B1); PG8_BAR;
            }
        }
        if constexpr (ALIGN_EPI) { if (wr == 0) PG8_BAR; }
        if constexpr (!Epi::AFTER_DRAIN) { E(acc, cur, wr, wc, fr, fq); S.done(cur); }
        if (!has_next) break;
#pragma unroll
        for (int a = 0; a < 2; ++a)
#pragma unroll
            for (int b = 0; b < 2; ++b)
#pragma unroll
                for (int m = 0; m < 4; ++m)
#pragma unroll
                    for (int n = 0; n < 2; ++n) acc[a][b][m][n] = (f32x4){0.f, 0.f, 0.f, 0.f};
        cur = nxt; cA = nA; cB = nB; ++ui;
        if constexpr (ALIGN_EPI) { if (wr == 1) PG8_BAR; }
    }
    PG8_WAIT_V(0);
    if constexpr (!ALIGN_EPI) { if (wr == 0) PG8_BAR; }
    PG8_BAR;
    if constexpr (Epi::AFTER_DRAIN) { E.fused(acc, cur, wr, wc, fr, fq, lds, wid, lane); S.done(cur); }
#undef PG8_SA
#undef PG8_SB
#undef PG8_STAGE
#undef PG8_LDA
#undef PG8_LDB
#undef PG8_MMA
#undef PG8_WAIT_V
#undef PG8_WAIT_L
#undef PG8_BAR
#undef PG8_SCHED
}
}

constexpr int DM = 1024, NBATCH = 16, SEQ = 2048, MP = NBATCH * SEQ, NS = 128, MT = 33024  , MREAL = MP + NS;
constexpr int MMEM = 4096, MEMT = 256;
constexpr int QC = 768, KVL = 256, RD = 32, CCH = 512, NIN = 2304, FF = 4096, INC = 2080;
constexpr int NPG = 64;
constexpr float LN_EPS = 1e-5f;
constexpr float ALPHA = 1.189207115002721f;
constexpr float LOG2E = 1.4426950408889634f;
constexpr float QS_MLA = 0.10206207261596577f * LOG2E;
constexpr float QS_MEM = 0.0625f * LOG2E;
constexpr size_t O_YP = 0, O_YS = O_YP + (size_t)MP * DM, O_CKVP = O_YS + (size_t)NS * DM, O_KRP = O_CKVP + (size_t)MP * KVL, O_CONVP = O_KRP + (size_t)MP * RD,
                 O_MKP = O_CONVP + (size_t)NBATCH * 30 * CCH, O_MVP = O_MKP + (size_t)MMEM * DM, O_CKVS = O_MVP + (size_t)MMEM * DM, O_KRS = O_CKVS + (size_t)NS * KVL,
                 O_CONVS = O_KRS + (size_t)NS * RD, O_END = O_CONVS + (size_t)NS * 30 * CCH;
static_assert(O_END == 53760000, "output size");

constexpr size_t MiB = 1u << 20;
constexpr size_t WS_CTL = 0, CTL_ZERO_BYTES = 128 * 1024;
constexpr size_t WS_WIN = 2 * MiB;
constexpr size_t WS_WXKV = WS_WIN + (size_t)NIN * DM * 2;
constexpr size_t WS_WUKV = 11 * MiB, WS_WO = 12 * MiB, WS_WXQ = 14 * MiB, WS_WXO = 16 * MiB, WS_WUP = 18 * MiB, WS_WDN = 26 * MiB;
constexpr size_t WS_ROPE = 34 * MiB;
constexpr size_t WS_PART = 35 * MiB, WS_PML = 37 * MiB, WS_QLAT = 38 * MiB;
constexpr size_t WS_VEC = 39 * MiB;
constexpr int VO_CSQ = 0, VO_BWQ = 1024, VO_CSU = 2048, VO_BWU = 6144, VO_PCSQ = 10240, VO_PBWQ = VO_PCSQ + 16 * 1024, VO_PCSU = VO_PBWQ + 16 * 1024, VO_PBWU = VO_PCSU + 16 * 4096, VO_END = VO_PBWU + 16 * 4096;
static_assert(VO_END * 4 <= (int)MiB, "vector region");
constexpr size_t WS_XB = 40 * MiB;
constexpr size_t WS_Q = 113 * MiB, WS_CKV = 162 * MiB, WS_KR = 179 * MiB, WS_U = 182 * MiB, WS_KN = 215 * MiB, WS_VV = 247 * MiB, WS_MKB = 279 * MiB, WS_MVB = 287 * MiB;
constexpr size_t WS_AC = 295 * MiB, WS_V = 360 * MiB, WS_X1 = 489 * MiB, WS_X1B = 618 * MiB, WS_QX = 683 * MiB, WS_OX = 748 * MiB, WS_X2 = 813 * MiB, WS_X2B = 942 * MiB, WS_H = 1007 * MiB;
constexpr size_t WS_SL1 = 1266 * MiB, WS_SL2 = 1268 * MiB;
constexpr size_t WS_SSL1 = 1270 * MiB, WS_SSL2 = 1271 * MiB;
constexpr size_t WS_ZS = 1272 * MiB, WS_XCH = 1274 * MiB, WS_END = 1276 * MiB;
static_assert(WS_WXKV + (size_t)2048 * DM * 2 <= WS_WUKV && WS_XB + (size_t)(MT + MMEM) * DM * 2 <= WS_Q && WS_Q + (size_t)MT * QC * 2 <= WS_CKV && WS_CKV + (size_t)MT * KVL * 2 <= WS_KR &&
              WS_KR + (size_t)MT * RD * 2 <= WS_U && WS_U + (size_t)MT * CCH * 2 <= WS_KN && WS_AC + (size_t)MT * DM * 2 <= WS_V && WS_V + (size_t)MT * DM * 4 <= WS_X1 && WS_X1 + (size_t)MT * DM * 4 <= WS_X1B &&
              WS_X1B + (size_t)MT * DM * 2 <= WS_QX && WS_X2 + (size_t)MT * DM * 4 <= WS_X2B && WS_H + (size_t)MT * FF * 2 <= WS_END, "d_ws map");
constexpr int CW_TMO = 0, CW_CODE = 1, CW_BAR = 4096, CW_CMB = 8192  , CW_SKG = 9216  , CW_SKD = 10240  , CW_SRW = 11264  , CW_SEAM = 16384;

constexpr int RING_OFF = 0, RING_BYTES = 131072;
constexpr int XL_OFF = 131072;
constexpr int LDS_BYTES = 147456, MISC_OFF = LDS_BYTES - 128;
constexpr int NWAVES = 8;

#define GAS __attribute__((address_space(1)))
#define LAS __attribute__((address_space(3)))
typedef unsigned short bf16;
typedef unsigned v4u __attribute__((ext_vector_type(4)));
typedef unsigned v2u __attribute__((ext_vector_type(2)));
typedef float f32x4 __attribute__((ext_vector_type(4)));
typedef float f32x2 __attribute__((ext_vector_type(2)));
typedef float f32x16 __attribute__((ext_vector_type(16)));
typedef short bf16x8 __attribute__((ext_vector_type(8)));
typedef short s16x4 __attribute__((ext_vector_type(4)));
typedef __bf16 bf16x2_t __attribute__((ext_vector_type(2)));
typedef GAS unsigned gu32;
#define RLX_AGENT __ATOMIC_RELAXED, __HIP_MEMORY_SCOPE_AGENT
#define LDS_WAIT() asm volatile("s_waitcnt lgkmcnt(0)" ::: "memory")
#define VM_WAIT() asm volatile("s_waitcnt vmcnt(0)" ::: "memory")
__device__ __forceinline__ unsigned pk2(float lo, float hi) { f32x2 v = {lo, hi}; bf16x2_t b = __builtin_convertvector(v, bf16x2_t); return __builtin_bit_cast(unsigned, b); }
__device__ __forceinline__ float bf2f(unsigned short h) { return __builtin_bit_cast(float, (unsigned)h << 16); }
__device__ __forceinline__ float bflo(unsigned w) { return __builtin_bit_cast(float, w << 16); }
__device__ __forceinline__ float bfhi(unsigned w) { return __builtin_bit_cast(float, w & 0xffff0000u); }
__device__ __forceinline__ float ex2(float x) { return __builtin_amdgcn_exp2f(x); }
__device__ __forceinline__ float wave_sum(float v) {
#pragma unroll
    for (int o = 1; o < 64; o <<= 1) v += __shfl_xor(v, o);
    return v;
}
__device__ __forceinline__ float wave_max(float v) {
#pragma unroll
    for (int o = 1; o < 64; o <<= 1) v = fmaxf(v, __shfl_xor(v, o));
    return v;
}
__device__ __forceinline__ s16x4 tr_read(const LAS unsigned char* p) { return __builtin_bit_cast(s16x4, __builtin_amdgcn_ds_read_tr16_b64_v4i16((LAS s16x4*)p)); }

#define XB_TMO      128
#define XB_XCNT(j)  (256  + 64 * (j))
#define XB_XSUB(j)  (1280 + 64 * (j))
#define XB_XGEN(j)  (2304 + 64 * (j))
#define XB_TOP      3328
#define XB_TOPGEN   3392
#define XCD_BAR_WORDS 3456
#define XB_SPIN_CAP (1u << 18)

__device__ __forceinline__ unsigned xb_ld(unsigned* p)              { return __hip_atomic_load(p, __ATOMIC_RELAXED, __HIP_MEMORY_SCOPE_AGENT); }
__device__ __forceinline__ unsigned xb_add(unsigned* p, unsigned v) { return __hip_atomic_fetch_add(p, v, __ATOMIC_RELAXED, __HIP_MEMORY_SCOPE_AGENT); }
__device__ __forceinline__ unsigned xb_xcc_id() { return (unsigned)__builtin_amdgcn_s_getreg((3 << 11) | 20) & 0xFu; }
#define XB_SPIN(cond, bar) do { unsigned _sp = 0; while (cond) { __builtin_amdgcn_s_sleep(1); \
    if ((++_sp & 255u) == 0u) { if (xb_ld(&(bar)[XB_TMO])) break; if (_sp > XB_SPIN_CAP) { atomicAdd(&(bar)[XB_TMO], 1u); break; } } } } while (0)

struct XcdBarrier {
    unsigned* bar; unsigned x;
    volatile LAS unsigned* st;
};

__device__ __forceinline__ XcdBarrier xcd_barrier_post(unsigned* bar, volatile LAS unsigned* st) {
    XcdBarrier b; b.bar = bar; b.x = xb_xcc_id(); b.st = st;
    if (threadIdx.x == 0) (void)xb_add(&bar[XB_XCNT(b.x)], 1u);
    return b;
}
__device__ __forceinline__ void xcd_barrier_complete(unsigned* bar, unsigned x, unsigned& nloc, unsigned& nx) {
    const unsigned G = gridDim.x * gridDim.y * gridDim.z;
    unsigned sum, cnt, mine, sp = 0u;
    for (;;) {
        sum = 0u; cnt = 0u; mine = 0u;
#pragma unroll
        for (unsigned j = 0; j < 16; ++j) { const unsigned c = xb_ld(&bar[XB_XCNT(j)]); sum += c; cnt += (c > 0u) ? 1u : 0u; mine = (j == x) ? c : mine; }
        if (sum == G) break;
        __builtin_amdgcn_s_sleep(1);
        if ((++sp & 255u) == 0u) { if (xb_ld(&bar[XB_TMO])) break; if (sp > XB_SPIN_CAP) { atomicAdd(&bar[XB_TMO], 1u); break; } }
    }
    nloc = mine > 0u ? mine : 1u; nx = cnt > 0u ? cnt : 1u;
}

__device__ __forceinline__ void xcd_barrier(const XcdBarrier& b) {
    asm volatile("s_waitcnt vmcnt(0)" ::: "memory");
    __syncthreads();
    if (threadIdx.x == 0) {
        unsigned* bar = b.bar;
        __builtin_amdgcn_s_waitcnt(0);
        unsigned nloc = b.st[0], nx = b.st[1];
        if (nloc == 0u) { xcd_barrier_complete(bar, b.x, nloc, nx); b.st[0] = nloc; b.st[1] = nx; }
        const unsigned old = xb_add(&bar[XB_XSUB(b.x)], 1u);
        const unsigned gen = old / nloc;
        if (old + 1u == (gen + 1u) * nloc) {
            __builtin_amdgcn_fence(__ATOMIC_RELEASE, "agent");
            asm volatile("s_waitcnt vmcnt(0)" ::: "memory");
            const unsigned og = xb_add(&bar[XB_TOP], 1u);
            const unsigned tg = og / nx;
            if (og + 1u == (tg + 1u) * nx) xb_add(&bar[XB_TOPGEN], 1u);
            else XB_SPIN(xb_ld(&bar[XB_TOPGEN]) == tg, bar);
            __builtin_amdgcn_fence(__ATOMIC_ACQUIRE, "agent");
            xb_add(&bar[XB_XGEN(b.x)], 1u);
            asm volatile("s_waitcnt vmcnt(0)" ::: "memory");
        } else {
            XB_SPIN(xb_ld(&bar[XB_XGEN(b.x)]) == gen, bar);
            __builtin_amdgcn_fence(__ATOMIC_ACQUIRE, "agent");
            asm volatile("s_waitcnt vmcnt(0)" ::: "memory");
        }
    }
    __syncthreads();
}

struct Args { const float* in[30]; float* out; unsigned char* ws; int ph_lo, ph_hi; };
static_assert(sizeof(Args) == 30 * 8 + 8 + 8 + 8, "Args has no padding");
enum { I_XP = 0, I_XS, I_CKV, I_KROPE, I_SCONV, I_MEMK, I_MEMV, I_PT, I_MEMP, I_WIN, I_KVG, I_WUK, I_WUV, I_CONVW, I_CONVB, I_CLNG, I_CLNB, I_WO, I_LN1G, I_LN1B,
       I_WXQ, I_WXK, I_WXV, I_WXO, I_LN2G, I_LN2B, I_WUP, I_WDN, I_LN3G, I_LN3B };
struct Frame {
    LAS unsigned char* lds;
    volatile LAS unsigned* MISC;
    gu32* ctl;
    int tid, lane, wave, vcu, G;
};

__device__ __forceinline__ void xcd_arrive(const XcdBarrier& b) {
    asm volatile("s_waitcnt vmcnt(0)" ::: "memory");
    __syncthreads();
    if (threadIdx.x == 0) {
        unsigned* bar = b.bar;
        __builtin_amdgcn_s_waitcnt(0);
        unsigned nloc = b.st[0], nx = b.st[1];
        if (nloc == 0u) { xcd_barrier_complete(bar, b.x, nloc, nx); b.st[0] = nloc; b.st[1] = nx; }
        const unsigned old = xb_add(&bar[XB_XSUB(b.x)], 1u);
        const unsigned gen = old / nloc;
        if (old + 1u == (gen + 1u) * nloc) {
            __builtin_amdgcn_fence(__ATOMIC_RELEASE, "agent");
            asm volatile("s_waitcnt vmcnt(0)" ::: "memory");
            const unsigned og = xb_add(&bar[XB_TOP], 1u);
            const unsigned tg = og / nx;
            if (og + 1u == (tg + 1u) * nx) xb_add(&bar[XB_TOPGEN], 1u);
            else XB_SPIN(xb_ld(&bar[XB_TOPGEN]) == tg, bar);
            __builtin_amdgcn_fence(__ATOMIC_ACQUIRE, "agent");
            xb_add(&bar[XB_XGEN(b.x)], 1u);
            asm volatile("s_waitcnt vmcnt(0)" ::: "memory");
            b.st[2] = 0xffffffffu;
        } else b.st[2] = gen;
    }
}
__device__ __forceinline__ void xcd_wait(const XcdBarrier& b) {
    if (threadIdx.x == 0) {
        unsigned* bar = b.bar; const unsigned gen = b.st[2];
        if (gen != 0xffffffffu) { XB_SPIN(xb_ld(&bar[XB_XGEN(b.x)]) == gen, bar); __builtin_amdgcn_fence(__ATOMIC_ACQUIRE, "agent"); asm volatile("s_waitcnt vmcnt(0)" ::: "memory"); }
    }
    __syncthreads();
}
__device__ __forceinline__ void st_wt8(void* p, unsigned lo, unsigned hi) { __hip_atomic_store((unsigned long long*)p, ((unsigned long long)hi << 32) | lo, __ATOMIC_RELAXED, __HIP_MEMORY_SCOPE_AGENT); }
__device__ __forceinline__ void st_bf4_wt(bf16* p, f32x4 v) { st_wt8(p, pk2(v[0], v[1]), pk2(v[2], v[3])); }
__device__ __forceinline__ void st_wt16(float* p, f32x4 v) { asm volatile("global_store_dwordx4 %0, %1, off sc1" :: "v"(p), "v"(v) : "memory"); }
__device__ __forceinline__ void wait_count(Frame& F, gu32* cnt, unsigned n) {
    if (F.wave == 0) {
        unsigned sp = 0u; while ((unsigned)__builtin_amdgcn_readfirstlane((int)__hip_atomic_load(cnt, RLX_AGENT)) < n) { __builtin_amdgcn_s_sleep(1); if (++sp > (1u << 22)) break; }
        __builtin_amdgcn_fence(__ATOMIC_ACQUIRE, "agent"); asm volatile("s_waitcnt vmcnt(0)" ::: "memory"); }
    __syncthreads();
}

template <bool FOLD>
__device__ __forceinline__ void transpose_item(const float* W, int N, int K, bf16* WT, int k0, int n0, int dst_row0, LAS float* scr, int lane, const float* g = nullptr, const float* b = nullptr, float* pcs = nullptr, float* pbw = nullptr) {
    float pc = 0.f, pb = 0.f;
#pragma unroll 8
    for (int i = 0; i < 32; ++i) { const int kk = 2 * i + (lane >> 5); float v = W[(size_t)(k0 + kk) * N + n0 + (lane & 31)];
        if (FOLD) { pb += v * b[k0 + kk]; v *= g[k0 + kk]; pc += v; }
        scr[kk * 33 + (lane & 31)] = v; }
    if (FOLD) { pc += __shfl_xor(pc, 32); pb += __shfl_xor(pb, 32); if (lane < 32) { pcs[n0 + lane] = pc; pbw[n0 + lane] = pb; } }
    LDS_WAIT(); asm volatile("" ::: "memory");
    const int c = lane & 7;
#pragma unroll
    for (int j = 0; j < 4; ++j) { const int n = (lane >> 3) + 8 * j; const LAS float* s = scr + (8 * c) * 33 + n;
        v4u o; o.x = pk2(s[0 * 33], s[1 * 33]); o.y = pk2(s[2 * 33], s[3 * 33]); o.z = pk2(s[4 * 33], s[5 * 33]); o.w = pk2(s[6 * 33], s[7 * 33]);
        *(GAS v4u*)(WT + (size_t)(dst_row0 + n) * K + k0 + 8 * c) = o; }
    LDS_WAIT(); asm volatile("" ::: "memory");
}
__device__ __forceinline__ int win_dst_row(int n0) {
    if (n0 < 1024) return n0;
    if (n0 < 1056) return 2048 + (n0 - 1024);
    if (n0 < 1568) { const int a = n0 - 1056; return 1024 + 256 * (a >> 7) + (a & 127); }
    const int g = n0 - 1568; return 1024 + 256 * (g >> 7) + 128 + (g & 127);
}
__device__ __forceinline__ void p0_prologue(Frame& F, const Args& a) {
    LAS float* scr = (LAS float*)(F.lds + F.wave * 16384);
    const int gw = F.vcu * NWAVES + F.wave, NGW = F.G * NWAVES;
    unsigned char* ws = a.ws; float* vec = (float*)(ws + WS_VEC);
    constexpr int C0 = 1040, C1 = C0 + 512, C2 = C1 + 512, C3 = C2 + 64, C4 = C3 + 64, C5 = C4 + 512, C6 = C5 + 512, C7 = C6 + 512, C8 = C7 + 2048, C9 = C8 + 2048;
    for (int it = gw; it < C9; it += NGW) {
        if (it < C0) { const int kb = it / 65, nb = it % 65; transpose_item<false>(a.in[I_WIN], INC, DM, (bf16*)(ws + WS_WIN), kb * 64, nb * 32, win_dst_row(nb * 32), scr, F.lane); }
        else if (it < C1) { const int r = it - C0; transpose_item<false>(a.in[I_WXK], DM, DM, (bf16*)(ws + WS_WXKV), (r >> 5) * 64, (r & 31) * 32, (r & 31) * 32, scr, F.lane); }
        else if (it < C2) { const int r = it - C1; transpose_item<false>(a.in[I_WXV], DM, DM, (bf16*)(ws + WS_WXKV), (r >> 5) * 64, (r & 31) * 32, 1024 + (r & 31) * 32, scr, F.lane); }
        else if (it < C3) { const int r = it - C2; transpose_item<false>(a.in[I_WUK], 512, KVL, (bf16*)(ws + WS_WUKV), (r >> 4) * 64, (r & 15) * 32, (r & 15) * 32, scr, F.lane); }
        else if (it < C4) { const int r = it - C3; transpose_item<false>(a.in[I_WUV], 512, KVL, (bf16*)(ws + WS_WUKV), (r >> 4) * 64, (r & 15) * 32, 512 + (r & 15) * 32, scr, F.lane); }
        else if (it < C5) { const int r = it - C4; transpose_item<false>(a.in[I_WO], DM, DM, (bf16*)(ws + WS_WO), (r >> 5) * 64, (r & 31) * 32, (r & 31) * 32, scr, F.lane); }
        else if (it < C6) { const int r = it - C5; transpose_item<true>(a.in[I_WXQ], DM, DM, (bf16*)(ws + WS_WXQ), (r >> 5) * 64, (r & 31) * 32, (r & 31) * 32, scr, F.lane, a.in[I_LN1G], a.in[I_LN1B], vec + VO_PCSQ + (r >> 5) * 1024, vec + VO_PBWQ + (r >> 5) * 1024); }
        else if (it < C7) { const int r = it - C6; transpose_item<false>(a.in[I_WXO], DM, DM, (bf16*)(ws + WS_WXO), (r >> 5) * 64, (r & 31) * 32, (r & 31) * 32, scr, F.lane); }
        else if (it < C8) { const int r = it - C7; transpose_item<true>(a.in[I_WUP], FF, DM, (bf16*)(ws + WS_WUP), (r >> 7) * 64, (r & 127) * 32, (r & 127) * 32, scr, F.lane, a.in[I_LN2G], a.in[I_LN2B], vec + VO_PCSU + (r >> 7) * 4096, vec + VO_PBWU + (r >> 7) * 4096); }
        else { const int r = it - C8; transpose_item<false>(a.in[I_WDN], DM, FF, (bf16*)(ws + WS_WDN), (r >> 5) * 64, (r & 31) * 32, (r & 31) * 32, scr, F.lane); }
    }
    { GAS v4u* z = (GAS v4u*)(ws + WS_WIN + (size_t)INC * DM * 2); const int n16 = (NIN - INC) * DM * 2 / 16;
      for (int i = F.vcu * 512 + F.tid; i < n16; i += F.G * 512) z[i] = (v4u){0u, 0u, 0u, 0u}; }
    bf16* XB = (bf16*)(ws + WS_XB);
    for (int rbase = gw; rbase < MT + MMEM; rbase += 4 * NGW) {
        f32x4 v[4][4];
#pragma unroll
        for (int q = 0; q < 4; ++q) { const int r = rbase + q * NGW;
            if (r < MT + MMEM && !(r >= MREAL && r < MT)) {
                const float* src = r < MP ? a.in[I_XP] + (size_t)r * DM : (r < MREAL ? a.in[I_XS] + (size_t)(r - MP) * DM : a.in[I_MEMP] + (size_t)(r - MT) * DM);
                const GAS f32x4* xr = (const GAS f32x4*)src + F.lane;
#pragma unroll
                for (int j = 0; j < 4; ++j) v[q][j] = xr[64 * j]; }
            else {
#pragma unroll
                for (int j = 0; j < 4; ++j) v[q][j] = (f32x4){0.f, 0.f, 0.f, 0.f}; } }
#pragma unroll
        for (int q = 0; q < 4; ++q) { const int r = rbase + q * NGW; if (r < MT + MMEM) { GAS unsigned long long* o8 = (GAS unsigned long long*)(XB + (size_t)r * DM) + F.lane;
#pragma unroll
            for (int j = 0; j < 4; ++j) o8[64 * j] = (unsigned long long)pk2(v[q][j].x, v[q][j].y) | ((unsigned long long)pk2(v[q][j].z, v[q][j].w) << 32); } }
    }
    float* rope = (float*)(ws + WS_ROPE);
    for (int idx = F.vcu * 512 + F.tid; idx < 2049 * 16; idx += F.G * 512) {
        const int p = idx >> 4, i = idx & 15; const double pos = (p == 2048) ? 8192.0 : (double)p;
        double f = 1.0; for (int k = 0; k < i; ++k) f *= 0.5623413251903491;
        const double x = pos * f; const double kq = __builtin_rint(x * 0.6366197723675814);
        double y = __builtin_fma(-kq, 1.5707963267948966, x); y = __builtin_fma(-kq, 6.123233995736766e-17, y);
        const int q = (int)((long long)kq & 3ll); const double y2 = y * y;
        const double sn = y * (1.0 + y2 * (-1.0 / 6 + y2 * (1.0 / 120 + y2 * (-1.0 / 5040 + y2 * (1.0 / 362880 + y2 * (-1.0 / 39916800 + y2 * (1.0 / 6227020800.0 + y2 * (-1.0 / 1307674368000.0))))))));
        const double cs = 1.0 + y2 * (-0.5 + y2 * (1.0 / 24 + y2 * (-1.0 / 720 + y2 * (1.0 / 40320 + y2 * (-1.0 / 3628800 + y2 * (1.0 / 479001600.0 + y2 * (-1.0 / 87178291200.0 + y2 * (1.0 / 20922789888000.0))))))));
        const double s = (q == 0) ? sn : (q == 1) ? cs : (q == 2) ? -sn : -cs;
        const double c = (q == 0) ? cs : (q == 1) ? -sn : (q == 2) ? -cs : sn;
        rope[p * 32 + i] = (float)c; rope[p * 32 + 16 + i] = (float)s;
    }
}

struct InOrder {
    pg8::StaticOrder s1, s2; int G, c;
    __device__ __forceinline__ void init(int G_, int c_) { s1.init(MP, NIN, 1, 0); s2.init(MMEM, 2048, 1, 0); G = G_; c = c_; }
    __device__ __forceinline__ bool next(int i, pg8::Unit& u) const {
        const int L = i * G + c;
        if (L < s1.nwg) return s1.next(L, u);
        if (!s2.next(L - s1.nwg, u)) return false;
        u.pm += MT / 256; u.pn += NIN / 256; return true;
    }
    __device__ __forceinline__ void a_ready(const pg8::Unit&) const {}
    __device__ __forceinline__ void done(const pg8::Unit&) const {}
};

__device__ __forceinline__ void st_bf4(bf16* p, f32x4 v) { v2u w; w.x = pk2(v[0], v[1]); w.y = pk2(v[2], v[3]); *(v2u*)p = w; }

struct EpiIn {
    static constexpr bool PERM = false, AFTER_DRAIN = false;
    bf16 *Q, *CKV, *KR, *U, *MKB, *MVB; float* out; const float* rope; const float* kvg; LAS float* xl;
    __device__ __forceinline__ void operator()(const pg8::f32x4 (&acc)[2][2][4][2], const pg8::Unit& u, int wr, int wc, int fr, int fq) const {
        const int row0 = u.pm * 256 + wr * 64 + fr;
        if (u.pm >= MT / 256) {
            const int cb = (u.pn - NIN / 256) * 256; const bool isv = cb >= 1024; const int c0 = (isv ? cb - 1024 : cb) + wc * 32 + 4 * fq;
            float* of = out + (isv ? O_MVP : O_MKP); bf16* ob = isv ? MVB : MKB;
#pragma unroll
            for (int ai = 0; ai < 2; ++ai)
#pragma unroll
                for (int m = 0; m < 4; ++m) { const size_t ro = (size_t)(row0 - MT + ai * 128 + m * 16) * DM;
#pragma unroll
                    for (int bj = 0; bj < 2; ++bj)
#pragma unroll
                        for (int n = 0; n < 2; ++n) { const int c = c0 + bj * 128 + n * 16; const f32x4 v = acc[ai][bj][m][n]; *(f32x4*)(of + ro + c) = v; st_bf4(ob + ro + c, v); } }
        } else if (u.pn < 3) {
#pragma unroll
            for (int bj = 0; bj < 2; ++bj) { const int grp = u.pn * 8 + bj * 4 + wc; const bool isr = (grp % 3) == 2; const int colb = grp * 32 + 4 * fq;
#pragma unroll
                for (int ai = 0; ai < 2; ++ai)
#pragma unroll
                    for (int m = 0; m < 4; ++m) { const int row = row0 + ai * 128 + m * 16; f32x4 v0 = acc[ai][bj][m][0], v1 = acc[ai][bj][m][1];
                        if (isr) { const int pidx = row >= MP ? 2048 : (row & 2047); const f32x4 cs = *(const f32x4*)(rope + pidx * 32 + 4 * fq), sn = *(const f32x4*)(rope + pidx * 32 + 16 + 4 * fq);
                            const f32x4 o0 = v0 * cs - v1 * sn, o1 = v1 * cs + v0 * sn; v0 = o0; v1 = o1; }
                        st_bf4(Q + (size_t)row * QC + colb, v0 * QS_MLA); st_bf4(Q + (size_t)row * QC + colb + 16, v1 * QS_MLA); } }
        } else if (u.pn == 3) {
#pragma unroll
            for (int ai = 0; ai < 2; ++ai)
#pragma unroll
                for (int m = 0; m < 4; ++m) { float ss = 0.f;
#pragma unroll
                    for (int bj = 0; bj < 2; ++bj)
#pragma unroll
                        for (int n = 0; n < 2; ++n) { const f32x4 v = acc[ai][bj][m][n]; ss += (v[0] * v[0] + v[1] * v[1]) + (v[2] * v[2] + v[3] * v[3]); }
                    ss += __shfl_xor(ss, 16); ss += __shfl_xor(ss, 32);
                    if (fq == 0) xl[(ai * 128 + wr * 64 + m * 16 + fr) * 4 + wc] = ss; }
            asm volatile("s_waitcnt lgkmcnt(0)" ::: "memory"); __builtin_amdgcn_s_barrier(); asm volatile("" ::: "memory");
#pragma unroll
            for (int ai = 0; ai < 2; ++ai)
#pragma unroll
                for (int m = 0; m < 4; ++m) { const int rl = ai * 128 + wr * 64 + m * 16 + fr, row = u.pm * 256 + rl; const f32x4 p = *(const LAS f32x4*)(xl + rl * 4);
                    const float rs = 1.0f / sqrtf(((p[0] + p[1]) + (p[2] + p[3])) * (1.0f / 256.0f) + LN_EPS);
                    float* of = row < MP ? out + O_CKVP + (size_t)row * KVL : out + O_CKVS + (size_t)(row - MP) * KVL;
#pragma unroll
                    for (int bj = 0; bj < 2; ++bj)
#pragma unroll
                        for (int n = 0; n < 2; ++n) { const int c = bj * 128 + wc * 32 + n * 16 + 4 * fq; const f32x4 o = acc[ai][bj][m][n] * rs * *(const f32x4*)(kvg + c);
                            st_bf4(CKV + (size_t)row * KVL + c, o); if (row < MREAL) *(f32x4*)(of + c) = o; } }
            asm volatile("s_waitcnt lgkmcnt(0)" ::: "memory"); __builtin_amdgcn_s_barrier(); asm volatile("" ::: "memory");
        } else if (u.pn < 8) {
            const int cb = (u.pn - 4) * 128 + wc * 32 + 4 * fq;
#pragma unroll
            for (int ai = 0; ai < 2; ++ai)
#pragma unroll
                for (int m = 0; m < 4; ++m) { const int row = row0 + ai * 128 + m * 16, t = row & 2047;
#pragma unroll
                    for (int n = 0; n < 2; ++n) { const f32x4 av = acc[ai][0][m][n], gv = acc[ai][1][m][n]; f32x4 o;
#pragma unroll
                        for (int j = 0; j < 4; ++j) o[j] = av[j] / (1.0f + __expf(-gv[j]));
                        const int c = cb + n * 16; st_bf4(U + (size_t)row * CCH + c, o);
                        if (row < MP) { if (t >= SEQ - 30) *(f32x4*)(out + O_CONVP + ((size_t)(row >> 11) * 30 + (t - (SEQ - 30))) * CCH + c) = o; }
                        else if (row < MREAL) *(f32x4*)(out + O_CONVS + ((size_t)(row - MP) * 30 + 29) * CCH + c) = o; } }
        } else {
            if (wc == 0) {
#pragma unroll
                for (int ai = 0; ai < 2; ++ai)
#pragma unroll
                    for (int m = 0; m < 4; ++m) { const int row = row0 + ai * 128 + m * 16; const f32x4 v0 = acc[ai][0][m][0], v1 = acc[ai][0][m][1];
                        const int pidx = row >= MP ? 2048 : (row & 2047); const f32x4 cs = *(const f32x4*)(rope + pidx * 32 + 4 * fq), sn = *(const f32x4*)(rope + pidx * 32 + 16 + 4 * fq);
                        const f32x4 o0 = v0 * cs - v1 * sn, o1 = v1 * cs + v0 * sn;
                        st_bf4(KR + (size_t)row * RD + 4 * fq, o0); st_bf4(KR + (size_t)row * RD + 16 + 4 * fq, o1);
                        if (row < MREAL) { float* of = row < MP ? out + O_KRP + (size_t)row * RD : out + O_KRS + (size_t)(row - MP) * RD; *(f32x4*)(of + 4 * fq) = o0; *(f32x4*)(of + 16 + 4 * fq) = o1; } }
            }
        }
    }
};

template <int ACT  > struct EpiB {
    static constexpr bool PERM = true, AFTER_DRAIN = false;
    bf16* O; int ldc; int split_cols; size_t split_stride; float scale;
    __device__ __forceinline__ void operator()(const pg8::f32x4 (&acc)[2][2][4][2], const pg8::Unit& u, int wr, int wc, int fr, int fq) const {
        const int row0 = u.pm * 256 + wr * 64 + fr; int colt = u.pn * 256; bf16* base = O;
        if (split_cols) { const int t = colt / split_cols; base += (size_t)t * split_stride; colt -= t * split_cols; }
        const int col0 = colt + wc * 32 + 8 * fq;
#pragma unroll
        for (int ai = 0; ai < 2; ++ai)
#pragma unroll
            for (int m = 0; m < 4; ++m) { bf16* rowp = base + (size_t)(row0 + ai * 128 + m * 16) * ldc + col0;
#pragma unroll
                for (int bj = 0; bj < 2; ++bj) { f32x4 v0 = acc[ai][bj][m][0], v1 = acc[ai][bj][m][1];
                    if (ACT == 1) {
#pragma unroll
                        for (int j = 0; j < 4; ++j) { const float a0 = fmaxf(v0[j], 0.f), a1 = fmaxf(v1[j], 0.f); v0[j] = a0 * a0; v1[j] = a1 * a1; } }
                    v0 = v0 * scale; v1 = v1 * scale; v4u w; w.x = pk2(v0[0], v0[1]); w.y = pk2(v0[2], v0[3]); w.z = pk2(v1[0], v1[1]); w.w = pk2(v1[2], v1[3]);
                    *(v4u*)(rowp + bj * 128) = w; } }
    }
};
__device__ __forceinline__ f32x2 row_stats4(const float* slot, int row) {
    const f32x4 a = *(const f32x4*)(slot + (size_t)row * 8), b = *(const f32x4*)(slot + (size_t)row * 8 + 4);
    const float mean = ((a[0] + a[2]) + (b[0] + b[2])) * (1.0f / DM), var = ((a[1] + a[3]) + (b[1] + b[3])) * (1.0f / DM) - mean * mean;
    return (f32x2){mean, 1.0f / sqrtf(var + LN_EPS)};
}
template <int MODE, int GRP  > struct EpiV {
    static constexpr bool PERM = true, AFTER_DRAIN = false;
    bf16* VB; float* slot; const bf16* r0; const float* pslot; const float* pg; const float* pb; LAS float* xl;
    __device__ __forceinline__ void operator()(const pg8::f32x4 (&acc)[2][2][4][2], const pg8::Unit& u, int wr, int wc, int fr, int fq) const {
        const int row0 = u.pm * 256 + wr * 64 + fr, col0 = u.pn * 256 + wc * 32 + 8 * fq;
        f32x4 gv[2][2], bv[2][2];
        if (MODE == 1) {
#pragma unroll
            for (int bj = 0; bj < 2; ++bj)
#pragma unroll
                for (int n = 0; n < 2; ++n) { gv[bj][n] = *(const f32x4*)(pg + col0 + bj * 128 + 4 * n); bv[bj][n] = *(const f32x4*)(pb + col0 + bj * 128 + 4 * n); } }
#pragma unroll
        for (int am = 0; am < 8 / GRP; ++am) {
            v4u rws[GRP][2]; f32x2 sts[GRP];
#pragma unroll
            for (int mm = 0; mm < GRP; ++mm) { const int ai = (am * GRP + mm) >> 2, m = (am * GRP + mm) & 3; const int row = row0 + ai * 128 + m * 16; const size_t ro = (size_t)row * DM + col0;
                rws[mm][0] = *(const v4u*)(r0 + ro); rws[mm][1] = *(const v4u*)(r0 + ro + 128);
                sts[mm] = (f32x2){0.f, 0.f}; if (MODE == 1) sts[mm] = row_stats4(pslot, row); }
#pragma unroll
            for (int mm = 0; mm < GRP; ++mm) { const int ai = (am * GRP + mm) >> 2, m = (am * GRP + mm) & 3; const int row = row0 + ai * 128 + m * 16; const size_t ro = (size_t)row * DM + col0; float s1 = 0.f, s2 = 0.f;
                const f32x2 st = sts[mm];
#pragma unroll
                for (int bj = 0; bj < 2; ++bj) { const v4u rw = rws[mm][bj];
                    f32x4 ra = (f32x4){bflo(rw.x), bfhi(rw.x), bflo(rw.y), bfhi(rw.y)}, rb = (f32x4){bflo(rw.z), bfhi(rw.z), bflo(rw.w), bfhi(rw.w)};
                    if (MODE == 1) { const float nm = -st[0] * st[1]; ra = (ra * st[1] + nm) * gv[bj][0] + bv[bj][0]; rb = (rb * st[1] + nm) * gv[bj][1] + bv[bj][1]; }
                    const f32x4 v0 = acc[ai][bj][m][0] + ALPHA * ra, v1 = acc[ai][bj][m][1] + ALPHA * rb;
                    v4u w; w.x = pk2(v0[0], v0[1]); w.y = pk2(v0[2], v0[3]); w.z = pk2(v1[0], v1[1]); w.w = pk2(v1[2], v1[3]); *(v4u*)(VB + ro + bj * 128) = w;
                    s1 += ((v0[0] + v0[1]) + (v0[2] + v0[3])) + ((v1[0] + v1[1]) + (v1[2] + v1[3]));
                    s2 += ((v0[0] * v0[0] + v0[1] * v0[1]) + (v0[2] * v0[2] + v0[3] * v0[3])) + ((v1[0] * v1[0] + v1[1] * v1[1]) + (v1[2] * v1[2] + v1[3] * v1[3])); }
                if (slot) { s1 += __shfl_xor(s1, 16); s1 += __shfl_xor(s1, 32); s2 += __shfl_xor(s2, 16); s2 += __shfl_xor(s2, 32);
                    if (fq == 0) *(LAS f32x2*)(xl + ((ai * 128 + wr * 64 + m * 16 + fr) * 4 + wc) * 2) = (f32x2){s1, s2}; } } }
        if (slot) {
            asm volatile("s_waitcnt lgkmcnt(0)" ::: "memory"); __builtin_amdgcn_s_barrier(); asm volatile("" ::: "memory");
            if (wc == 0 && fq == 0) {
#pragma unroll
                for (int ai = 0; ai < 2; ++ai)
#pragma unroll
                    for (int m = 0; m < 4; ++m) { const int rl = ai * 128 + wr * 64 + m * 16 + fr; const f32x4 a = *(const LAS f32x4*)(xl + rl * 8), b = *(const LAS f32x4*)(xl + rl * 8 + 4);
                        *(f32x2*)(slot + ((size_t)(u.pm * 256 + rl) * 4 + u.pn) * 2) = (f32x2){(a[0] + a[2]) + (b[0] + b[2]), (a[1] + a[3]) + (b[1] + b[3])}; } }
            asm volatile("s_waitcnt lgkmcnt(0)" ::: "memory"); __builtin_amdgcn_s_barrier(); asm volatile("" ::: "memory");
        }
    }
};
template <int ACT  > struct EpiFold {
    static constexpr bool PERM = true, AFTER_DRAIN = false;
    bf16* O; int ldc; const float* pslot; const float* cs; const float* bw; float scale;
    __device__ __forceinline__ void operator()(const pg8::f32x4 (&acc)[2][2][4][2], const pg8::Unit& u, int wr, int wc, int fr, int fq) const {
        const int row0 = u.pm * 256 + wr * 64 + fr, col0 = u.pn * 256 + wc * 32 + 8 * fq;
        f32x4 cv[2][2], bv[2][2];
#pragma unroll
        for (int bj = 0; bj < 2; ++bj)
#pragma unroll
            for (int n = 0; n < 2; ++n) { cv[bj][n] = *(const f32x4*)(cs + col0 + bj * 128 + 4 * n); bv[bj][n] = *(const f32x4*)(bw + col0 + bj * 128 + 4 * n); }
#pragma unroll
        for (int ai = 0; ai < 2; ++ai)
#pragma unroll
            for (int m = 0; m < 4; ++m) { const int row = row0 + ai * 128 + m * 16; const f32x2 st = row_stats4(pslot, row); bf16* rowp = O + (size_t)row * ldc + col0;
#pragma unroll
                for (int bj = 0; bj < 2; ++bj) { f32x4 v0 = (acc[ai][bj][m][0] - st[0] * cv[bj][0]) * st[1] + bv[bj][0], v1 = (acc[ai][bj][m][1] - st[0] * cv[bj][1]) * st[1] + bv[bj][1];
                    if (ACT == 1) {
#pragma unroll
                        for (int j = 0; j < 4; ++j) { const float a0 = fmaxf(v0[j], 0.f), a1 = fmaxf(v1[j], 0.f); v0[j] = a0 * a0; v1[j] = a1 * a1; } }
                    v0 = v0 * scale; v1 = v1 * scale; v4u w; w.x = pk2(v0[0], v0[1]); w.y = pk2(v0[2], v0[3]); w.z = pk2(v1[0], v1[1]); w.w = pk2(v1[2], v1[3]);
                    *(v4u*)(rowp + bj * 128) = w; } }
    }
};

__device__ __forceinline__ void ln_final(Frame& F, const bf16* V, const float* g, const float* b, float* out, int r_lo, int r_hi, gu32* cnt, unsigned cnt_n) {
    const int gw = F.vcu * NWAVES + F.wave, NGW = F.G * NWAVES;
    f32x4 gv[4], bv[4];
#pragma unroll
    for (int j = 0; j < 4; ++j) { gv[j] = *((const GAS f32x4*)g + F.lane + 64 * j); bv[j] = *((const GAS f32x4*)b + F.lane + 64 * j); }
    for (int rbase = r_lo + gw; rbase < r_hi; rbase += 4 * NGW) {
        if (rbase >= MP) { unsigned sp = 0u;
            while ((unsigned)__builtin_amdgcn_readfirstlane((int)__hip_atomic_load(cnt, RLX_AGENT)) < cnt_n) { __builtin_amdgcn_s_sleep(1); if (++sp > (1u << 22)) break; }
            __builtin_amdgcn_fence(__ATOMIC_ACQUIRE, "agent"); asm volatile("s_waitcnt vmcnt(0)" ::: "memory"); }
        v2u w[4][4];
#pragma unroll
        for (int q = 0; q < 4; ++q) { const int r = rbase + q * NGW; if (r < r_hi) { const GAS v2u* xr = (const GAS v2u*)(V + (size_t)r * DM) + F.lane;
#pragma unroll
            for (int j = 0; j < 4; ++j) w[q][j] = xr[64 * j]; } }
#pragma unroll
        for (int q = 0; q < 4; ++q) { const int r = rbase + q * NGW; if (r < r_hi) {
            f32x4 v[4]; float s = 0.f;
#pragma unroll
            for (int j = 0; j < 4; ++j) { v[j] = (f32x4){bflo(w[q][j].x), bfhi(w[q][j].x), bflo(w[q][j].y), bfhi(w[q][j].y)}; s += (v[j].x + v[j].y) + (v[j].z + v[j].w); }
            const float mean = wave_sum(s) * (1.f / DM); float s2 = 0.f;
#pragma unroll
            for (int j = 0; j < 4; ++j) { v[j] = v[j] - mean; s2 += (v[j].x * v[j].x + v[j].y * v[j].y) + (v[j].z * v[j].z + v[j].w * v[j].w); }
            const float rstd = 1.f / sqrtf(wave_sum(s2) * (1.f / DM) + LN_EPS);
            float* of = r < MP ? out + O_YP + (size_t)r * DM : out + O_YS + (size_t)(r - MP) * DM;
#pragma unroll
            for (int j = 0; j < 4; ++j) *((GAS f32x4*)of + F.lane + 64 * j) = v[j] * rstd * gv[j] + bv[j]; } }
    }
}

constexpr int CX_KSTR = 528, CX_VSTR = 544;
static_assert(256 * CX_VSTR <= MISC_OFF, "cross-attention LDS");
__device__ __forceinline__ void cross_unit32(Frame& F, const Args& a, int bh, int qblk) {
    const bf16* QX = (const bf16*)(a.ws + WS_QX); const bf16* MKB = (const bf16*)(a.ws + WS_MKB); const bf16* MVB = (const bf16*)(a.ws + WS_MVB); bf16* OX = (bf16*)(a.ws + WS_OX);
    const int b = bh >> 2, h = bh & 3, tid = F.tid, lane = F.lane, w = F.wave, q32 = lane & 31, hh = lane >> 5, gi = lane >> 4, i16 = lane & 15;
    const size_t qrow = (size_t)b * SEQ + qblk * 256 + 32 * w + q32;
    const int lr = tid >> 5, lc = tid & 31;
    bf16x8 qf[16];
#pragma unroll
    for (int k8 = 0; k8 < 16; ++k8) qf[k8] = *(const bf16x8*)(QX + qrow * DM + h * 256 + 16 * k8 + 8 * hh);
    { const bf16* ksrc = MKB + ((size_t)b * MEMT + lr) * DM + h * 256 + lc * 8;
      v4u rk[16];
#pragma unroll
      for (int i = 0; i < 16; ++i) rk[i] = *(const v4u*)(ksrc + (size_t)(16 * i) * DM);
#pragma unroll
      for (int i = 0; i < 16; ++i) *(LAS v4u*)(F.lds + (lr + 16 * i) * CX_KSTR + lc * 16) = rk[i]; }
    __syncthreads();
    f32x16 s[8];
#pragma unroll
    for (int kb = 0; kb < 8; ++kb)
#pragma unroll
        for (int r = 0; r < 16; ++r) s[kb][r] = 0.f;
    const LAS unsigned char* kp = F.lds + q32 * CX_KSTR + 16 * hh;
#pragma unroll
    for (int half = 0; half < 4; ++half) {
#pragma unroll
        for (int k8 = 0; k8 < 4; ++k8) {
#pragma unroll
            for (int kb = 0; kb < 8; ++kb) { const bf16x8 kf = *(const LAS bf16x8*)(kp + (32 * kb) * CX_KSTR + 32 * (4 * half + k8)); s[kb] = __builtin_amdgcn_mfma_f32_32x32x16_bf16(kf, qf[4 * half + k8], s[kb], 0, 0, 0); if (kb == 3) __builtin_amdgcn_sched_barrier(0); }
            __builtin_amdgcn_sched_barrier(0); } }
    float mx = s[0][0];
#pragma unroll
    for (int kb = 0; kb < 8; ++kb)
#pragma unroll
        for (int r = 0; r < 16; ++r) mx = fmaxf(mx, s[kb][r]);
    mx = fmaxf(mx, __shfl_xor(mx, 32));
    unsigned pp[8][8]; float ps = 0.f;
#pragma unroll
    for (int kb = 0; kb < 8; ++kb)
#pragma unroll
        for (int j = 0; j < 8; ++j) { const float e0 = ex2(s[kb][2 * j] - mx), e1 = ex2(s[kb][2 * j + 1] - mx); ps += e0 + e1; pp[kb][j] = pk2(e0, e1); }
    ps += __shfl_xor(ps, 32);
    const float il = 1.0f / ps;
    { const bf16* vsrc = MVB + ((size_t)b * MEMT + lr) * DM + h * 256 + lc * 8;
      v4u rv[16];
#pragma unroll
      for (int i = 0; i < 16; ++i) rv[i] = *(const v4u*)(vsrc + (size_t)(16 * i) * DM);
      __syncthreads();
#pragma unroll
      for (int i = 0; i < 16; ++i) *(LAS v4u*)(F.lds + (lr + 16 * i) * CX_VSTR + lc * 16) = rv[i]; }
    __syncthreads();
    const LAS unsigned char* vb = F.lds + (4 * (gi >> 1) + (i16 >> 2)) * CX_VSTR + (16 * (gi & 1) + 4 * (i16 & 3)) * 2;
#pragma unroll 1
    for (int dh = 0; dh < 2; ++dh) {
        f32x16 o[4];
#pragma unroll
        for (int db = 0; db < 4; ++db)
#pragma unroll
            for (int r = 0; r < 16; ++r) o[db][r] = 0.f;
#pragma unroll
        for (int kb = 0; kb < 8; ++kb)
#pragma unroll
            for (int st = 0; st < 2; ++st) {
                const v4u pw = (v4u){pp[kb][4 * st], pp[kb][4 * st + 1], pp[kb][4 * st + 2], pp[kb][4 * st + 3]};
                const bf16x8 pf = __builtin_bit_cast(bf16x8, pw);
                const LAS unsigned char* vk = vb + (32 * kb + 16 * st) * CX_VSTR + dh * 256;
#pragma unroll
                for (int db = 0; db < 4; ++db) { const s16x4 lo = tr_read(vk + db * 64), hi = tr_read(vk + 8 * CX_VSTR + db * 64);
                    const bf16x8 av = (bf16x8){lo[0], lo[1], lo[2], lo[3], hi[0], hi[1], hi[2], hi[3]};
                    o[db] = __builtin_amdgcn_mfma_f32_32x32x16_bf16(av, pf, o[db], 0, 0, 0); }
                __builtin_amdgcn_sched_barrier(0); }
#pragma unroll
        for (int db = 0; db < 4; ++db)
#pragma unroll
            for (int rg = 0; rg < 4; ++rg) st_bf4(OX + qrow * DM + h * 256 + 128 * dh + 32 * db + 8 * rg + 4 * hh, (f32x4){o[db][4 * rg], o[db][4 * rg + 1], o[db][4 * rg + 2], o[db][4 * rg + 3]} * il);
    }
    __syncthreads();
}

__device__ __forceinline__ void scross_unit(Frame& F, const Args& a, int b, int hp) {
    const bf16* QX = (const bf16*)(a.ws + WS_QX); bf16* OX = (bf16*)(a.ws + WS_OX);
    const int lane = F.lane, w = F.wave, tid = F.tid;
    LAS float* SC = (LAS float*)F.lds;
    LAS float* OP = (LAS float*)(F.lds + 2048);
    const size_t qrow = (size_t)MP + b;
    f32x4 q[2];
#pragma unroll
    for (int j = 0; j < 2; ++j) { const v2u qq = *(const v2u*)(QX + qrow * DM + (2 * hp + j) * 256 + 4 * lane); q[j] = (f32x4){bflo(qq.x), bfhi(qq.x), bflo(qq.y), bfhi(qq.y)}; }
    const float* kb = a.in[I_MEMK] + ((size_t)b * MEMT) * DM + (2 * hp) * 256 + 4 * lane; const float* vb = a.in[I_MEMV] + ((size_t)b * MEMT) * DM + (2 * hp) * 256 + 4 * lane;
#pragma unroll 8
    for (int i = 0; i < 32; ++i) { const int mt = w * 32 + i;
        const f32x4 k0 = __builtin_nontemporal_load((const f32x4*)(kb + (size_t)mt * DM)), k1 = __builtin_nontemporal_load((const f32x4*)(kb + (size_t)mt * DM + 256));
        float d0 = (k0[0] * q[0][0] + k0[1] * q[0][1]) + (k0[2] * q[0][2] + k0[3] * q[0][3]), d1 = (k1[0] * q[1][0] + k1[1] * q[1][1]) + (k1[2] * q[1][2] + k1[3] * q[1][3]);
        d0 = wave_sum(d0); d1 = wave_sum(d1);
        if (lane == 0) { SC[mt] = d0; SC[256 + mt] = d1; } }
    __syncthreads();
    if (w < 2) { f32x4 s = *(const LAS f32x4*)(SC + w * 256 + 4 * lane); const float mx = wave_max(fmaxf(fmaxf(s[0], s[1]), fmaxf(s[2], s[3])));
#pragma unroll
        for (int j = 0; j < 4; ++j) s[j] = ex2(s[j] - mx);
        const float inv = 1.0f / wave_sum((s[0] + s[1]) + (s[2] + s[3]));
        *(LAS f32x4*)(SC + w * 256 + 4 * lane) = s * inv; }
    __syncthreads();
    f32x4 o0 = (f32x4){0.f, 0.f, 0.f, 0.f}, o1 = o0;
#pragma unroll 8
    for (int i = 0; i < 32; ++i) { const int mt = w * 32 + i; const float p0 = SC[mt], p1 = SC[256 + mt];
        const f32x4 v0 = __builtin_nontemporal_load((const f32x4*)(vb + (size_t)mt * DM)), v1 = __builtin_nontemporal_load((const f32x4*)(vb + (size_t)mt * DM + 256));
        o0 += p0 * v0; o1 += p1 * v1; }
    *(LAS f32x4*)(OP + w * 512 + 4 * lane) = o0; *(LAS f32x4*)(OP + w * 512 + 256 + 4 * lane) = o1;
    __syncthreads();
    { float s = 0.f;
#pragma unroll
      for (int k = 0; k < 8; ++k) s += OP[k * 512 + tid];
      OX[qrow * DM + (2 * hp) * 256 + tid] = (bf16)(pk2(s, 0.f) & 0xffffu); }
    __syncthreads();
}

constexpr int MLA_KSTR = 208, MLA_VSTR = 144, MLA_KT = 64 * MLA_KSTR, MLA_BUF = MLA_KT + 64 * MLA_VSTR;
constexpr int DT_STR = 592, DT_BYTES = 16 * DT_STR, P3_T = 2 * MLA_BUF, P3_QL = P3_T + 8 * DT_BYTES, P3_QN = P3_QL + 16 * DT_STR, P3_CTL = P3_QN + 2048, P3_QS0 = P3_CTL + 128;
static_assert(P3_QS0 + 4 * 3072 <= MISC_OFF && P3_T % 16 == 0 && P3_QS0 % 16 == 0, "phase-3 LDS map");
__device__ __forceinline__ void bar4(LAS unsigned* ctr, unsigned& target, int lane) {
    target += 4u;
    asm volatile("s_waitcnt lgkmcnt(0)" ::: "memory");
    if (lane == 0) __hip_atomic_fetch_add(ctr, 1u, __ATOMIC_RELAXED, __HIP_MEMORY_SCOPE_WORKGROUP);
    while (__hip_atomic_load(ctr, __ATOMIC_RELAXED, __HIP_MEMORY_SCOPE_WORKGROUP) < target) __builtin_amdgcn_s_sleep(1);
    asm volatile("" ::: "memory");
}
__device__ __forceinline__ void mla_unit4(Frame& F, const Args& a, int bh, int qblk, LAS unsigned* bctr, unsigned& btgt) {
    const bf16* Q = (const bf16*)(a.ws + WS_Q); const bf16* KN = (const bf16*)(a.ws + WS_KN); const bf16* VV = (const bf16*)(a.ws + WS_VV); const bf16* KR = (const bf16*)(a.ws + WS_KR); bf16* AC = (bf16*)(a.ws + WS_AC);
    const int b = bh >> 3, h = bh & 7, lane = F.lane, aw = F.wave, q32 = lane & 31, hh = lane >> 5, t4 = aw * 64 + lane;
    const size_t rb = (size_t)b * SEQ; const int q0 = qblk * 256, NT = 4 * (qblk + 1);
    const size_t qrow = rb + q0 + 64 * aw + q32;
    bf16x8 qf[3];
    LAS unsigned char* qst = F.lds + P3_T + aw * DT_BYTES + lane * 16; LAS unsigned char* qs0 = F.lds + P3_QS0 + aw * 3072 + lane * 16;
#pragma unroll
    for (int s = 0; s < 6; ++s) { const bf16x8 q0v = *(const bf16x8*)(Q + qrow * QC + h * 96 + 16 * s + 8 * hh); if (s < 3) qf[s] = q0v; else *(LAS bf16x8*)(qs0 + (s - 3) * 1024) = q0v;
        *(LAS bf16x8*)(qst + s * 1024) = *(const bf16x8*)(Q + (qrow + 32) * QC + h * 96 + 16 * s + 8 * hh); }
    f32x16 o[2][2];
#pragma unroll
    for (int r = 0; r < 16; ++r) { o[0][0][r] = 0.f; o[0][1][r] = 0.f; o[1][0][r] = 0.f; o[1][1][r] = 0.f; }
    float m[2] = {-1e30f, -1e30f}, l[2] = {0.f, 0.f};
    const int r0 = t4 >> 3, c0 = t4 & 7, rr = t4 >> 2, cr = t4 & 3;
    const bf16* vsrc = VV + (rb + r0) * 512 + h * 64 + c0 * 8; const bf16* nsrc = KN + (rb + r0) * 512 + h * 64 + c0 * 8; const bf16* rsrc = KR + (rb + rr) * RD + cr * 8;
    const int vdst = MLA_KT + r0 * MLA_VSTR + c0 * 16, ndst = r0 * MLA_KSTR + c0 * 16, rdst = rr * MLA_KSTR + 128 + cr * 16;
    v4u pv0, pv1, pn0, pn1, pr;
#define MLA_LOAD(t_) do { const size_t off_ = (size_t)(t_) * 64; pv0 = *(const v4u*)(vsrc + off_ * 512); pv1 = *(const v4u*)(vsrc + (off_ + 32) * 512); pn0 = *(const v4u*)(nsrc + off_ * 512); pn1 = *(const v4u*)(nsrc + (off_ + 32) * 512); pr = *(const v4u*)(rsrc + off_ * RD); } while (0)
#define MLA_STORE(buf_) do { LAS unsigned char* nb_ = (buf_); *(LAS v4u*)(nb_ + vdst) = pv0; *(LAS v4u*)(nb_ + vdst + 32 * MLA_VSTR) = pv1; *(LAS v4u*)(nb_ + ndst) = pn0; *(LAS v4u*)(nb_ + ndst + 32 * MLA_KSTR) = pn1; *(LAS v4u*)(nb_ + rdst) = pr; } while (0)
    MLA_LOAD(0); MLA_STORE(F.lds);
    bar4(bctr, btgt, lane);
    const int qmin = q0 + 64 * aw, qpos = qmin + q32;
    const int gi = lane >> 4, i16 = lane & 15;
    for (int t = 0; t < NT; ++t) {
        const LAS unsigned char* Kt = F.lds + (t & 1) * MLA_BUF; const LAS unsigned char* Vt = Kt + MLA_KT;
        const bool more = t + 1 < NT;
        if (more) MLA_LOAD(t + 1);
        if (64 * t <= qmin + 63) {
            const bool diag = 64 * t + 63 > qmin;
            const LAS unsigned char* vb = Vt + (4 * (gi >> 1) + (i16 >> 2)) * MLA_VSTR + (16 * (gi & 1) + 4 * (i16 & 3)) * 2;
#pragma unroll
            for (int kb = 0; kb < 2; ++kb) {
                f32x16 s[2];
#pragma unroll
                for (int r = 0; r < 16; ++r) { s[0][r] = 0.f; s[1][r] = 0.f; }
#pragma unroll
                for (int ks = 0; ks < 6; ++ks) { const bf16x8 kf = *(const LAS bf16x8*)(Kt + (32 * kb + q32) * MLA_KSTR + (16 * ks + 8 * hh) * 2); const bf16x8 q1 = *(const LAS bf16x8*)(qst + ks * 1024);
                    const bf16x8 q0 = ks < 3 ? qf[ks < 3 ? ks : 0] : *(const LAS bf16x8*)(qs0 + (ks - 3) * 1024);
                    s[0] = __builtin_amdgcn_mfma_f32_32x32x16_bf16(kf, q0, s[0], 0, 0, 0); s[1] = __builtin_amdgcn_mfma_f32_32x32x16_bf16(kf, q1, s[1], 0, 0, 0);
                    if (ks & 1) __builtin_amdgcn_sched_barrier(0); }
                s16x4 vlo[2][2], vhi[2][2];
#pragma unroll
                for (int st = 0; st < 2; ++st)
#pragma unroll
                    for (int db = 0; db < 2; ++db) { const LAS unsigned char* vk = vb + (32 * kb + 16 * st) * MLA_VSTR + db * 64; vlo[st][db] = tr_read(vk); vhi[st][db] = tr_read(vk + 8 * MLA_VSTR); }
#pragma unroll
                for (int u = 0; u < 2; ++u) {
                    if (diag) {
#pragma unroll
                        for (int r = 0; r < 16; ++r) { const int key = 64 * t + 32 * kb + (r & 3) + 8 * (r >> 2) + 4 * hh; if (key > qpos + 32 * u) s[u][r] = -INFINITY; } }
                    float mx = fmaxf(s[u][0], s[u][1]);
#pragma unroll
                    for (int r = 2; r < 16; ++r) mx = fmaxf(mx, s[u][r]);
                    mx = fmaxf(mx, __shfl_xor(mx, 32));
                    if (__any(mx > m[u])) { const float mn = fmaxf(m[u], mx), al = ex2(m[u] - mn); m[u] = mn; l[u] *= al;
#pragma unroll
                        for (int r = 0; r < 16; ++r) { o[u][0][r] *= al; o[u][1][r] *= al; } }
                    float ps = 0.f; unsigned pp[8];
#pragma unroll
                    for (int j = 0; j < 8; ++j) { const float e0 = ex2(s[u][2 * j] - m[u]), e1 = ex2(s[u][2 * j + 1] - m[u]); ps += e0 + e1; pp[j] = pk2(e0, e1); }
                    l[u] += ps;
#pragma unroll
                    for (int st = 0; st < 2; ++st) {
                        const v4u pw = (v4u){pp[4 * st], pp[4 * st + 1], pp[4 * st + 2], pp[4 * st + 3]};
                        const bf16x8 pf = __builtin_bit_cast(bf16x8, pw);
#pragma unroll
                        for (int db = 0; db < 2; ++db) { const s16x4 lo = vlo[st][db], hi = vhi[st][db];
                            const bf16x8 av = (bf16x8){lo[0], lo[1], lo[2], lo[3], hi[0], hi[1], hi[2], hi[3]};
                            o[u][db] = __builtin_amdgcn_mfma_f32_32x32x16_bf16(av, pf, o[u][db], 0, 0, 0); } }
                }
            }
        }
        if (more) MLA_STORE(F.lds + ((t + 1) & 1) * MLA_BUF);
        bar4(bctr, btgt, lane);
    }
#undef MLA_LOAD
#undef MLA_STORE
#pragma unroll
    for (int u = 0; u < 2; ++u) { const float lt = l[u] + __shfl_xor(l[u], 32), il = 1.0f / lt;
#pragma unroll
        for (int db = 0; db < 2; ++db)
#pragma unroll
            for (int rg = 0; rg < 4; ++rg) st_bf4(AC + (qrow + 32 * u) * DM + h * 64 + 32 * db + 8 * rg + 4 * hh, (f32x4){o[u][db][4 * rg], o[u][db][4 * rg + 1], o[u][db][4 * rg + 2], o[u][db][4 * rg + 3]} * il); }
}

__device__ __forceinline__ void decode_setup4(Frame& F, const Args& a, int b) {
    const bf16* Q = (const bf16*)(a.ws + WS_Q); const float* QLAT = (const float*)(a.ws + WS_QLAT);
    const int lane = F.lane, w4 = F.wave - 4, t4 = w4 * 64 + lane;
    LAS unsigned char* QL = F.lds + P3_QL;
    const size_t qrow = (size_t)MP + b;
#pragma unroll
    for (int hp = 0; hp < 2; ++hp) { const int h = 2 * w4 + hp, l4 = lane * 4; const f32x4 ql = *(const f32x4*)(QLAT + ((size_t)b * 8 + h) * 256 + l4);
      v2u pw; pw.x = pk2(ql[0], ql[1]); pw.y = pk2(ql[2], ql[3]); *(LAS v2u*)(QL + h * DT_STR + l4 * 2) = pw; }
    for (int i = t4; i < 8 * DT_STR / 4; i += 256) ((LAS unsigned*)(QL + 8 * DT_STR))[i] = 0u;
    { const int h = t4 >> 5, r = t4 & 31; *(LAS bf16*)(QL + h * DT_STR + (256 + r) * 2) = Q[qrow * QC + h * 96 + 64 + r]; }
}
__device__ __forceinline__ void decode_stream(Frame& F, const Args& a, int b, int half, LAS unsigned* pctr, f32x4 (&o)[16], float& m, float& l) {
    const int lane = F.lane, w = F.wave, r16 = lane & 15, g = lane >> 4;
    const LAS unsigned char* QL = F.lds + P3_QL; LAS unsigned char* T = F.lds + P3_T + w * DT_BYTES;
    const LAS unsigned char* qlp = QL + r16 * DT_STR + 16 * g;
    const int* pt = (const int*)a.in[I_PT] + b * NPG + half * 32;
    const float* cck = a.in[I_CKV]; const float* ckr = a.in[I_KROPE];
    f32x4 cl[16], rp[2];
#define DEC_LOAD(blk_, pgi_) do { const float* cb_ = cck + ((size_t)(pgi_) * 128 + (blk_) * 16) * KVL + 4 * lane; const float* rb_ = ckr + ((size_t)(pgi_) * 128 + (blk_) * 16 + (lane >> 2)) * RD + (lane & 3) * 8; \
        _Pragma("unroll") for (int i_ = 0; i_ < 16; ++i_) cl[i_] = __builtin_nontemporal_load((const f32x4*)(cb_ + i_ * KVL)); \
        rp[0] = __builtin_nontemporal_load((const f32x4*)rb_); rp[1] = __builtin_nontemporal_load((const f32x4*)(rb_ + 4)); } while (0)
#define DEC_GRAB(dst_) do { unsigned v_ = 0u; if (lane == 0) v_ = __hip_atomic_fetch_add(pctr, 1u, __ATOMIC_RELAXED, __HIP_MEMORY_SCOPE_WORKGROUP); dst_ = (int)__builtin_amdgcn_readfirstlane(v_); } while (0)
    int pcur; DEC_GRAB(pcur);
    bool valid = pcur < 32; int pg = 0, blk = 0;
    if (valid) { pg = __builtin_amdgcn_readfirstlane(pt[pcur]); DEC_LOAD(0, pg); }
#pragma unroll 1
    while (valid) {
#pragma unroll
        for (int i = 0; i < 16; ++i) { v2u pw; pw.x = pk2(cl[i][0], cl[i][1]); pw.y = pk2(cl[i][2], cl[i][3]); *(LAS v2u*)(T + i * DT_STR + lane * 8) = pw; }
        { v4u pw; pw.x = pk2(rp[0][0], rp[0][1]); pw.y = pk2(rp[0][2], rp[0][3]); pw.z = pk2(rp[1][0], rp[1][1]); pw.w = pk2(rp[1][2], rp[1][3]); *(LAS v4u*)(T + (lane >> 2) * DT_STR + 512 + (lane & 3) * 16) = pw; }
        ++blk;
        if (blk == 8) { blk = 0; DEC_GRAB(pcur); valid = pcur < 32; if (valid) pg = __builtin_amdgcn_readfirstlane(pt[pcur]); }
        if (valid) DEC_LOAD(blk, pg);
        f32x4 sa = (f32x4){0.f, 0.f, 0.f, 0.f};
#pragma unroll
        for (int s = 0; s < 9; ++s) { const bf16x8 av = *(const LAS bf16x8*)(T + r16 * DT_STR + (32 * s + 8 * g) * 2); const bf16x8 qv = *(const LAS bf16x8*)(qlp + 64 * s); sa = __builtin_amdgcn_mfma_f32_16x16x32_bf16(av, qv, sa, 0, 0, 0); if (s % 3 == 2) __builtin_amdgcn_sched_barrier(0); }
        float mx = fmaxf(fmaxf(sa[0], sa[1]), fmaxf(sa[2], sa[3])); mx = fmaxf(mx, __shfl_xor(mx, 16)); mx = fmaxf(mx, __shfl_xor(mx, 32));
        if (__any(mx > m)) { const float mn = fmaxf(m, mx), al = ex2(m - mn); m = mn; l *= al;
#pragma unroll
            for (int lb = 0; lb < 16; ++lb) o[lb] = o[lb] * al; }
        float p[4];
#pragma unroll
        for (int r = 0; r < 4; ++r) p[r] = ex2(sa[r] - m);
        l += (p[0] + p[1]) + (p[2] + p[3]);
        v2u pw; pw.x = pk2(p[0], p[1]); pw.y = pk2(p[2], p[3]); const s16x4 pb = __builtin_bit_cast(s16x4, pw);
        const LAS unsigned char* tb = T + (4 * g + (r16 >> 2)) * DT_STR + (4 * (r16 & 3)) * 2;
#pragma unroll
        for (int lb = 0; lb < 16; ++lb) { const s16x4 av = tr_read(tb + lb * 32); o[lb] = __builtin_amdgcn_mfma_f32_16x16x16bf16_1k(av, pb, o[lb], 0, 0, 0); if ((lb & 3) == 3) __builtin_amdgcn_sched_barrier(0); }
    }
#undef DEC_LOAD
#undef DEC_GRAB
}
__device__ __forceinline__ void decode_finish4(Frame& F, const Args& a, int b, int half, const f32x4 (&o)[16], float m, float l, LAS unsigned* dctr, unsigned& dtgt) {
    float* PART = (float*)(a.ws + WS_PART); float* PML = (float*)(a.ws + WS_PML);
    const int lane = F.lane, w4 = F.wave - 4, t4 = w4 * 64 + lane, r16 = lane & 15, g = lane >> 4;
    l += __shfl_xor(l, 16); l += __shfl_xor(l, 32);
    LAS float* CB = (LAS float*)(F.lds + P3_T + 4 * DT_BYTES);
    LAS float* ML = CB + 4 * 8 * 256;
    bar4(dctr, dtgt, lane);
    if (r16 < 8) {
#pragma unroll
        for (int lb = 0; lb < 16; ++lb) *(LAS f32x4*)(CB + (w4 * 8 + r16) * 256 + 16 * lb + 4 * g) = o[lb];
        if (g == 0) { ML[(w4 * 8 + r16) * 2] = m; ML[(w4 * 8 + r16) * 2 + 1] = l; } }
    bar4(dctr, dtgt, lane);
    { const int h = t4 >> 5, l8 = (t4 & 31) * 8; float M = -1e30f;
#pragma unroll
      for (int k = 0; k < 4; ++k) M = fmaxf(M, ML[(k * 8 + h) * 2]);
      float L = 0.f; f32x4 acc0 = (f32x4){0.f, 0.f, 0.f, 0.f}, acc1 = (f32x4){0.f, 0.f, 0.f, 0.f};
#pragma unroll
      for (int k = 0; k < 4; ++k) { const float sc = ex2(ML[(k * 8 + h) * 2] - M); L += ML[(k * 8 + h) * 2 + 1] * sc;
          acc0 += sc * *(const LAS f32x4*)(CB + (k * 8 + h) * 256 + l8); acc1 += sc * *(const LAS f32x4*)(CB + (k * 8 + h) * 256 + l8 + 4); }
      const size_t pu = ((size_t)(b * 2 + half) * 8 + h);
      *(f32x4*)(PART + pu * 256 + l8) = acc0; *(f32x4*)(PART + pu * 256 + l8 + 4) = acc1;
      if ((t4 & 31) == 0) { PML[pu * 2] = M; PML[pu * 2 + 1] = L; } }
}
__device__ __forceinline__ void combine_unit4(Frame& F, const Args& a, int b) {
    const bf16* Q = (const bf16*)(a.ws + WS_Q); const float* PART = (const float*)(a.ws + WS_PART); const float* PML = (const float*)(a.ws + WS_PML); const float* QLAT = (const float*)(a.ws + WS_QLAT); bf16* AC = (bf16*)(a.ws + WS_AC);
    const int w4 = F.wave - 4, j = F.lane;
    LAS float* OL = (LAS float*)(F.lds + P3_T + 4 * DT_BYTES);
    const float* cn = a.out + O_CKVS + (size_t)b * KVL; const float* kn = a.out + O_KRS + (size_t)b * RD;
    const f32x4 c4 = *(const f32x4*)(cn + 4 * j);
#pragma unroll
    for (int hp = 0; hp < 2; ++hp) { const int h = 2 * w4 + hp;
        const f32x4 q4 = *(const f32x4*)(QLAT + ((size_t)b * 8 + h) * 256 + 4 * j);
        float sp = (q4[0] * c4[0] + q4[1] * c4[1]) + (q4[2] * c4[2] + q4[3] * c4[3]);
        if (j < 32) sp += bf2f(Q[((size_t)MP + b) * QC + h * 96 + 64 + j]) * kn[j];
        const float sn = wave_sum(sp);
        const size_t p0 = ((size_t)(b * 2) * 8 + h), p1 = ((size_t)(b * 2 + 1) * 8 + h);
        const float M0 = PML[p0 * 2], L0 = PML[p0 * 2 + 1], M1 = PML[p1 * 2], L1 = PML[p1 * 2 + 1];
        const float M = fmaxf(fmaxf(M0, M1), sn), w0 = ex2(M0 - M), w1 = ex2(M1 - M), wn = ex2(sn - M), il = 1.0f / (L0 * w0 + L1 * w1 + wn);
        const f32x4 a0 = *(const f32x4*)(PART + p0 * 256 + 4 * j), a1 = *(const f32x4*)(PART + p1 * 256 + 4 * j);
        *(LAS f32x4*)(OL + h * 256 + 4 * j) = (a0 * w0 + a1 * w1 + c4 * wn) * il; }
    asm volatile("s_waitcnt lgkmcnt(0)" ::: "memory");
#pragma unroll 1
    for (int hp = 0; hp < 2; ++hp) { const int h = 2 * w4 + hp;
        const float* wuv = a.in[I_WUV] + h * 64 + j; float acc = 0.f, acc2 = 0.f;
#pragma unroll 1
        for (int l0 = 0; l0 < 256; l0 += 64) {
            float wv[64];
#pragma unroll
            for (int i = 0; i < 64; ++i) wv[i] = wuv[(size_t)(l0 + i) * 512];
#pragma unroll
            for (int i = 0; i < 64; i += 2) { acc += OL[h * 256 + l0 + i] * wv[i]; acc2 += OL[h * 256 + l0 + i + 1] * wv[i + 1]; } }
        acc += acc2;
        AC[((size_t)MP + b) * DM + h * 64 + j] = (bf16)(pk2(acc, 0.f) & 0xffffu); }
}
#if defined(PROBE_PH)
#define SUBSTAMP(i, cond) do { if (blockIdx.x == 0 && (cond)) F.MISC[(i)] = (unsigned)__builtin_amdgcn_s_memrealtime(); } while (0)
#else
#define SUBSTAMP(i, cond) do { } while (0)
#endif
__device__ __forceinline__ void p3_phase(Frame& F, const Args& a) {
    LAS unsigned* ctl = (LAS unsigned*)(F.lds + P3_CTL);
    bool first = true;
    for (int du = F.vcu; first || du < NS * 2; du += F.G) {
        const bool has_dec = du < NS * 2; const int b = du >> 1, half = du & 1;
        if (F.tid == 0) { ctl[0] = 0u; ctl[8] = 0u; ctl[16] = 0u; }
        __syncthreads();
        asm volatile("" : "+v"(F.tid)); F.lane = F.tid & 63;
        SUBSTAMP(28, F.tid == 0);
        if (F.wave < 4) {
            if (first) { unsigned btgt = 0u; __builtin_amdgcn_s_setprio(2);
                for (int i = 0;; ++i) { const int n = i * F.G + F.vcu; if (n >= 1024) break;
                    const int r = n >> 8, v = n & 255, bh = v >> 1, s = v & 1, qa = 2 * s + (r >> 1), qblk = (r & 1) ? 7 - qa : qa;
                    mla_unit4(F, a, bh, qblk, ctl, btgt); }
                __builtin_amdgcn_s_setprio(0); SUBSTAMP(29, F.tid == 0); }
        } else if (has_dec) {
            unsigned dtgt = 0u;
            if (first) {
                if (F.wave == 4) { const unsigned nsrw = F.G < NS ? (unsigned)F.G : (unsigned)NS; unsigned sp = 0u;
                    while ((unsigned)__builtin_amdgcn_readfirstlane((int)__hip_atomic_load(F.ctl + CW_SRW, RLX_AGENT)) < nsrw) { __builtin_amdgcn_s_sleep(1); if (++sp > (1u << 22)) break; }
                    __builtin_amdgcn_fence(__ATOMIC_ACQUIRE, "agent"); asm volatile("s_waitcnt vmcnt(0)" ::: "memory"); }
                bar4(ctl + 8, dtgt, F.lane); }
            decode_setup4(F, a, b);
            bar4(ctl + 8, dtgt, F.lane);
            f32x4 o[16];
#pragma unroll
            for (int lb = 0; lb < 16; ++lb) o[lb] = (f32x4){0.f, 0.f, 0.f, 0.f};
            float m = -1e30f, l = 0.f;
            decode_stream(F, a, b, half, ctl + 16, o, m, l);
            SUBSTAMP(10, F.tid == 256);
            decode_finish4(F, a, b, half, o, m, l, ctl + 8, dtgt);
            asm volatile("s_waitcnt vmcnt(0)" ::: "memory");
            bar4(ctl + 8, dtgt, F.lane);
            if (F.wave == 4) { if (F.lane == 0) { __builtin_amdgcn_fence(__ATOMIC_RELEASE, "agent"); asm volatile("s_waitcnt vmcnt(0)" ::: "memory");
                const unsigned old = __hip_atomic_fetch_add((unsigned*)(F.ctl + CW_CMB) + b, 1u, __ATOMIC_RELAXED, __HIP_MEMORY_SCOPE_AGENT);
                if (old == 1u) { __builtin_amdgcn_fence(__ATOMIC_ACQUIRE, "agent"); asm volatile("s_waitcnt vmcnt(0)" ::: "memory"); }
                ctl[24] = old; } }
            bar4(ctl + 8, dtgt, F.lane);
            if (__builtin_amdgcn_readfirstlane((int)ctl[24]) == 1) combine_unit4(F, a, b);
            SUBSTAMP(31, F.tid == 256);
        }
        __syncthreads();
        SUBSTAMP(30, F.tid == 0);
        asm volatile("" : "+v"(F.tid)); F.lane = F.tid & 63;
        first = false;
    }
}


__device__ __forceinline__ void combine_unit(Frame& F, const Args& a, int b) {
    const bf16* Q = (const bf16*)(a.ws + WS_Q); const float* PART = (const float*)(a.ws + WS_PART); const float* PML = (const float*)(a.ws + WS_PML); const float* QLAT = (const float*)(a.ws + WS_QLAT); bf16* AC = (bf16*)(a.ws + WS_AC);
    const int tid = F.tid, h = tid >> 6, j = tid & 63;
    LAS float* OL = (LAS float*)F.lds;
    const float* cn = a.out + O_CKVS + (size_t)b * KVL; const float* kn = a.out + O_KRS + (size_t)b * RD;
    const f32x4 c4 = *(const f32x4*)(cn + 4 * j); const f32x4 q4 = *(const f32x4*)(QLAT + ((size_t)b * 8 + h) * 256 + 4 * j);
    float sp = (q4[0] * c4[0] + q4[1] * c4[1]) + (q4[2] * c4[2] + q4[3] * c4[3]);
    if (j < 32) sp += bf2f(Q[((size_t)MP + b) * QC + h * 96 + 64 + j]) * kn[j];
    const float sn = wave_sum(sp);
    const size_t p0 = ((size_t)(b * 2) * 8 + h), p1 = ((size_t)(b * 2 + 1) * 8 + h);
    const float M0 = PML[p0 * 2], L0 = PML[p0 * 2 + 1], M1 = PML[p1 * 2], L1 = PML[p1 * 2 + 1];
    const float M = fmaxf(fmaxf(M0, M1), sn), w0 = ex2(M0 - M), w1 = ex2(M1 - M), wn = ex2(sn - M), il = 1.0f / (L0 * w0 + L1 * w1 + wn);
    const f32x4 a0 = *(const f32x4*)(PART + p0 * 256 + 4 * j), a1 = *(const f32x4*)(PART + p1 * 256 + 4 * j);
    *(LAS f32x4*)(OL + h * 256 + 4 * j) = (a0 * w0 + a1 * w1 + c4 * wn) * il;
    __syncthreads();
    const float* wuv = a.in[I_WUV] + h * 64 + j; float acc = 0.f, acc2 = 0.f;
#pragma unroll 1
    for (int l0 = 0; l0 < 256; l0 += 64) {
        float wv[64];
#pragma unroll
        for (int i = 0; i < 64; ++i) wv[i] = wuv[(size_t)(l0 + i) * 512];
#pragma unroll
        for (int i = 0; i < 64; i += 2) { acc += OL[h * 256 + l0 + i] * wv[i]; acc2 += OL[h * 256 + l0 + i + 1] * wv[i + 1]; } }
    acc += acc2;
    AC[((size_t)MP + b) * DM + h * 64 + j] = (bf16)(pk2(acc, 0.f) & 0xffffu);
    __syncthreads();
}

constexpr int CV_UB = 62 * CCH * 2, CV_CB = 32 * CCH * 4;
__device__ __forceinline__ void conv_phase(Frame& F, const Args& a) {
    const bf16* U = (const bf16*)(a.ws + WS_U); bf16* AC = (bf16*)(a.ws + WS_AC);
    const int tid = F.tid, lane = F.lane, w = F.wave;
    LAS unsigned char* ub = F.lds;
    LAS float* cb = (LAS float*)(F.lds + CV_UB);
    const int cp = tid & 255, th = tid >> 8;
    f32x2 wt[31];
#pragma unroll
    for (int jj = 0; jj < 31; ++jj) wt[jj] = *(const f32x2*)(a.in[I_CONVW] + jj * CCH + 2 * cp);
    const f32x2 bias = *(const f32x2*)(a.in[I_CONVB] + 2 * cp);
    const f32x4 g0 = *(const f32x4*)(a.in[I_CLNG] + 8 * lane), g1 = *(const f32x4*)(a.in[I_CLNG] + 8 * lane + 4), b0 = *(const f32x4*)(a.in[I_CLNB] + 8 * lane), b1 = *(const f32x4*)(a.in[I_CLNB] + 8 * lane + 4);
    v4u tv[8];
#define CONV_LOAD(n_) do { const int b_ = (n_) >> 6, t0_ = ((n_) & 63) * 32; _Pragma("unroll") for (int i = 0; i < 8; ++i) { const int c = tid + 512 * i, r = c >> 6, ch = c & 63, t = t0_ - 30 + r; tv[i] = (v4u){0u, 0u, 0u, 0u}; \
        if (c < 62 * 64 && t >= 0) tv[i] = *(const v4u*)(U + ((size_t)b_ * SEQ + t) * CCH + ch * 8); } } while (0)
    int n = F.vcu;
    if (n < NBATCH * 64) CONV_LOAD(n);
    while (n < NBATCH * 64) {
        const int b = n >> 6, t0 = (n & 63) * 32;
#pragma unroll
        for (int i = 0; i < 8; ++i) { const int c = tid + 512 * i; if (c < 62 * 64) *(LAS v4u*)(ub + (c >> 6) * 1024 + (c & 63) * 16) = tv[i]; }
        const int nn = n + F.G;
        if (nn < NBATCH * 64) CONV_LOAD(nn);
        __syncthreads();
        {
            const int tb0 = th * 16;
            f32x2 acc[16];
#pragma unroll
            for (int tt = 0; tt < 16; ++tt) acc[tt] = bias;
#pragma unroll
            for (int i = 0; i < 46; ++i) { const unsigned uw = *(const LAS unsigned*)(ub + (tb0 + i) * 1024 + cp * 4); const f32x2 uv = {bflo(uw), bfhi(uw)};
#pragma unroll
                for (int tt = 0; tt < 16; ++tt) { const int jj = i - tt; if (jj >= 0 && jj < 31) acc[tt] += wt[jj] * uv; }
                }
#pragma unroll
            for (int tt = 0; tt < 16; ++tt) *(LAS f32x2*)(cb + (tb0 + tt) * CCH + 2 * cp) = acc[tt];
        }
        __syncthreads();
#pragma unroll
        for (int k = 0; k < 4; ++k) { const int tt = w * 4 + k; f32x4 v0 = *(const LAS f32x4*)(cb + tt * CCH + 8 * lane), v1 = *(const LAS f32x4*)(cb + tt * CCH + 8 * lane + 4);
            const float mean = wave_sum((v0[0] + v0[1]) + (v0[2] + v0[3]) + (v1[0] + v1[1]) + (v1[2] + v1[3])) * (1.0f / CCH);
            v0 = v0 - mean; v1 = v1 - mean;
            const float var = wave_sum((v0[0] * v0[0] + v0[1] * v0[1]) + (v0[2] * v0[2] + v0[3] * v0[3]) + (v1[0] * v1[0] + v1[1] * v1[1]) + (v1[2] * v1[2] + v1[3] * v1[3])) * (1.0f / CCH);
            const float rstd = 1.0f / sqrtf(var + LN_EPS);
            f32x4 y0 = v0 * rstd * g0 + b0, y1 = v1 * rstd * g1 + b1;
#pragma unroll
            for (int e = 0; e < 4; ++e) { y0[e] = y0[e] / (1.0f + __expf(-y0[e])); y1[e] = y1[e] / (1.0f + __expf(-y1[e])); }
            v4u o; o.x = pk2(y0[0], y0[1]); o.y = pk2(y0[2], y0[3]); o.z = pk2(y1[0], y1[1]); o.w = pk2(y1[2], y1[3]);
            *(v4u*)(AC + ((size_t)b * SEQ + t0 + tt) * DM + CCH + 8 * lane) = o; }
        __syncthreads();
        n = nn;
    }
#undef CONV_LOAD
}
__device__ __forceinline__ void srow_wave(Frame& F, const Args& a, int b) {
    bf16* __restrict__ AC = (bf16*)(a.ws + WS_AC); bf16* __restrict__ Q = (bf16*)(a.ws + WS_Q); const float* __restrict__ z = (const float*)(a.ws + WS_ZS) + (size_t)b * NIN; const float* __restrict__ rope = (const float*)(a.ws + WS_ROPE) + 2048 * 32;
    float* __restrict__ out = a.out;
    const int lane = F.lane, rl = lane & 15; const size_t qrow = (size_t)MP + b;
    float qn[8], x1[8], x2[8];
#pragma unroll
    for (int h = 0; h < 8; ++h) { qn[h] = z[h * 96 + lane]; x1[h] = z[h * 96 + 64 + rl]; x2[h] = z[h * 96 + 80 + rl]; }
    const float cs = rope[rl], sn = rope[16 + rl], k1 = z[2048 + rl], k2 = z[2064 + rl];
    const f32x4 c = *(const f32x4*)(z + 768 + 4 * lane), kg = *(const f32x4*)(a.in[I_KVG] + 4 * lane);
    const int c0 = 8 * lane, zb = 1024 + 256 * (c0 >> 7) + (c0 & 127);
    const f32x4 ga0 = *(const f32x4*)(z + zb), ga1 = *(const f32x4*)(z + zb + 4), gg0 = *(const f32x4*)(z + zb + 128), gg1 = *(const f32x4*)(z + zb + 132);
#pragma unroll
    for (int h = 0; h < 8; ++h) { Q[qrow * QC + h * 96 + lane] = (bf16)(pk2(qn[h] * QS_MLA, 0.f) & 0xffffu);
        if (lane < 16) { Q[qrow * QC + h * 96 + 64 + lane] = (bf16)(pk2((x1[h] * cs - x2[h] * sn) * QS_MLA, 0.f) & 0xffffu); Q[qrow * QC + h * 96 + 80 + lane] = (bf16)(pk2((x2[h] * cs + x1[h] * sn) * QS_MLA, 0.f) & 0xffffu); } }
    { const float ss = wave_sum((c[0] * c[0] + c[1] * c[1]) + (c[2] * c[2] + c[3] * c[3]));
      const float rs = 1.0f / sqrtf(ss * (1.0f / 256.0f) + LN_EPS); *(f32x4*)(out + O_CKVS + (size_t)b * KVL + 4 * lane) = c * rs * kg; }
    if (lane < 16) { out[O_KRS + (size_t)b * RD + lane] = k1 * cs - k2 * sn; out[O_KRS + (size_t)b * RD + 16 + lane] = k2 * cs + k1 * sn; }
    f32x4 u0, u1;
#pragma unroll
    for (int e = 0; e < 4; ++e) { u0[e] = ga0[e] / (1.0f + __expf(-gg0[e])); u1[e] = ga1[e] / (1.0f + __expf(-gg1[e])); }
    const float* __restrict__ st = a.in[I_SCONV] + (size_t)b * 30 * CCH + c0; const float* __restrict__ cw = a.in[I_CONVW] + c0; float* __restrict__ os = out + O_CONVS + (size_t)b * 30 * CCH + c0;
    *(f32x4*)(os + 29 * CCH) = u0; *(f32x4*)(os + 29 * CCH + 4) = u1;
    f32x4 a0 = *(const f32x4*)(a.in[I_CONVB] + c0), a1 = *(const f32x4*)(a.in[I_CONVB] + c0 + 4);
#pragma unroll 10
    for (int jj = 0; jj < 30; ++jj) { const f32x4 s0 = *(const f32x4*)(st + jj * CCH), s1 = *(const f32x4*)(st + jj * CCH + 4);
        a0 += s0 * *(const f32x4*)(cw + jj * CCH); a1 += s1 * *(const f32x4*)(cw + jj * CCH + 4); }
#pragma unroll 10
    for (int jj = 1; jj < 30; ++jj) { *(f32x4*)(os + (jj - 1) * CCH) = *(const f32x4*)(st + jj * CCH); *(f32x4*)(os + (jj - 1) * CCH + 4) = *(const f32x4*)(st + jj * CCH + 4); }
    a0 += u0 * *(const f32x4*)(cw + 30 * CCH); a1 += u1 * *(const f32x4*)(cw + 30 * CCH + 4);
    const float mean = wave_sum((a0[0] + a0[1]) + (a0[2] + a0[3]) + (a1[0] + a1[1]) + (a1[2] + a1[3])) * (1.0f / CCH);
    a0 = a0 - mean; a1 = a1 - mean;
    const float var = wave_sum((a0[0] * a0[0] + a0[1] * a0[1]) + (a0[2] * a0[2] + a0[3] * a0[3]) + (a1[0] * a1[0] + a1[1] * a1[1]) + (a1[2] * a1[2] + a1[3] * a1[3])) * (1.0f / CCH);
    const float rstd = 1.0f / sqrtf(var + LN_EPS);
    f32x4 y0 = a0 * rstd * *(const f32x4*)(a.in[I_CLNG] + c0) + *(const f32x4*)(a.in[I_CLNB] + c0), y1 = a1 * rstd * *(const f32x4*)(a.in[I_CLNG] + c0 + 4) + *(const f32x4*)(a.in[I_CLNB] + c0 + 4);
#pragma unroll
    for (int e = 0; e < 4; ++e) { y0[e] = y0[e] / (1.0f + __expf(-y0[e])); y1[e] = y1[e] / (1.0f + __expf(-y1[e])); }
    v4u o; o.x = pk2(y0[0], y0[1]); o.y = pk2(y0[2], y0[3]); o.z = pk2(y1[0], y1[1]); o.w = pk2(y1[2], y1[3]);
    *(v4u*)(AC + qrow * DM + CCH + c0) = o;
}

__device__ __forceinline__ void qlat_wave(Frame& F, const Args& a, int unit) {
    const float* __restrict__ z = (const float*)(a.ws + WS_ZS); const float* __restrict__ wuk = a.in[I_WUK]; float* __restrict__ QLAT = (float*)(a.ws + WS_QLAT);
    const int lane = F.lane, r16 = lane & 15, g = lane >> 4, h = unit >> 4, l0 = (unit & 15) * 16;
    f32x4 af[8][2][2], bf_[2][2];
#pragma unroll
    for (int ks = 0; ks < 2; ++ks) { const float* wp = wuk + ((size_t)(l0 + r16) * 8 + h) * 64 + 32 * ks + 8 * g; bf_[ks][0] = *(const f32x4*)wp; bf_[ks][1] = *(const f32x4*)(wp + 4);
#pragma unroll
        for (int mt = 0; mt < 8; ++mt) { const float* zp = z + (size_t)(16 * mt + r16) * NIN + h * 96 + 32 * ks + 8 * g; af[mt][ks][0] = *(const f32x4*)zp; af[mt][ks][1] = *(const f32x4*)(zp + 4); } }
    f32x4 acc[8];
#pragma unroll
    for (int mt = 0; mt < 8; ++mt) acc[mt] = (f32x4){0.f, 0.f, 0.f, 0.f};
#pragma unroll
    for (int ks = 0; ks < 2; ++ks) { v4u bw; bw.x = pk2(bf_[ks][0][0], bf_[ks][0][1]); bw.y = pk2(bf_[ks][0][2], bf_[ks][0][3]); bw.z = pk2(bf_[ks][1][0], bf_[ks][1][1]); bw.w = pk2(bf_[ks][1][2], bf_[ks][1][3]);
        const bf16x8 bfr = __builtin_bit_cast(bf16x8, bw);
#pragma unroll
        for (int mt = 0; mt < 8; ++mt) { const f32x4 a0 = af[mt][ks][0] * QS_MLA, a1 = af[mt][ks][1] * QS_MLA; v4u aw; aw.x = pk2(a0[0], a0[1]); aw.y = pk2(a0[2], a0[3]); aw.z = pk2(a1[0], a1[1]); aw.w = pk2(a1[2], a1[3]);
            acc[mt] = __builtin_amdgcn_mfma_f32_16x16x32_bf16(__builtin_bit_cast(bf16x8, aw), bfr, acc[mt], 0, 0, 0); } }
#pragma unroll
    for (int mt = 0; mt < 8; ++mt)
#pragma unroll
        for (int r = 0; r < 4; ++r) QLAT[((size_t)(16 * mt + 4 * g + r) * 8 + h) * 256 + l0 + r16] = acc[mt][r];
}

__device__ __forceinline__ f32x4 skinny_tile(Frame& F, const bf16* A, int lda, const bf16* Bt, int K, int n0) {
    const int lane = F.lane, w = F.wave, r16 = lane & 15, g = lane >> 4, kw = K >> 3;
    f32x4 acc[8];
#pragma unroll
    for (int mt = 0; mt < 8; ++mt) acc[mt] = (f32x4){0.f, 0.f, 0.f, 0.f};
    const bf16* ap = A + (size_t)r16 * lda + w * kw + 8 * g; const bf16* bp = Bt + (size_t)(n0 + r16) * K + w * kw + 8 * g;
#pragma unroll 1
    for (int kb = 0; kb < kw; kb += 128) {
        bf16x8 bf[4], af[4][8];
#pragma unroll
        for (int ks = 0; ks < 4; ++ks) { bf[ks] = *(const bf16x8*)(bp + kb + 32 * ks);
#pragma unroll
            for (int mt = 0; mt < 8; ++mt) af[ks][mt] = *(const bf16x8*)(ap + (size_t)(16 * mt) * lda + kb + 32 * ks); }
        __builtin_amdgcn_sched_barrier(0);
#pragma unroll
        for (int ks = 0; ks < 4; ++ks)
#pragma unroll
            for (int mt = 0; mt < 8; ++mt) acc[mt] = __builtin_amdgcn_mfma_f32_16x16x32_bf16(af[ks][mt], bf[ks], acc[mt], 0, 0, 0);
    }
    LAS float* red = (LAS float*)F.lds;
#pragma unroll
    for (int mt = 0; mt < 8; ++mt) *(LAS f32x4*)(red + (w * 16 + r16) * 128 + 16 * mt + 4 * g) = acc[mt];
    __syncthreads();
    const int row = F.tid >> 2, c4 = (F.tid & 3) * 4; f32x4 v = (f32x4){0.f, 0.f, 0.f, 0.f};
#pragma unroll
    for (int k = 0; k < 8; ++k)
#pragma unroll
        for (int j = 0; j < 4; ++j) v[j] += red[(k * 16 + c4 + j) * 128 + row];
    return v;
}
__device__ __forceinline__ void sample_stats(Frame& F, const float* sslot) {
    const int row = F.tid >> 2, part = F.tid & 3; float s1 = 0.f, s2 = 0.f;
#pragma unroll
    for (int i = 0; i < 16; ++i) { const f32x2 p = *(const f32x2*)(sslot + ((size_t)row * 64 + part * 16 + i) * 2); s1 += p[0]; s2 += p[1]; }
    s1 += __shfl_xor(s1, 1); s1 += __shfl_xor(s1, 2); s2 += __shfl_xor(s2, 1); s2 += __shfl_xor(s2, 2);
    const float mean = s1 * (1.0f / DM), var = s2 * (1.0f / DM) - mean * mean;
    if (part == 0) *(LAS f32x2*)(F.lds + 65536 + row * 8) = (f32x2){mean, 1.0f / sqrtf(var + LN_EPS)};
}
__device__ __forceinline__ void slice_stats_store(Frame& F, float* sslot, int unit, f32x4 v) {
    float s1 = (v[0] + v[1]) + (v[2] + v[3]), s2 = (v[0] * v[0] + v[1] * v[1]) + (v[2] * v[2] + v[3] * v[3]);
    s1 += __shfl_xor(s1, 1); s1 += __shfl_xor(s1, 2); s2 += __shfl_xor(s2, 1); s2 += __shfl_xor(s2, 2);
    if ((F.tid & 3) == 0) st_wt8(sslot + ((size_t)(F.tid >> 2) * 64 + unit) * 2, __builtin_bit_cast(unsigned, s1), __builtin_bit_cast(unsigned, s2));
}
template <int WHICH> __device__ __forceinline__ void sample_gemm(Frame& F, const Args& a) {
    unsigned char* ws = a.ws; const float* vec = (const float*)(ws + WS_VEC);
    constexpr int NU = WHICH == 1 ? INC / 16 : (WHICH == 9 ? FF / 16 : DM / 16);
    constexpr bool DYN = true;
    constexpr int PREV = WHICH == 6 ? 5 : (WHICH == 9 ? 8 : (WHICH == 10 ? 9 : -1)), NUPREV = WHICH == 10 ? FF / 16 : DM / 16;
    LAS unsigned* lw = (LAS unsigned*)(F.lds + 67584);
    bool first = true;
    for (int u = F.vcu;; u += F.G) {
        if (DYN) {
            if (F.wave == 0) { unsigned gv = 0u;
                if (F.lane == 0) gv = __hip_atomic_fetch_add(F.ctl + CW_SKG + 64 * WHICH, 1u, RLX_AGENT);
                gv = (unsigned)__builtin_amdgcn_readfirstlane((int)gv); if (F.lane == 0) lw[0] = gv; }
            __syncthreads(); u = __builtin_amdgcn_readfirstlane((int)lw[0]); __syncthreads(); }
        if (u >= NU) break;
        if (DYN && first && PREV >= 0) wait_count(F, F.ctl + CW_SKD + 64 * (PREV >= 0 ? PREV : 0), (unsigned)NUPREV);
        first = false;
        const int n0 = 16 * u, row = F.tid >> 2, col = n0 + (F.tid & 3) * 4; const size_t ro = (size_t)(MP + row) * DM + col;
        if (WHICH == 1) { const f32x4 v = skinny_tile(F, (const bf16*)(ws + WS_XB) + (size_t)MP * DM, DM, (const bf16*)(ws + WS_WIN), DM, n0); st_wt16((float*)(ws + WS_ZS) + (size_t)row * NIN + col, v); }
        if (WHICH == 5) { const f32x4 xs = *(const f32x4*)(a.in[I_XS] + (size_t)row * DM + col);
            f32x4 v = skinny_tile(F, (const bf16*)(ws + WS_AC) + (size_t)MP * DM, DM, (const bf16*)(ws + WS_WO), DM, n0);
            v += ALPHA * xs;
            st_bf4_wt((bf16*)(ws + WS_X1B) + ro, v); slice_stats_store(F, (float*)(ws + WS_SSL1), u, v); }
        if (WHICH == 6) { sample_stats(F, (const float*)(ws + WS_SSL1)); const f32x4 cs = *(const f32x4*)(vec + VO_CSQ + col), bw = *(const f32x4*)(vec + VO_BWQ + col);
            f32x4 v = skinny_tile(F, (const bf16*)(ws + WS_X1B) + (size_t)MP * DM, DM, (const bf16*)(ws + WS_WXQ), DM, n0);
            const f32x2 st = *(const LAS f32x2*)(F.lds + 65536 + row * 8);
            v = ((v - st[0] * cs) * st[1] + bw) * QS_MEM; st_bf4_wt((bf16*)(ws + WS_QX) + ro, v); }
        if (WHICH == 8) { sample_stats(F, (const float*)(ws + WS_SSL1)); const v2u pw = *(const v2u*)((const bf16*)(ws + WS_X1B) + ro); const f32x4 g1 = *(const f32x4*)(a.in[I_LN1G] + col), b1 = *(const f32x4*)(a.in[I_LN1B] + col);
            f32x4 v = skinny_tile(F, (const bf16*)(ws + WS_OX) + (size_t)MP * DM, DM, (const bf16*)(ws + WS_WXO), DM, n0);
            const f32x2 st = *(const LAS f32x2*)(F.lds + 65536 + row * 8);
            const f32x4 pv = (f32x4){bflo(pw.x), bfhi(pw.x), bflo(pw.y), bfhi(pw.y)};
            const f32x4 x1 = (pv - st[0]) * st[1] * g1 + b1;
            v += ALPHA * x1; st_bf4_wt((bf16*)(ws + WS_X2B) + ro, v); slice_stats_store(F, (float*)(ws + WS_SSL2), u, v); }
        if (WHICH == 9) { sample_stats(F, (const float*)(ws + WS_SSL2)); const f32x4 cs = *(const f32x4*)(vec + VO_CSU + col), bw = *(const f32x4*)(vec + VO_BWU + col);
            f32x4 v = skinny_tile(F, (const bf16*)(ws + WS_X2B) + (size_t)MP * DM, DM, (const bf16*)(ws + WS_WUP), DM, n0);
            const f32x2 st = *(const LAS f32x2*)(F.lds + 65536 + row * 8);
            v = (v - st[0] * cs) * st[1] + bw;
#pragma unroll
            for (int j = 0; j < 4; ++j) { const float t = fmaxf(v[j], 0.f); v[j] = t * t; }
            st_bf4_wt((bf16*)(ws + WS_H) + (size_t)(MP + row) * FF + col, v); }
        if (WHICH == 10) { sample_stats(F, (const float*)(ws + WS_SSL2)); const v2u pw = *(const v2u*)((const bf16*)(ws + WS_X2B) + ro); const f32x4 g2 = *(const f32x4*)(a.in[I_LN2G] + col), b2 = *(const f32x4*)(a.in[I_LN2B] + col);
            f32x4 v = skinny_tile(F, (const bf16*)(ws + WS_H) + (size_t)MP * FF, FF, (const bf16*)(ws + WS_WDN), FF, n0);
            const f32x2 st = *(const LAS f32x2*)(F.lds + 65536 + row * 8);
            const f32x4 pv = (f32x4){bflo(pw.x), bfhi(pw.x), bflo(pw.y), bfhi(pw.y)};
            const f32x4 x2 = (pv - st[0]) * st[1] * g2 + b2;
            v += ALPHA * x2; st_bf4_wt((bf16*)(ws + WS_OX) + ro, v); }
        if (DYN) { asm volatile("s_waitcnt vmcnt(0)" ::: "memory"); }
        __syncthreads();
        if (DYN && F.wave == 0) { if (F.lane == 0) __hip_atomic_fetch_add(F.ctl + CW_SKD + 64 * WHICH, 1u, RLX_AGENT); }
    }
}

constexpr int N_PHASES = 11;
#ifndef REP_P0
#define REP_P0 1
#endif
#ifndef REP_CONV
#define REP_CONV 1
#endif
#ifndef REP_SK
#define REP_SK 1
#endif
#ifndef REP_LN
#define REP_LN 1
#endif
#define REPEAT_1(...) __VA_ARGS__
#define REPEAT_2(...) __VA_ARGS__ __VA_ARGS__
#define REPEAT_X(n, ...) REPEAT_##n(__VA_ARGS__)
#define REPEAT(n, ...) REPEAT_X(n, __VA_ARGS__)
#ifndef REP_G1
#define REP_G1 1
#endif
#ifndef REP_G2
#define REP_G2 1
#endif
#ifndef REP_G4
#define REP_G4 1
#endif
#ifndef REP_G5
#define REP_G5 1
#endif
#ifndef REP_G7
#define REP_G7 1
#endif
#ifndef REP_G8
#define REP_G8 1
#endif
#ifndef REP_G9
#define REP_G9 1
#endif

#ifndef REP_DEC
#define REP_DEC 1
#endif
#ifndef REP_MLA
#define REP_MLA 1
#endif
#ifndef REP_CR
#define REP_CR 1
#endif
#ifndef REP_SCR
#define REP_SCR 1
#endif
#if defined(PROBE_PH)
#define STAMP(i) do { if (blockIdx.x == 0 && F.tid == 0) F.MISC[16 + (i)] = (unsigned)__builtin_amdgcn_s_memrealtime(); } while (0)
#ifndef PROBE_A
#define PROBE_A (16 + PROBE_PH)
#endif
#ifndef PROBE_B
#define PROBE_B (17 + PROBE_PH)
#endif
#define GSTAMP(k) do { if (PROBE_PH == (k) && blockIdx.x == 0 && F.tid == 0) F.MISC[11] = (unsigned)__builtin_amdgcn_s_memrealtime(); } while (0)
#else
#define STAMP(i) do { } while (0)
#define GSTAMP(k) do { } while (0)
#endif
__global__ void __launch_bounds__(NWAVES * 64, 2) fwd_kernel(Args args) {
    extern __shared__ __attribute__((aligned(16))) unsigned char lds[];
    Frame F;
    F.lds = (LAS unsigned char*)lds;
    F.MISC = (volatile LAS unsigned*)(F.lds + MISC_OFF);
    F.tid = threadIdx.x; F.lane = F.tid & 63; F.wave = __builtin_amdgcn_readfirstlane(F.tid >> 6);
    F.G = gridDim.x; { const int bx = blockIdx.x; F.vcu = (F.G % 8 == 0) ? (bx % 8) * (F.G / 8) + bx / 8 : bx; }
    unsigned char* ws = args.ws;
    F.ctl = (gu32*)(ws + WS_CTL);
    if (F.tid < 32) F.MISC[F.tid] = 0u;
    __syncthreads();
    XcdBarrier bar = xcd_barrier_post((unsigned*)(F.ctl + CW_BAR), F.MISC + 8);
    STAMP(0);
    const int lo = args.ph_lo, hi = args.ph_hi;
#ifndef PHMASK
#define PHMASK 0x7ff
#endif
#define IN(k) (((PHMASK >> (k)) & 1) && lo <= (k) && (k) < hi)
#define SEAM(k) do { if (IN(k) && IN((k) + 1)) xcd_barrier(bar); STAMP((k) + 1); asm volatile("" : "+v"(F.tid)); F.lane = F.tid & 63; } while (0)
    typedef pg8::bf16_t pb;

    if (IN(0)) { REPEAT(REP_P0, p0_prologue(F, args);) }
    SEAM(0);
    if (IN(1)) {
        pg8::Gemm g{(const pb*)(ws + WS_XB), (const pb*)(ws + WS_WIN), MT + MMEM, NIN + 2048, DM}; InOrder S; S.init(F.G, (int)blockIdx.x);
        EpiIn E{(bf16*)(ws + WS_Q), (bf16*)(ws + WS_CKV), (bf16*)(ws + WS_KR), (bf16*)(ws + WS_U), (bf16*)(ws + WS_MKB), (bf16*)(ws + WS_MVB), args.out, (const float*)(ws + WS_ROPE), args.in[I_KVG], (LAS float*)(F.lds + XL_OFF)};
        REPEAT(REP_G1, pg8::gemm_phase<EpiIn, InOrder, true, true>(F.lds + RING_OFF, g, S, E);)
        GSTAMP(1);
        xcd_arrive(bar);
        { float* vec = (float*)(ws + WS_VEC);
          for (int i = F.vcu * 512 + F.tid; i < 2 * 1024 + 2 * 4096; i += F.G * 512) {
              const float* p; int n, ld; float* o;
              if (i < 1024) { p = vec + VO_PCSQ; n = i; ld = 1024; o = vec + VO_CSQ; } else if (i < 2048) { p = vec + VO_PBWQ; n = i - 1024; ld = 1024; o = vec + VO_BWQ; }
              else if (i < 6144) { p = vec + VO_PCSU; n = i - 2048; ld = 4096; o = vec + VO_CSU; } else { p = vec + VO_PBWU; n = i - 6144; ld = 4096; o = vec + VO_BWU; }
              float sacc = 0.f;
#pragma unroll
              for (int k = 0; k < 16; ++k) sacc += p[k * ld + n];
              o[n] = sacc; } }
        sample_gemm<1>(F, args);
        xcd_wait(bar); STAMP(2); asm volatile("" : "+v"(F.tid)); F.lane = F.tid & 63;
    }
    if (IN(2)) {
        int kk_ = KVL; asm volatile("" : "+s"(kk_));
        pg8::Gemm g{(const pb*)(ws + WS_CKV), (const pb*)(ws + WS_WUKV), MP, 1024, kk_}; pg8::StaticOrder S; S.init(MP, 1024, F.G, (int)blockIdx.x);
        EpiB<0> E{(bf16*)(ws + WS_KN), 512, 512, (size_t)(WS_VV - WS_KN) / 2, 1.0f};
        REPEAT(REP_G2, pg8::gemm_phase<EpiB<0>, pg8::StaticOrder, true, true>(F.lds + RING_OFF, g, S, E);)
        GSTAMP(2);
        __syncthreads();
        REPEAT(REP_CONV, conv_phase(F, args);)
        xcd_arrive(bar);
        wait_count(F, F.ctl + CW_SKD + 64 * 1, INC / 16);
        for (int n = F.vcu + F.G * F.wave; n < NS; n += F.G * NWAVES) srow_wave(F, args, n);
        if (F.wave == 1) for (int n = F.vcu; n < 128; n += F.G) qlat_wave(F, args, n);
        if (F.vcu < NS) {
            asm volatile("s_waitcnt vmcnt(0)" ::: "memory"); __syncthreads();
            if (F.wave == 0) { if (F.lane == 0) { __builtin_amdgcn_fence(__ATOMIC_RELEASE, "agent"); asm volatile("s_waitcnt vmcnt(0)" ::: "memory"); __hip_atomic_fetch_add(F.ctl + CW_SRW, 1u, RLX_AGENT); } } }
        xcd_wait(bar); STAMP(3); asm volatile("" : "+v"(F.tid)); F.lane = F.tid & 63;
    }
    if (IN(3)) {
        for (int rep_ = 0; rep_ < REP_MLA; ++rep_) p3_phase(F, args);
    }
    SEAM(3);
    if (IN(4)) {
        pg8::Gemm g{(const pb*)(ws + WS_AC), (const pb*)(ws + WS_WO), MP, DM, DM}; pg8::StaticOrder S; S.init(MP, DM, F.G, (int)blockIdx.x);
        EpiV<0, 2> E{(bf16*)(ws + WS_X1B), (float*)(ws + WS_SL1), (const bf16*)(ws + WS_XB), nullptr, nullptr, nullptr, (LAS float*)(F.lds + XL_OFF)};
        REPEAT(REP_G4, pg8::gemm_phase<EpiV<0, 2>, pg8::StaticOrder, true, true>(F.lds + RING_OFF, g, S, E);)
        GSTAMP(4);
        xcd_arrive(bar);
        sample_gemm<5>(F, args);
        xcd_wait(bar); STAMP(5); asm volatile("" : "+v"(F.tid)); F.lane = F.tid & 63;
    }
    if (IN(5)) {
        pg8::Gemm g{(const pb*)(ws + WS_X1B), (const pb*)(ws + WS_WXQ), MP, DM, DM}; pg8::StaticOrder S; S.init(MP, DM, F.G, (int)blockIdx.x);
        EpiFold<0> E{(bf16*)(ws + WS_QX), DM, (const float*)(ws + WS_SL1), (const float*)(ws + WS_VEC) + VO_CSQ, (const float*)(ws + WS_VEC) + VO_BWQ, QS_MEM};
        REPEAT(REP_G5, pg8::gemm_phase<EpiFold<0>, pg8::StaticOrder, true, true>(F.lds + RING_OFF, g, S, E);)
        GSTAMP(5);
        xcd_arrive(bar);
        sample_gemm<6>(F, args);
        xcd_wait(bar); STAMP(6); asm volatile("" : "+v"(F.tid)); F.lane = F.tid & 63;
    }
    if (IN(6)) {
        for (int rep_ = 0; rep_ < REP_CR; ++rep_) for (int n = F.vcu; n < NBATCH * 4 * 8; n += F.G) cross_unit32(F, args, n >> 3, n & 7);
        wait_count(F, F.ctl + CW_SKD + 64 * 6, DM / 16);
        for (int rep_ = 0; rep_ < REP_SCR; ++rep_) for (int n = F.vcu; n < NS * 2; n += F.G) scross_unit(F, args, n >> 1, n & 1);
    }
    SEAM(6);
    if (IN(7)) {
        pg8::Gemm g{(const pb*)(ws + WS_OX), (const pb*)(ws + WS_WXO), MP, DM, DM}; pg8::StaticOrder S; S.init(MP, DM, F.G, (int)blockIdx.x);
        EpiV<1, 1> E{(bf16*)(ws + WS_X2B), (float*)(ws + WS_SL2), (const bf16*)(ws + WS_X1B), (const float*)(ws + WS_SL1), args.in[I_LN1G], args.in[I_LN1B], (LAS float*)(F.lds + XL_OFF)};
        REPEAT(REP_G7, pg8::gemm_phase<EpiV<1, 1>, pg8::StaticOrder, true, true>(F.lds + RING_OFF, g, S, E);)
        GSTAMP(7);
        xcd_arrive(bar);
        sample_gemm<8>(F, args);
        xcd_wait(bar); STAMP(8); asm volatile("" : "+v"(F.tid)); F.lane = F.tid & 63;
    }
    if (IN(8)) {
        pg8::Gemm g{(const pb*)(ws + WS_X2B), (const pb*)(ws + WS_WUP), MP, FF, DM}; pg8::StaticOrder S; S.init(MP, FF, F.G, (int)blockIdx.x);
        EpiFold<1> E{(bf16*)(ws + WS_H), FF, (const float*)(ws + WS_SL2), (const float*)(ws + WS_VEC) + VO_CSU, (const float*)(ws + WS_VEC) + VO_BWU, 1.0f};
        REPEAT(REP_G8, pg8::gemm_phase<EpiFold<1>, pg8::StaticOrder, true, true>(F.lds + RING_OFF, g, S, E);)
        GSTAMP(8);
        xcd_arrive(bar);
        sample_gemm<9>(F, args);
        xcd_wait(bar); STAMP(9); asm volatile("" : "+v"(F.tid)); F.lane = F.tid & 63;
    }
    if (IN(9)) {
        pg8::Gemm g{(const pb*)(ws + WS_H), (const pb*)(ws + WS_WDN), MP, DM, FF}; pg8::StaticOrder S; S.init(MP, DM, F.G, (int)blockIdx.x);
        EpiV<1, 2> E{(bf16*)(ws + WS_OX), nullptr, (const bf16*)(ws + WS_X2B), (const float*)(ws + WS_SL2), args.in[I_LN2G], args.in[I_LN2B], (LAS float*)(F.lds + XL_OFF)};
        REPEAT(REP_G9, pg8::gemm_phase<EpiV<1, 2>, pg8::StaticOrder, true, true>(F.lds + RING_OFF, g, S, E);)
        GSTAMP(9);
        xcd_arrive(bar);
        sample_gemm<10>(F, args);
        xcd_wait(bar); STAMP(10); asm volatile("" : "+v"(F.tid)); F.lane = F.tid & 63;
    }
    if (IN(10)) {
        REPEAT(REP_LN, ln_final(F, (const bf16*)(ws + WS_OX), args.in[I_LN3G], args.in[I_LN3B], args.out, 0, MREAL, F.ctl + CW_SKD + 64 * 10, DM / 16);)
    }
#if defined(PROBE_PH)
    __syncthreads(); STAMP(11); __syncthreads();
    if (blockIdx.x == 0) { const unsigned dt = F.MISC[PROBE_B] - F.MISC[PROBE_A];
        const float sc = 1.0f + sqrtf((float)dt * 1e-5f);
        for (int i = F.tid; i < NS * RD; i += NWAVES * 64) args.out[O_KRS + i] *= sc; }
#endif
#undef IN
#undef SEAM
}

#ifndef MK_PER_PHASE
#define MK_PER_PHASE 0
#endif
extern "C" void kernel_launch(void* const* d_in, const int* in_sizes, int n_in, void* d_out, int out_size, void* d_ws, size_t ws_size, hipStream_t stream) {
    static int grid = 0;
    if (grid == 0) {
        if (n_in != 30 || out_size != (int)O_END || ws_size < WS_END) { fprintf(stderr, "kernel_launch: unexpected problem (n_in %d, out %d, ws %zu); nothing launched\n", n_in, out_size, ws_size); grid = -1; return; }
        int dev = 0, cus = 0, per_cu = 0;
        if (hipGetDevice(&dev) != hipSuccess || hipDeviceGetAttribute(&cus, hipDeviceAttributeMultiprocessorCount, dev) != hipSuccess) { grid = -1; return; }
        if (hipFuncSetAttribute((const void*)fwd_kernel, hipFuncAttributeMaxDynamicSharedMemorySize, LDS_BYTES) != hipSuccess) { fprintf(stderr, "kernel_launch: hipFuncSetAttribute failed\n"); grid = -1; return; }
        if (hipOccupancyMaxActiveBlocksPerMultiprocessor(&per_cu, (const void*)fwd_kernel, NWAVES * 64, LDS_BYTES) != hipSuccess || per_cu < 1) { fprintf(stderr, "kernel_launch: occupancy query says %d\n", per_cu); }
        (void)hipGetLastError();
        grid = cus;
    }
    if (grid < 0) return;
    if (hipMemsetAsync((char*)d_ws + WS_CTL, 0, CTL_ZERO_BYTES, stream) != hipSuccess) return;
    Args a{};
    for (int i = 0; i < 30; ++i) a.in[i] = (const float*)d_in[i];
    a.out = (float*)d_out; a.ws = (unsigned char*)d_ws;
#if MK_PER_PHASE
    for (int p = 0; p < N_PHASES; ++p) { a.ph_lo = p; a.ph_hi = p + 1; hipLaunchKernelGGL(fwd_kernel, dim3(grid), dim3(NWAVES * 64), LDS_BYTES, stream, a); }
#else
    a.ph_lo = 0; a.ph_hi = N_PHASES;
    hipLaunchKernelGGL(fwd_kernel, dim3(grid), dim3(NWAVES * 64), LDS_BYTES, stream, a);
#endif
    (void)in_sizes;
}
```

```cpp
#include <hip/hip_runtime.h>
#include <cstdio>
#include <cstdint>
namespace pg8 {
#define PG8_LAS __attribute__((address_space(3)))
typedef unsigned short bf16_t;
typedef short bf16x8 __attribute__((ext_vector_type(8)));
typedef float f32x4 __attribute__((ext_vector_type(4)));
typedef unsigned u32x4 __attribute__((ext_vector_type(4)));
constexpr int BM = 256, BK = 64, HALF = 128, HTB = HALF * BK * 2  , STAGE_BYTES = 8 * HTB, NXCD = 8, WGM = 8;

__host__ __device__ __forceinline__ int lds_byte(int r, int c) { const int st = (r >> 4) * 2 + (c >> 5), rr = r & 15, cc = c & 31, ob = rr * 64 + cc * 2; return st * 1024 + (ob ^ (((ob >> 9) & 1) << 5)); }
__host__ __device__ __forceinline__ void stage_rc(int b, int& R, int& C) { const int st = b / 1024, sb = b % 1024, swz = sb ^ (((sb >> 9) & 1) << 5); R = (st >> 1) * 16 + swz / 64; C = (st & 1) * 32 + (swz % 64) / 2; }
__host__ __device__ __forceinline__ int perm32(int rho) { const int n = rho >> 4, i = rho & 15; return 8 * (i >> 2) + 4 * n + (i & 3); }

struct Unit { int pm, pn; };
struct Gemm { const bf16_t* A; const bf16_t* Bt; int M, N, K; };

struct StaticOrder {
    int nM, nN, nwg, G, c;
    __host__ __device__ void init(int M, int N, int G_, int c_) { nM = M / BM; nN = N / BM; nwg = nM * nN; G = G_; c = c_; }
    __host__ __device__ bool next(int i, Unit& u) const {
        const long L = (long)i * G + c; if (L >= nwg) return false;
        int wgid = (int)L; { const int q = nwg / NXCD, r = nwg % NXCD, xcd = wgid % NXCD, off = wgid / NXCD; wgid = (xcd < r ? xcd * (q + 1) : r * (q + 1) + (xcd - r) * q) + off; }
        const int nig = WGM * nN, gid = wgid / nig, fm = gid * WGM, gsz = (nM - fm) < WGM ? (nM - fm) : WGM;
        u.pm = fm + ((wgid % nig) % gsz); u.pn = (wgid % nig) / gsz; return true;
    }
    __device__ __forceinline__ void a_ready(const Unit&) const {}
    __device__ __forceinline__ void done(const Unit&) const {}
};


template <class Epi, class Sched, bool ALIGN_EPI = false, bool SP2 = false>
__device__ __forceinline__ void gemm_phase(PG8_LAS unsigned char* lds, const Gemm g, const Sched& S, const Epi& E) {
    const int tid = threadIdx.x, wid = __builtin_amdgcn_readfirstlane(tid >> 6), lane = tid & 63, wr = wid >> 2, wc = wid & 3, fr = lane & 15, fq = lane >> 4;
    const int K = g.K, nt = K / BK;
    unsigned voffA[2], voffB[2];
#pragma unroll
    for (int i = 0; i < 2; ++i) { int R, C; stage_rc(tid * 16 + i * 8192, R, C); const int Rb = Epi::PERM ? ((R & ~31) + perm32(R & 31)) : R;
        voffA[i] = (unsigned)(R * K + C) * 2u; voffB[i] = (unsigned)(Rb * K + C) * 2u; }
    const size_t kstep = (size_t)(BK * 2);
    const size_t hstep = (size_t)HALF * K * 2;
    const size_t tstep = 2 * hstep;
    const unsigned ldsw = (unsigned)wid * 1024u;
    const int aoff = lds_byte(wr * 64 + fr, fq * 8), boff = lds_byte(wc * 32 + fr, fq * 8);
#define PG8_SA(b, h) (((b) * 2 + (h)) * HTB)
#define PG8_SB(b, h) ((4 + (b) * 2 + (h)) * HTB)
#define PG8_STAGE(bufoff, gbase, voff) do { _Pragma("unroll") for (int _i = 0; _i < 2; ++_i) \
        __builtin_amdgcn_global_load_lds((const unsigned*)((const char*)(gbase) + (voff)[_i]), (PG8_LAS unsigned*)(lds + (bufoff) + ldsw + _i * 8192), 16, 0, 0); } while (0)
#define PG8_LDA(dst, b, h) do { _Pragma("unroll") for (int m = 0; m < 4; ++m) _Pragma("unroll") for (int k = 0; k < 2; ++k) dst[m][k] = *(const PG8_LAS bf16x8*)(lds + PG8_SA(b, h) + aoff + m * 2048 + k * 1024); } while (0)
#define PG8_LDB(dst, b, h) do { _Pragma("unroll") for (int n = 0; n < 2; ++n) _Pragma("unroll") for (int k = 0; k < 2; ++k) dst[n][k] = *(const PG8_LAS bf16x8*)(lds + PG8_SB(b, h) + boff + n * 2048 + k * 1024); } while (0)
#define PG8_MMA(ai, bj, At, Bt) do { __builtin_amdgcn_s_setprio(1); _Pragma("unroll") for (int m = 0; m < 4; ++m) _Pragma("unroll") for (int n = 0; n < 2; ++n) _Pragma("unroll") for (int k = 0; k < 2; ++k) \
        acc[ai][bj][m][n] = __builtin_amdgcn_mfma_f32_16x16x32_bf16(Bt[n][k], At[m][k], acc[ai][bj][m][n], 0, 0, 0); __builtin_amdgcn_s_setprio(0); } while (0)
#define PG8_WAIT_V(n) asm volatile("s_waitcnt vmcnt(" #n ")" ::: "memory")
#define PG8_WAIT_L(n) asm volatile("s_waitcnt lgkmcnt(" #n ")" ::: "memory")
#define PG8_BAR __builtin_amdgcn_s_barrier()
#define PG8_SCHED __builtin_amdgcn_sched_barrier(0)
    Unit cur, nxt; int ui = 0;
    if (!S.next(0, cur)) return;
    f32x4 acc[2][2][4][2];
#pragma unroll
    for (int a = 0; a < 2; ++a)
#pragma unroll
        for (int b = 0; b < 2; ++b)
#pragma unroll
            for (int m = 0; m < 4; ++m)
#pragma unroll
                for (int n = 0; n < 2; ++n) acc[a][b][m][n] = (f32x4){0.f, 0.f, 0.f, 0.f};
    bf16x8 At[4][2], B0[2][2], B1[2][2];
    const char* cA = (const char*)g.A + (size_t)cur.pm * tstep; const char* cB = (const char*)g.Bt + (size_t)cur.pn * tstep;
    S.a_ready(cur);
    if constexpr (SP2) {
        PG8_STAGE(PG8_SB(0, 0), cB, voffB); PG8_STAGE(PG8_SB(0, 1), cB + hstep, voffB); PG8_STAGE(PG8_SA(0, 0), cA, voffA); PG8_STAGE(PG8_SA(0, 1), cA + hstep, voffA);
        if (wr == 1) PG8_BAR;
        PG8_WAIT_V(2); PG8_BAR;
        PG8_STAGE(PG8_SB(1, 0), cB + kstep, voffB); PG8_STAGE(PG8_SA(1, 0), cA + kstep, voffA); PG8_STAGE(PG8_SB(1, 1), cB + hstep + kstep, voffB);
        PG8_WAIT_V(6); PG8_BAR;
    } else {
        PG8_STAGE(PG8_SB(0, 0), cB, voffB); PG8_STAGE(PG8_SA(0, 0), cA, voffA); PG8_STAGE(PG8_SB(0, 1), cB + hstep, voffB); PG8_STAGE(PG8_SA(0, 1), cA + hstep, voffA);
        if (wr == 1) PG8_BAR;
        PG8_WAIT_V(4); PG8_BAR;
        PG8_STAGE(PG8_SB(1, 0), cB + kstep, voffB); PG8_STAGE(PG8_SA(1, 0), cA + kstep, voffA); PG8_STAGE(PG8_SB(1, 1), cB + hstep + kstep, voffB);
        PG8_WAIT_V(6); PG8_BAR;
    }
    for (;;) {
        const bool has_next = S.next(ui + 1, nxt);
        const char* nA = has_next ? (const char*)g.A + (size_t)nxt.pm * tstep : cA; const char* nB = has_next ? (const char*)g.Bt + (size_t)nxt.pn * tstep : cB;
        for (int t = 0; t < nt; t += 2) {
            const bool last = (t == nt - 2);
            const char* a1 = cA + (size_t)(t + 1) * kstep;
            const char* a2 = last ? nA : cA + (size_t)(t + 2) * kstep; const char* b2 = last ? nB : cB + (size_t)(t + 2) * kstep;
            const char* a3 = a2 + kstep; const char* b3 = b2 + kstep;
            if (last && has_next) S.a_ready(nxt);
            if constexpr (SP2) {
            PG8_LDB(B0, 0, 0); PG8_LDB(B1, 0, 1); PG8_SCHED; PG8_LDA(At, 0, 0); PG8_STAGE(PG8_SA(1, 1), a1 + hstep, voffA);
            PG8_WAIT_V(8); PG8_WAIT_L(0); PG8_BAR; PG8_MMA(0, 0, At, B0); PG8_MMA(0, 1, At, B1); PG8_BAR; PG8_SCHED;
            PG8_LDA(At, 0, 1); PG8_STAGE(PG8_SB(0, 0), b2, voffB); PG8_STAGE(PG8_SB(0, 1), b2 + hstep, voffB); PG8_STAGE(PG8_SA(0, 0), a2, voffA);
            PG8_WAIT_V(8); PG8_WAIT_L(0); PG8_BAR; PG8_MMA(1, 0, At, B0); PG8_MMA(1, 1, At, B1); PG8_BAR; PG8_SCHED;
            PG8_LDB(B0, 1, 0); PG8_LDB(B1, 1, 1); PG8_SCHED; PG8_LDA(At, 1, 0); PG8_STAGE(PG8_SA(0, 1), a2 + hstep, voffA);
            PG8_WAIT_V(8); PG8_WAIT_L(0); PG8_BAR; PG8_MMA(0, 0, At, B0); PG8_MMA(0, 1, At, B1); PG8_BAR; PG8_SCHED;
            PG8_LDA(At, 1, 1); PG8_STAGE(PG8_SB(1, 0), b3, voffB); PG8_STAGE(PG8_SB(1, 1), b3 + hstep, voffB); PG8_STAGE(PG8_SA(1, 0), a3, voffA);
            PG8_WAIT_V(8); PG8_WAIT_L(0); PG8_BAR; PG8_MMA(1, 0, At, B0); PG8_MMA(1, 1, At, B1); PG8_BAR; PG8_SCHED;
            } else {
            PG8_LDB(B0, 0, 0); PG8_SCHED; PG8_LDA(At, 0, 0); PG8_STAGE(PG8_SA(1, 1), a1 + hstep, voffA);
            PG8_WAIT_L(8); PG8_BAR; PG8_WAIT_L(0); PG8_MMA(0, 0, At, B0); PG8_BAR; PG8_SCHED;
            PG8_LDB(B1, 0, 1); PG8_STAGE(PG8_SB(0, 0), b2, voffB);
            PG8_BAR; PG8_WAIT_L(0); PG8_MMA(0, 1, At, B1); PG8_BAR;
            PG8_LDA(At, 0, 1); PG8_STAGE(PG8_SA(0, 0), a2, voffA);
            PG8_BAR; PG8_WAIT_L(0); PG8_MMA(1, 0, At, B0); PG8_BAR; PG8_SCHED;
            PG8_STAGE(PG8_SB(0, 1), b2 + hstep, voffB);
            PG8_WAIT_V(6); PG8_BAR; PG8_MMA(1, 1, At, B1); PG8_BAR;
            PG8_LDB(B0, 1, 0); PG8_SCHED; PG8_LDA(At, 1, 0); PG8_STAGE(PG8_SA(0, 1), a2 + hstep, voffA);
            PG8_WAIT_L(8); PG8_BAR; PG8_WAIT_L(0); PG8_MMA(0, 0, At, B0); PG8_BAR; PG8_SCHED;
            PG8_LDB(B1, 1, 1); PG8_STAGE(PG8_SB(1, 0), b3, voffB);
            PG8_BAR; PG8_WAIT_L(0); PG8_MMA(0, 1, At, B1); PG8_BAR;
            PG8_LDA(At, 1, 1); PG8_STAGE(PG8_SA(1, 0), a3, voffA);
            PG8_BAR; PG8_WAIT_L(0); PG8_MMA(1, 0, At, B0); PG8_BAR; PG8_SCHED;
            PG8_STAGE(PG8_SB(1, 1), b3 + hstep, voffB);
            PG8_WAIT_V(6); PG8_BAR; PG8_MMA(1, 1, At, B1); PG8_BAR;
            }
        }
        if constexpr (ALIGN_EPI) { if (wr == 0) PG8_BAR; }
        if constexpr (!Epi::AFTER_DRAIN) { E(acc, cur, wr, wc, fr, fq); S.done(cur); }
        if (!has_next) break;
#pragma unroll
        for (int a = 0; a < 2; ++a)
#pragma unroll
            for (int b = 0; b < 2; ++b)
#pragma unroll
                for (int m = 0; m < 4; ++m)
#pragma unroll
                    for (int n = 0; n < 2; ++n) acc[a][b][m][n] = (f32x4){0.f, 0.f, 0.f, 0.f};
        cur = nxt; cA = nA; cB = nB; ++ui;
        if constexpr (ALIGN_EPI) { if (wr == 1) PG8_BAR; }
    }
    PG8_WAIT_V(0);
    if constexpr (!ALIGN_EPI) { if (wr == 0) PG8_BAR; }
    PG8_BAR;
    if constexpr (Epi::AFTER_DRAIN) { E.fused(acc, cur, wr, wc, fr, fq, lds, wid, lane); S.done(cur); }
#undef PG8_SA
#undef PG8_SB
#undef PG8_STAGE
#undef PG8_LDA
#undef PG8_LDB
#undef PG8_MMA
#undef PG8_WAIT_V
#undef PG8_WAIT_L
#undef PG8_BAR
#undef PG8_SCHED
}
}

constexpr int DM = 1024, NBATCH = 16, SEQ = 2048, MP = NBATCH * SEQ, NS = 128, MT = 33024  , MREAL = MP + NS;
constexpr int MMEM = 4096, MEMT = 256;
constexpr int QC = 768, KVL = 256, RD = 32, CCH = 512, NIN = 2304, FF = 4096, INC = 2080;
constexpr int NPG = 64;
constexpr float LN_EPS = 1e-5f;
constexpr float ALPHA = 1.189207115002721f;
constexpr float LOG2E = 1.4426950408889634f;
constexpr float QS_MLA = 0.10206207261596577f * LOG2E;
constexpr float QS_MEM = 0.0625f * LOG2E;
constexpr size_t O_YP = 0, O_YS = O_YP + (size_t)MP * DM, O_CKVP = O_YS + (size_t)NS * DM, O_KRP = O_CKVP + (size_t)MP * KVL, O_CONVP = O_KRP + (size_t)MP * RD,
                 O_MKP = O_CONVP + (size_t)NBATCH * 30 * CCH, O_MVP = O_MKP + (size_t)MMEM * DM, O_CKVS = O_MVP + (size_t)MMEM * DM, O_KRS = O_CKVS + (size_t)NS * KVL,
                 O_CONVS = O_KRS + (size_t)NS * RD, O_END = O_CONVS + (size_t)NS * 30 * CCH;
static_assert(O_END == 53760000, "output size");

constexpr size_t MiB = 1u << 20;
constexpr size_t WS_CTL = 0, CTL_ZERO_BYTES = 128 * 1024;
constexpr size_t WS_WIN = 2 * MiB;
constexpr size_t WS_WXKV = WS_WIN + (size_t)NIN * DM * 2;
constexpr size_t WS_WUKV = 11 * MiB, WS_WO = 12 * MiB, WS_WXQ = 14 * MiB, WS_WXO = 16 * MiB, WS_WUP = 18 * MiB, WS_WDN = 26 * MiB;
constexpr size_t WS_ROPE = 34 * MiB;
constexpr size_t WS_PART = 35 * MiB, WS_PML = 37 * MiB, WS_QLAT = 38 * MiB;
constexpr size_t WS_VEC = 39 * MiB;
constexpr int VO_CSQ = 0, VO_BWQ = 1024, VO_CSU = 2048, VO_BWU = 6144, VO_PCSQ = 10240, VO_PBWQ = VO_PCSQ + 16 * 1024, VO_PCSU = VO_PBWQ + 16 * 1024, VO_PBWU = VO_PCSU + 16 * 4096, VO_END = VO_PBWU + 16 * 4096;
static_assert(VO_END * 4 <= (int)MiB, "vector region");
constexpr size_t WS_XB = 40 * MiB;
constexpr size_t WS_Q = 113 * MiB, WS_CKV = 162 * MiB, WS_KR = 179 * MiB, WS_U = 182 * MiB, WS_KN = 215 * MiB, WS_VV = 247 * MiB, WS_MKB = 279 * MiB, WS_MVB = 287 * MiB;
constexpr size_t WS_AC = 295 * MiB, WS_V = 360 * MiB, WS_X1 = 489 * MiB, WS_X1B = 618 * MiB, WS_QX = 683 * MiB, WS_OX = 748 * MiB, WS_X2 = 813 * MiB, WS_X2B = 942 * MiB, WS_H = 1007 * MiB;
constexpr size_t WS_SL1 = 1266 * MiB, WS_SL2 = 1268 * MiB;
constexpr size_t WS_SSL1 = 1270 * MiB, WS_SSL2 = 1271 * MiB;
constexpr size_t WS_ZS = 1272 * MiB, WS_XCH = 1274 * MiB, WS_END = 1276 * MiB;
static_assert(WS_WXKV + (size_t)2048 * DM * 2 <= WS_WUKV && WS_XB + (size_t)(MT + MMEM) * DM * 2 <= WS_Q && WS_Q + (size_t)MT * QC * 2 <= WS_CKV && WS_CKV + (size_t)MT * KVL * 2 <= WS_KR &&
              WS_KR + (size_t)MT * RD * 2 <= WS_U && WS_U + (size_t)MT * CCH * 2 <= WS_KN && WS_AC + (size_t)MT * DM * 2 <= WS_V && WS_V + (size_t)MT * DM * 4 <= WS_X1 && WS_X1 + (size_t)MT * DM * 4 <= WS_X1B &&
              WS_X1B + (size_t)MT * DM * 2 <= WS_QX && WS_X2 + (size_t)MT * DM * 4 <= WS_X2B && WS_H + (size_t)MT * FF * 2 <= WS_END, "d_ws map");
constexpr int CW_TMO = 0, CW_CODE = 1, CW_BAR = 4096, CW_CMB = 8192  , CW_SKG = 9216  , CW_SKD = 10240  , CW_SRW = 11264  , CW_SEAM = 16384;

constexpr int RING_OFF = 0, RING_BYTES = 131072;
constexpr int XL_OFF = 131072;
constexpr int LDS_BYTES = 147456, MISC_OFF = LDS_BYTES - 128;
constexpr int NWAVES = 8;

#define GAS __attribute__((address_space(1)))
#define LAS __attribute__((address_space(3)))
typedef unsigned short bf16;
typedef unsigned v4u __attribute__((ext_vector_type(4)));
typedef unsigned v2u __attribute__((ext_vector_type(2)));
typedef float f32x4 __attribute__((ext_vector_type(4)));
typedef float f32x2 __attribute__((ext_vector_type(2)));
typedef float f32x16 __attribute__((ext_vector_type(16)));
typedef short bf16x8 __attribute__((ext_vector_type(8)));
typedef short s16x4 __attribute__((ext_vector_type(4)));
typedef __bf16 bf16x2_t __attribute__((ext_vector_type(2)));
typedef GAS unsigned gu32;
#define RLX_AGENT __ATOMIC_RELAXED, __HIP_MEMORY_SCOPE_AGENT
#define LDS_WAIT() asm volatile("s_waitcnt lgkmcnt(0)" ::: "memory")
#define VM_WAIT() asm volatile("s_waitcnt vmcnt(0)" ::: "memory")
__device__ __forceinline__ unsigned pk2(float lo, float hi) { f32x2 v = {lo, hi}; bf16x2_t b = __builtin_convertvector(v, bf16x2_t); return __builtin_bit_cast(unsigned, b); }
__device__ __forceinline__ float bf2f(unsigned short h) { return __builtin_bit_cast(float, (unsigned)h << 16); }
__device__ __forceinline__ float bflo(unsigned w) { return __builtin_bit_cast(float, w << 16); }
__device__ __forceinline__ float bfhi(unsigned w) { return __builtin_bit_cast(float, w & 0xffff0000u); }
__device__ __forceinline__ float ex2(float x) { return __builtin_amdgcn_exp2f(x); }
__device__ __forceinline__ float wave_sum(float v) {
#pragma unroll
    for (int o = 1; o < 64; o <<= 1) v += __shfl_xor(v, o);
    return v;
}
__device__ __forceinline__ float wave_max(float v) {
#pragma unroll
    for (int o = 1; o < 64; o <<= 1) v = fmaxf(v, __shfl_xor(v, o));
    return v;
}
__device__ __forceinline__ s16x4 tr_read(const LAS unsigned char* p) { return __builtin_bit_cast(s16x4, __builtin_amdgcn_ds_read_tr16_b64_v4i16((LAS s16x4*)p)); }

#define XB_TMO      128
#define XB_XCNT(j)  (256  + 64 * (j))
#define XB_XSUB(j)  (1280 + 64 * (j))
#define XB_XGEN(j)  (2304 + 64 * (j))
#define XB_TOP      3328
#define XB_TOPGEN   3392
#define XCD_BAR_WORDS 3456
#define XB_SPIN_CAP (1u << 18)

__device__ __forceinline__ unsigned xb_ld(unsigned* p)              { return __hip_atomic_load(p, __ATOMIC_RELAXED, __HIP_MEMORY_SCOPE_AGENT); }
__device__ __forceinline__ unsigned xb_add(unsigned* p, unsigned v) { return __hip_atomic_fetch_add(p, v, __ATOMIC_RELAXED, __HIP_MEMORY_SCOPE_AGENT); }
__device__ __forceinline__ unsigned xb_xcc_id() { return (unsigned)__builtin_amdgcn_s_getreg((3 << 11) | 20) & 0xFu; }
#define XB_SPIN(cond, bar) do { unsigned _sp = 0; while (cond) { __builtin_amdgcn_s_sleep(1); \
    if ((++_sp & 255u) == 0u) { if (xb_ld(&(bar)[XB_TMO])) break; if (_sp > XB_SPIN_CAP) { atomicAdd(&(bar)[XB_TMO], 1u); break; } } } } while (0)

struct XcdBarrier {
    unsigned* bar; unsigned x;
    volatile LAS unsigned* st;
};

__device__ __forceinline__ XcdBarrier xcd_barrier_post(unsigned* bar, volatile LAS unsigned* st) {
    XcdBarrier b; b.bar = bar; b.x = xb_xcc_id(); b.st = st;
    if (threadIdx.x == 0) (void)xb_add(&bar[XB_XCNT(b.x)], 1u);
    return b;
}
__device__ __forceinline__ void xcd_barrier_complete(unsigned* bar, unsigned x, unsigned& nloc, unsigned& nx) {
    const unsigned G = gridDim.x * gridDim.y * gridDim.z;
    unsigned sum, cnt, mine, sp = 0u;
    for (;;) {
        sum = 0u; cnt = 0u; mine = 0u;
#pragma unroll
        for (unsigned j = 0; j < 16; ++j) { const unsigned c = xb_ld(&bar[XB_XCNT(j)]); sum += c; cnt += (c > 0u) ? 1u : 0u; mine = (j == x) ? c : mine; }
        if (sum == G) break;
        __builtin_amdgcn_s_sleep(1);
        if ((++sp & 255u) == 0u) { if (xb_ld(&bar[XB_TMO])) break; if (sp > XB_SPIN_CAP) { atomicAdd(&bar[XB_TMO], 1u); break; } }
    }
    nloc = mine > 0u ? mine : 1u; nx = cnt > 0u ? cnt : 1u;
}

__device__ __forceinline__ void xcd_barrier(const XcdBarrier& b) {
    asm volatile("s_waitcnt vmcnt(0)" ::: "memory");
    __syncthreads();
    if (threadIdx.x == 0) {
        unsigned* bar = b.bar;
        __builtin_amdgcn_s_waitcnt(0);
        unsigned nloc = b.st[0], nx = b.st[1];
        if (nloc == 0u) { xcd_barrier_complete(bar, b.x, nloc, nx); b.st[0] = nloc; b.st[1] = nx; }
        const unsigned old = xb_add(&bar[XB_XSUB(b.x)], 1u);
        const unsigned gen = old / nloc;
        if (old + 1u == (gen + 1u) * nloc) {
            __builtin_amdgcn_fence(__ATOMIC_RELEASE, "agent");
            asm volatile("s_waitcnt vmcnt(0)" ::: "memory");
            const unsigned og = xb_add(&bar[XB_TOP], 1u);
            const unsigned tg = og / nx;
            if (og + 1u == (tg + 1u) * nx) xb_add(&bar[XB_TOPGEN], 1u);
            else XB_SPIN(xb_ld(&bar[XB_TOPGEN]) == tg, bar);
            __builtin_amdgcn_fence(__ATOMIC_ACQUIRE, "agent");
            xb_add(&bar[XB_XGEN(b.x)], 1u);
            asm volatile("s_waitcnt vmcnt(0)" ::: "memory");
        } else {
            XB_SPIN(xb_ld(&bar[XB_XGEN(b.x)]) == gen, bar);
            __builtin_amdgcn_fence(__ATOMIC_ACQUIRE, "agent");
            asm volatile("s_waitcnt vmcnt(0)" ::: "memory");
        }
    }
    __syncthreads();
}

struct Args { const float* in[30]; float* out; unsigned char* ws; int ph_lo, ph_hi; };
static_assert(sizeof(Args) == 30 * 8 + 8 + 8 + 8, "Args has no padding");
enum { I_XP = 0, I_XS, I_CKV, I_KROPE, I_SCONV, I_MEMK, I_MEMV, I_PT, I_MEMP, I_WIN, I_KVG, I_WUK, I_WUV, I_CONVW, I_CONVB, I_CLNG, I_CLNB, I_WO, I_LN1G, I_LN1B,
       I_WXQ, I_WXK, I_WXV, I_WXO, I_LN2G, I_LN2B, I_WUP, I_WDN, I_LN3G, I_LN3B };
struct Frame {
    LAS unsigned char* lds;
    volatile LAS unsigned* MISC;
    gu32* ctl;
    int tid, lane, wave, vcu, G;
};

__device__ __forceinline__ void xcd_arrive(const XcdBarrier& b) {
    asm volatile("s_waitcnt vmcnt(0)" ::: "memory");
    __syncthreads();
    if (threadIdx.x == 0) {
        unsigned* bar = b.bar;
        __builtin_amdgcn_s_waitcnt(0);
        unsigned nloc = b.st[0], nx = b.st[1];
        if (nloc == 0u) { xcd_barrier_complete(bar, b.x, nloc, nx); b.st[0] = nloc; b.st[1] = nx; }
        const unsigned old = xb_add(&bar[XB_XSUB(b.x)], 1u);
        const unsigned gen = old / nloc;
        if (old + 1u == (gen + 1u) * nloc) {
            __builtin_amdgcn_fence(__ATOMIC_RELEASE, "agent");
            asm volatile("s_waitcnt vmcnt(0)" ::: "memory");
            const unsigned og = xb_add(&bar[XB_TOP], 1u);
            const unsigned tg = og / nx;
            if (og + 1u == (tg + 1u) * nx) xb_add(&bar[XB_TOPGEN], 1u);
            else XB_SPIN(xb_ld(&bar[XB_TOPGEN]) == tg, bar);
            __builtin_amdgcn_fence(__ATOMIC_ACQUIRE, "agent");
            xb_add(&bar[XB_XGEN(b.x)], 1u);
            asm volatile("s_waitcnt vmcnt(0)" ::: "memory");
            b.st[2] = 0xffffffffu;
        } else b.st[2] = gen;
    }
}
__device__ __forceinline__ void xcd_wait(const XcdBarrier& b) {
    if (threadIdx.x == 0) {
        unsigned* bar = b.bar; const unsigned gen = b.st[2];
        if (gen != 0xffffffffu) { XB_SPIN(xb_ld(&bar[XB_XGEN(b.x)]) == gen, bar); __builtin_amdgcn_fence(__ATOMIC_ACQUIRE, "agent"); asm volatile("s_waitcnt vmcnt(0)" ::: "memory"); }
    }
    __syncthreads();
}
__device__ __forceinline__ void st_wt8(void* p, unsigned lo, unsigned hi) { __hip_atomic_store((unsigned long long*)p, ((unsigned long long)hi << 32) | lo, __ATOMIC_RELAXED, __HIP_MEMORY_SCOPE_AGENT); }
__device__ __forceinline__ void st_bf4_wt(bf16* p, f32x4 v) { st_wt8(p, pk2(v[0], v[1]), pk2(v[2], v[3])); }
__device__ __forceinline__ void st_wt16(float* p, f32x4 v) { asm volatile("global_store_dwordx4 %0, %1, off sc1" :: "v"(p), "v"(v) : "memory"); }
__device__ __forceinline__ void wait_count(Frame& F, gu32* cnt, unsigned n) {
    if (F.wave == 0) {
        unsigned sp = 0u; while ((unsigned)__builtin_amdgcn_readfirstlane((int)__hip_atomic_load(cnt, RLX_AGENT)) < n) { __builtin_amdgcn_s_sleep(1); if (++sp > (1u << 22)) break; }
        __builtin_amdgcn_fence(__ATOMIC_ACQUIRE, "agent"); asm volatile("s_waitcnt vmcnt(0)" ::: "memory"); }
    __syncthreads();
}

template <bool FOLD>
__device__ __forceinline__ void transpose_item(const float* W, int N, int K, bf16* WT, int k0, int n0, int dst_row0, LAS float* scr, int lane, const float* g = nullptr, const float* b = nullptr, float* pcs = nullptr, float* pbw = nullptr) {
    float pc = 0.f, pb = 0.f;
#pragma unroll 8
    for (int i = 0; i < 32; ++i) { const int kk = 2 * i + (lane >> 5); float v = W[(size_t)(k0 + kk) * N + n0 + (lane & 31)];
        if (FOLD) { pb += v * b[k0 + kk]; v *= g[k0 + kk]; pc += v; }
        scr[kk * 33 + (lane & 31)] = v; }
    if (FOLD) { pc += __shfl_xor(pc, 32); pb += __shfl_xor(pb, 32); if (lane < 32) { pcs[n0 + lane] = pc; pbw[n0 + lane] = pb; } }
    LDS_WAIT(); asm volatile("" ::: "memory");
    const int c = lane & 7;
#pragma unroll
    for (int j = 0; j < 4; ++j) { const int n = (lane >> 3) + 8 * j; const LAS float* s = scr + (8 * c) * 33 + n;
        v4u o; o.x = pk2(s[0 * 33], s[1 * 33]); o.y = pk2(s[2 * 33], s[3 * 33]); o.z = pk2(s[4 * 33], s[5 * 33]); o.w = pk2(s[6 * 33], s[7 * 33]);
        *(GAS v4u*)(WT + (size_t)(dst_row0 + n) * K + k0 + 8 * c) = o; }
    LDS_WAIT(); asm volatile("" ::: "memory");
}
__device__ __forceinline__ int win_dst_row(int n0) {
    if (n0 < 1024) return n0;
    if (n0 < 1056) return 2048 + (n0 - 1024);
    if (n0 < 1568) { const int a = n0 - 1056; return 1024 + 256 * (a >> 7) + (a & 127); }
    const int g = n0 - 1568; return 1024 + 256 * (g >> 7) + 128 + (g & 127);
}
__device__ __forceinline__ void p0_prologue(Frame& F, const Args& a) {
    LAS float* scr = (LAS float*)(F.lds + F.wave * 16384);
    const int gw = F.vcu * NWAVES + F.wave, NGW = F.G * NWAVES;
    unsigned char* ws = a.ws; float* vec = (float*)(ws + WS_VEC);
    constexpr int C0 = 1040, C1 = C0 + 512, C2 = C1 + 512, C3 = C2 + 64, C4 = C3 + 64, C5 = C4 + 512, C6 = C5 + 512, C7 = C6 + 512, C8 = C7 + 2048, C9 = C8 + 2048;
    for (int it = gw; it < C9; it += NGW) {
        if (it < C0) { const int kb = it / 65, nb = it % 65; transpose_item<false>(a.in[I_WIN], INC, DM, (bf16*)(ws + WS_WIN), kb * 64, nb * 32, win_dst_row(nb * 32), scr, F.lane); }
        else if (it < C1) { const int r = it - C0; transpose_item<false>(a.in[I_WXK], DM, DM, (bf16*)(ws + WS_WXKV), (r >> 5) * 64, (r & 31) * 32, (r & 31) * 32, scr, F.lane); }
        else if (it < C2) { const int r = it - C1; transpose_item<false>(a.in[I_WXV], DM, DM, (bf16*)(ws + WS_WXKV), (r >> 5) * 64, (r & 31) * 32, 1024 + (r & 31) * 32, scr, F.lane); }
        else if (it < C3) { const int r = it - C2; transpose_item<false>(a.in[I_WUK], 512, KVL, (bf16*)(ws + WS_WUKV), (r >> 4) * 64, (r & 15) * 32, (r & 15) * 32, scr, F.lane); }
        else if (it < C4) { const int r = it - C3; transpose_item<false>(a.in[I_WUV], 512, KVL, (bf16*)(ws + WS_WUKV), (r >> 4) * 64, (r & 15) * 32, 512 + (r & 15) * 32, scr, F.lane); }
        else if (it < C5) { const int r = it - C4; transpose_item<false>(a.in[I_WO], DM, DM, (bf16*)(ws + WS_WO), (r >> 5) * 64, (r & 31) * 32, (r & 31) * 32, scr, F.lane); }
        else if (it < C6) { const int r = it - C5; transpose_item<true>(a.in[I_WXQ], DM, DM, (bf16*)(ws + WS_WXQ), (r >> 5) * 64, (r & 31) * 32, (r & 31) * 32, scr, F.lane, a.in[I_LN1G], a.in[I_LN1B], vec + VO_PCSQ + (r >> 5) * 1024, vec + VO_PBWQ + (r >> 5) * 1024); }
        else if (it < C7) { const int r = it - C6; transpose_item<false>(a.in[I_WXO], DM, DM, (bf16*)(ws + WS_WXO), (r >> 5) * 64, (r & 31) * 32, (r & 31) * 32, scr, F.lane); }
        else if (it < C8) { const int r = it - C7; transpose_item<true>(a.in[I_WUP], FF, DM, (bf16*)(ws + WS_WUP), (r >> 7) * 64, (r & 127) * 32, (r & 127) * 32, scr, F.lane, a.in[I_LN2G], a.in[I_LN2B], vec + VO_PCSU + (r >> 7) * 4096, vec + VO_PBWU + (r >> 7) * 4096); }
        else { const int r = it - C8; transpose_item<false>(a.in[I_WDN], DM, FF, (bf16*)(ws + WS_WDN), (r >> 5) * 64, (r & 31) * 32, (r & 31) * 32, scr, F.lane); }
    }
    { GAS v4u* z = (GAS v4u*)(ws + WS_WIN + (size_t)INC * DM * 2); const int n16 = (NIN - INC) * DM * 2 / 16;
      for (int i = F.vcu * 512 + F.tid; i < n16; i += F.G * 512) z[i] = (v4u){0u, 0u, 0u, 0u}; }
    bf16* XB = (bf16*)(ws + WS_XB);
    for (int rbase = gw; rbase < MT + MMEM; rbase += 4 * NGW) {
        f32x4 v[4][4];
#pragma unroll
        for (int q = 0; q < 4; ++q) { const int r = rbase + q * NGW;
            if (r < MT + MMEM && !(r >= MREAL && r < MT)) {
                const float* src = r < MP ? a.in[I_XP] + (size_t)r * DM : (r < MREAL ? a.in[I_XS] + (size_t)(r - MP) * DM : a.in[I_MEMP] + (size_t)(r - MT) * DM);
                const GAS f32x4* xr = (const GAS f32x4*)src + F.lane;
#pragma unroll
                for (int j = 0; j < 4; ++j) v[q][j] = xr[64 * j]; }
            else {
#pragma unroll
                for (int j = 0; j < 4; ++j) v[q][j] = (f32x4){0.f, 0.f, 0.f, 0.f}; } }
#pragma unroll
        for (int q = 0; q < 4; ++q) { const int r = rbase + q * NGW; if (r < MT + MMEM) { GAS unsigned long long* o8 = (GAS unsigned long long*)(XB + (size_t)r * DM) + F.lane;
#pragma unroll
            for (int j = 0; j < 4; ++j) o8[64 * j] = (unsigned long long)pk2(v[q][j].x, v[q][j].y) | ((unsigned long long)pk2(v[q][j].z, v[q][j].w) << 32); } }
    }
    float* rope = (float*)(ws + WS_ROPE);
    for (int idx = F.vcu * 512 + F.tid; idx < 2049 * 16; idx += F.G * 512) {
        const int p = idx >> 4, i = idx & 15; const double pos = (p == 2048) ? 8192.0 : (double)p;
        double f = 1.0; for (int k = 0; k < i; ++k) f *= 0.5623413251903491;
        const double x = pos * f; const double kq = __builtin_rint(x * 0.6366197723675814);
        double y = __builtin_fma(-kq, 1.5707963267948966, x); y = __builtin_fma(-kq, 6.123233995736766e-17, y);
        const int q = (int)((long long)kq & 3ll); const double y2 = y * y;
        const double sn = y * (1.0 + y2 * (-1.0 / 6 + y2 * (1.0 / 120 + y2 * (-1.0 / 5040 + y2 * (1.0 / 362880 + y2 * (-1.0 / 39916800 + y2 * (1.0 / 6227020800.0 + y2 * (-1.0 / 1307674368000.0))))))));
        const double cs = 1.0 + y2 * (-0.5 + y2 * (1.0 / 24 + y2 * (-1.0 / 720 + y2 * (1.0 / 40320 + y2 * (-1.0 / 3628800 + y2 * (1.0 / 479001600.0 + y2 * (-1.0 / 87178291200.0 + y2 * (1.0 / 20922789888000.0))))))));
        const double s = (q == 0) ? sn : (q == 1) ? cs : (q == 2) ? -sn : -cs;
        const double c = (q == 0) ? cs : (q == 1) ? -sn : (q == 2) ? -cs : sn;
        rope[p * 32 + i] = (float)c; rope[p * 32 + 16 + i] = (float)s;
    }
}

struct InOrder {
    pg8::StaticOrder s1, s2; int G, c;
    __device__ __forceinline__ void init(int G_, int c_) { s1.init(MP, NIN, 1, 0); s2.init(MMEM, 2048, 1, 0); G = G_; c = c_; }
    __device__ __forceinline__ bool next(int i, pg8::Unit& u) const {
        const int L = i * G + c;
        if (L < s1.nwg) return s1.next(L, u);
        if (!s2.next(L - s1.nwg, u)) return false;
        u.pm += MT / 256; u.pn += NIN / 256; return true;
    }
    __device__ __forceinline__ void a_ready(const pg8::Unit&) const {}
    __device__ __forceinline__ void done(const pg8::Unit&) const {}
};

__device__ __forceinline__ void st_bf4(bf16* p, f32x4 v) { v2u w; w.x = pk2(v[0], v[1]); w.y = pk2(v[2], v[3]); *(v2u*)p = w; }

struct EpiIn {
    static constexpr bool PERM = false, AFTER_DRAIN = false;
    bf16 *Q, *CKV, *KR, *U, *MKB, *MVB; float* out; const float* rope; const float* kvg; LAS float* xl;
    __device__ __forceinline__ void operator()(const pg8::f32x4 (&acc)[2][2][4][2], const pg8::Unit& u, int wr, int wc, int fr, int fq) const {
        const int row0 = u.pm * 256 + wr * 64 + fr;
        if (u.pm >= MT / 256) {
            const int cb = (u.pn - NIN / 256) * 256; const bool isv = cb >= 1024; const int c0 = (isv ? cb - 1024 : cb) + wc * 32 + 4 * fq;
            float* of = out + (isv ? O_MVP : O_MKP); bf16* ob = isv ? MVB : MKB;
#pragma unroll
            for (int ai = 0; ai < 2; ++ai)
#pragma unroll
                for (int m = 0; m < 4; ++m) { const size_t ro = (size_t)(row0 - MT + ai * 128 + m * 16) * DM;
#pragma unroll
                    for (int bj = 0; bj < 2; ++bj)
#pragma unroll
                        for (int n = 0; n < 2; ++n) { const int c = c0 + bj * 128 + n * 16; const f32x4 v = acc[ai][bj][m][n]; *(f32x4*)(of + ro + c) = v; st_bf4(ob + ro + c, v); } }
        } else if (u.pn < 3) {
#pragma unroll
            for (int bj = 0; bj < 2; ++bj) { const int grp = u.pn * 8 + bj * 4 + wc; const bool isr = (grp % 3) == 2; const int colb = grp * 32 + 4 * fq;
#pragma unroll
                for (int ai = 0; ai < 2; ++ai)
#pragma unroll
                    for (int m = 0; m < 4; ++m) { const int row = row0 + ai * 128 + m * 16; f32x4 v0 = acc[ai][bj][m][0], v1 = acc[ai][bj][m][1];
                        if (isr) { const int pidx = row >= MP ? 2048 : (row & 2047); const f32x4 cs = *(const f32x4*)(rope + pidx * 32 + 4 * fq), sn = *(const f32x4*)(rope + pidx * 32 + 16 + 4 * fq);
                            const f32x4 o0 = v0 * cs - v1 * sn, o1 = v1 * cs + v0 * sn; v0 = o0; v1 = o1; }
                        st_bf4(Q + (size_t)row * QC + colb, v0 * QS_MLA); st_bf4(Q + (size_t)row * QC + colb + 16, v1 * QS_MLA); } }
        } else if (u.pn == 3) {
#pragma unroll
            for (int ai = 0; ai < 2; ++ai)
#pragma unroll
                for (int m = 0; m < 4; ++m) { float ss = 0.f;
#pragma unroll
                    for (int bj = 0; bj < 2; ++bj)
#pragma unroll
                        for (int n = 0; n < 2; ++n) { const f32x4 v = acc[ai][bj][m][n]; ss += (v[0] * v[0] + v[1] * v[1]) + (v[2] * v[2] + v[3] * v[3]); }
                    ss += __shfl_xor(ss, 16); ss += __shfl_xor(ss, 32);
                    if (fq == 0) xl[(ai * 128 + wr * 64 + m * 16 + fr) * 4 + wc] = ss; }
            asm volatile("s_waitcnt lgkmcnt(0)" ::: "memory"); __builtin_amdgcn_s_barrier(); asm volatile("" ::: "memory");
#pragma unroll
            for (int ai = 0; ai < 2; ++ai)
#pragma unroll
                for (int m = 0; m < 4; ++m) { const int rl = ai * 128 + wr * 64 + m * 16 + fr, row = u.pm * 256 + rl; const f32x4 p = *(const LAS f32x4*)(xl + rl * 4);
                    const float rs = 1.0f / sqrtf(((p[0] + p[1]) + (p[2] + p[3])) * (1.0f / 256.0f) + LN_EPS);
                    float* of = row < MP ? out + O_CKVP + (size_t)row * KVL : out + O_CKVS + (size_t)(row - MP) * KVL;
#pragma unroll
                    for (int bj = 0; bj < 2; ++bj)
#pragma unroll
                        for (int n = 0; n < 2; ++n) { const int c = bj * 128 + wc * 32 + n * 16 + 4 * fq; const f32x4 o = acc[ai][bj][m][n] * rs * *(const f32x4*)(kvg + c);
                            st_bf4(CKV + (size_t)row * KVL + c, o); if (row < MREAL) *(f32x4*)(of + c) = o; } }
            asm volatile("s_waitcnt lgkmcnt(0)" ::: "memory"); __builtin_amdgcn_s_barrier(); asm volatile("" ::: "memory");
        } else if (u.pn < 8) {
            const int cb = (u.pn - 4) * 128 + wc * 32 + 4 * fq;
#pragma unroll
            for (int ai = 0; ai < 2; ++ai)
#pragma unroll
                for (int m = 0; m < 4; ++m) { const int row = row0 + ai * 128 + m * 16, t = row & 2047;
#pragma unroll
                    for (int n = 0; n < 2; ++n) { const f32x4 av = acc[ai][0][m][n], gv = acc[ai][1][m][n]; f32x4 o;
#pragma unroll
                        for (int j = 0; j < 4; ++j) o[j] = av[j] / (1.0f + __expf(-gv[j]));
                        const int c = cb + n * 16; st_bf4(U + (size_t)row * CCH + c, o);
                        if (row < MP) { if (t >= SEQ - 30) *(f32x4*)(out + O_CONVP + ((size_t)(row >> 11) * 30 + (t - (SEQ - 30))) * CCH + c) = o; }
                        else if (row < MREAL) *(f32x4*)(out + O_CONVS + ((size_t)(row - MP) * 30 + 29) * CCH + c) = o; } }
        } else {
            if (wc == 0) {
#pragma unroll
                for (int ai = 0; ai < 2; ++ai)
#pragma unroll
                    for (int m = 0; m < 4; ++m) { const int row = row0 + ai * 128 + m * 16; const f32x4 v0 = acc[ai][0][m][0], v1 = acc[ai][0][m][1];
                        const int pidx = row >= MP ? 2048 : (row & 2047); const f32x4 cs = *(const f32x4*)(rope + pidx * 32 + 4 * fq), sn = *(const f32x4*)(rope + pidx * 32 + 16 + 4 * fq);
                        const f32x4 o0 = v0 * cs - v1 * sn, o1 = v1 * cs + v0 * sn;
                        st_bf4(KR + (size_t)row * RD + 4 * fq, o0); st_bf4(KR + (size_t)row * RD + 16 + 4 * fq, o1);
                        if (row < MREAL) { float* of = row < MP ? out + O_KRP + (size_t)row * RD : out + O_KRS + (size_t)(row - MP) * RD; *(f32x4*)(of + 4 * fq) = o0; *(f32x4*)(of + 16 + 4 * fq) = o1; } }
            }
        }
    }
};

template <int ACT  > struct EpiB {
    static constexpr bool PERM = true, AFTER_DRAIN = false;
    bf16* O; int ldc; int split_cols; size_t split_stride; float scale;
    __device__ __forceinline__ void operator()(const pg8::f32x4 (&acc)[2][2][4][2], const pg8::Unit& u, int wr, int wc, int fr, int fq) const {
        const int row0 = u.pm * 256 + wr * 64 + fr; int colt = u.pn * 256; bf16* base = O;
        if (split_cols) { const int t = colt / split_cols; base += (size_t)t * split_stride; colt -= t * split_cols; }
        const int col0 = colt + wc * 32 + 8 * fq;
#pragma unroll
        for (int ai = 0; ai < 2; ++ai)
#pragma unroll
            for (int m = 0; m < 4; ++m) { bf16* rowp = base + (size_t)(row0 + ai * 128 + m * 16) * ldc + col0;
#pragma unroll
                for (int bj = 0; bj < 2; ++bj) { f32x4 v0 = acc[ai][bj][m][0], v1 = acc[ai][bj][m][1];
                    if (ACT == 1) {
#pragma unroll
                        for (int j = 0; j < 4; ++j) { const float a0 = fmaxf(v0[j], 0.f), a1 = fmaxf(v1[j], 0.f); v0[j] = a0 * a0; v1[j] = a1 * a1; } }
                    v0 = v0 * scale; v1 = v1 * scale; v4u w; w.x = pk2(v0[0], v0[1]); w.y = pk2(v0[2], v0[3]); w.z = pk2(v1[0], v1[1]); w.w = pk2(v1[2], v1[3]);
                    *(v4u*)(rowp + bj * 128) = w; } }
    }
};
__device__ __forceinline__ f32x2 row_stats4(const float* slot, int row) {
    const f32x4 a = *(const f32x4*)(slot + (size_t)row * 8), b = *(const f32x4*)(slot + (size_t)row * 8 + 4);
    const float mean = ((a[0] + a[2]) + (b[0] + b[2])) * (1.0f / DM), var = ((a[1] + a[3]) + (b[1] + b[3])) * (1.0f / DM) - mean * mean;
    return (f32x2){mean, 1.0f / sqrtf(var + LN_EPS)};
}
template <int MODE, int GRP  > struct EpiV {
    static constexpr bool PERM = true, AFTER_DRAIN = false;
    bf16* VB; float* slot; const bf16* r0; const float* pslot; const float* pg; const float* pb; LAS float* xl;
    __device__ __forceinline__ void operator()(const pg8::f32x4 (&acc)[2][2][4][2], const pg8::Unit& u, int wr, int wc, int fr, int fq) const {
        const int row0 = u.pm * 256 + wr * 64 + fr, col0 = u.pn * 256 + wc * 32 + 8 * fq;
        f32x4 gv[2][2], bv[2][2];
        if (MODE == 1) {
#pragma unroll
            for (int bj = 0; bj < 2; ++bj)
#pragma unroll
                for (int n = 0; n < 2; ++n) { gv[bj][n] = *(const f32x4*)(pg + col0 + bj * 128 + 4 * n); bv[bj][n] = *(const f32x4*)(pb + col0 + bj * 128 + 4 * n); } }
#pragma unroll
        for (int am = 0; am < 8 / GRP; ++am) {
            v4u rws[GRP][2]; f32x2 sts[GRP];
#pragma unroll
            for (int mm = 0; mm < GRP; ++mm) { const int ai = (am * GRP + mm) >> 2, m = (am * GRP + mm) & 3; const int row = row0 + ai * 128 + m * 16; const size_t ro = (size_t)row * DM + col0;
                rws[mm][0] = *(const v4u*)(r0 + ro); rws[mm][1] = *(const v4u*)(r0 + ro + 128);
                sts[mm] = (f32x2){0.f, 0.f}; if (MODE == 1) sts[mm] = row_stats4(pslot, row); }
#pragma unroll
            for (int mm = 0; mm < GRP; ++mm) { const int ai = (am * GRP + mm) >> 2, m = (am * GRP + mm) & 3; const int row = row0 + ai * 128 + m * 16; const size_t ro = (size_t)row * DM + col0; float s1 = 0.f, s2 = 0.f;
                const f32x2 st = sts[mm];
#pragma unroll
                for (int bj = 0; bj < 2; ++bj) { const v4u rw = rws[mm][bj];
                    f32x4 ra = (f32x4){bflo(rw.x), bfhi(rw.x), bflo(rw.y), bfhi(rw.y)}, rb = (f32x4){bflo(rw.z), bfhi(rw.z), bflo(rw.w), bfhi(rw.w)};
                    if (MODE == 1) { const float nm = -st[0] * st[1]; ra = (ra * st[1] + nm) * gv[bj][0] + bv[bj][0]; rb = (rb * st[1] + nm) * gv[bj][1] + bv[bj][1]; }
                    const f32x4 v0 = acc[ai][bj][m][0] + ALPHA * ra, v1 = acc[ai][bj][m][1] + ALPHA * rb;
                    v4u w; w.x = pk2(v0[0], v0[1]); w.y = pk2(v0[2], v0[3]); w.z = pk2(v1[0], v1[1]); w.w = pk2(v1[2], v1[3]); *(v4u*)(VB + ro + bj * 128) = w;
                    s1 += ((v0[0] + v0[1]) + (v0[2] + v0[3])) + ((v1[0] + v1[1]) + (v1[2] + v1[3]));
                    s2 += ((v0[0] * v0[0] + v0[1] * v0[1]) + (v0[2] * v0[2] + v0[3] * v0[3])) + ((v1[0] * v1[0] + v1[1] * v1[1]) + (v1[2] * v1[2] + v1[3] * v1[3])); }
                if (slot) { s1 += __shfl_xor(s1, 16); s1 += __shfl_xor(s1, 32); s2 += __shfl_xor(s2, 16); s2 += __shfl_xor(s2, 32);
                    if (fq == 0) *(LAS f32x2*)(xl + ((ai * 128 + wr * 64 + m * 16 + fr) * 4 + wc) * 2) = (f32x2){s1, s2}; } } }
        if (slot) {
            asm volatile("s_waitcnt lgkmcnt(0)" ::: "memory"); __builtin_amdgcn_s_barrier(); asm volatile("" ::: "memory");
            if (wc == 0 && fq == 0) {
#pragma unroll
                for (int ai = 0; ai < 2; ++ai)
#pragma unroll
                    for (int m = 0; m < 4; ++m) { const int rl = ai * 128 + wr * 64 + m * 16 + fr; const f32x4 a = *(const LAS f32x4*)(xl + rl * 8), b = *(const LAS f32x4*)(xl + rl * 8 + 4);
                        *(f32x2*)(slot + ((size_t)(u.pm * 256 + rl) * 4 + u.pn) * 2) = (f32x2){(a[0] + a[2]) + (b[0] + b[2]), (a[1] + a[3]) + (b[1] + b[3])}; } }
            asm volatile("s_waitcnt lgkmcnt(0)" ::: "memory"); __builtin_amdgcn_s_barrier(); asm volatile("" ::: "memory");
        }
    }
};
template <int ACT  > struct EpiFold {
    static constexpr bool PERM = true, AFTER_DRAIN = false;
    bf16* O; int ldc; const float* pslot; const float* cs; const float* bw; float scale;
    __device__ __forceinline__ void operator()(const pg8::f32x4 (&acc)[2][2][4][2], const pg8::Unit& u, int wr, int wc, int fr, int fq) const {
        const int row0 = u.pm * 256 + wr * 64 + fr, col0 = u.pn * 256 + wc * 32 + 8 * fq;
        f32x4 cv[2][2], bv[2][2];
#pragma unroll
        for (int bj = 0; bj < 2; ++bj)
#pragma unroll
            for (int n = 0; n < 2; ++n) { cv[bj][n] = *(const f32x4*)(cs + col0 + bj * 128 + 4 * n); bv[bj][n] = *(const f32x4*)(bw + col0 + bj * 128 + 4 * n); }
#pragma unroll
        for (int ai = 0; ai < 2; ++ai)
#pragma unroll
            for (int m = 0; m < 4; ++m) { const int row = row0 + ai * 128 + m * 16; const f32x2 st = row_stats4(pslot, row); bf16* rowp = O + (size_t)row * ldc + col0;
#pragma unroll
                for (int bj = 0; bj < 2; ++bj) { f32x4 v0 = (acc[ai][bj][m][0] - st[0] * cv[bj][0]) * st[1] + bv[bj][0], v1 = (acc[ai][bj][m][1] - st[0] * cv[bj][1]) * st[1] + bv[bj][1];
                    if (ACT == 1) {
#pragma unroll
                        for (int j = 0; j < 4; ++j) { const float a0 = fmaxf(v0[j], 0.f), a1 = fmaxf(v1[j], 0.f); v0[j] = a0 * a0; v1[j] = a1 * a1; } }
                    v0 = v0 * scale; v1 = v1 * scale; v4u w; w.x = pk2(v0[0], v0[1]); w.y = pk2(v0[2], v0[3]); w.z = pk2(v1[0], v1[1]); w.w = pk2(v1[2], v1[3]);
                    *(v4u*)(rowp + bj * 128) = w; } }
    }
};

__device__ __forceinline__ void ln_final(Frame& F, const bf16* V, const float* g, const float* b, float* out, int r_lo, int r_hi, gu32* cnt, unsigned cnt_n) {
    const int gw = F.vcu * NWAVES + F.wave, NGW = F.G * NWAVES;
    f32x4 gv[4], bv[4];
#pragma unroll
    for (int j = 0; j < 4; ++j) { gv[j] = *((const GAS f32x4*)g + F.lane + 64 * j); bv[j] = *((const GAS f32x4*)b + F.lane + 64 * j); }
    for (int rbase = r_lo + gw; rbase < r_hi; rbase += 4 * NGW) {
        if (rbase >= MP) { unsigned sp = 0u;
            while ((unsigned)__builtin_amdgcn_readfirstlane((int)__hip_atomic_load(cnt, RLX_AGENT)) < cnt_n) { __builtin_amdgcn_s_sleep(1); if (++sp > (1u << 22)) break; }
            __builtin_amdgcn_fence(__ATOMIC_ACQUIRE, "agent"); asm volatile("s_waitcnt vmcnt(0)" ::: "memory"); }
        v2u w[4][4];
#pragma unroll
        for (int q = 0; q < 4; ++q) { const int r = rbase + q * NGW; if (r < r_hi) { const GAS v2u* xr = (const GAS v2u*)(V + (size_t)r * DM) + F.lane;
#pragma unroll
            for (int j = 0; j < 4; ++j) w[q][j] = xr[64 * j]; } }
#pragma unroll
        for (int q = 0; q < 4; ++q) { const int r = rbase + q * NGW; if (r < r_hi) {
            f32x4 v[4]; float s = 0.f;
#pragma unroll
            for (int j = 0; j < 4; ++j) { v[j] = (f32x4){bflo(w[q][j].x), bfhi(w[q][j].x), bflo(w[q][j].y), bfhi(w[q][j].y)}; s += (v[j].x + v[j].y) + (v[j].z + v[j].w); }
            const float mean = wave_sum(s) * (1.f / DM); float s2 = 0.f;
#pragma unroll
            for (int j = 0; j < 4; ++j) { v[j] = v[j] - mean; s2 += (v[j].x * v[j].x + v[j].y * v[j].y) + (v[j].z * v[j].z + v[j].w * v[j].w); }
            const float rstd = 1.f / sqrtf(wave_sum(s2) * (1.f / DM) + LN_EPS);
            float* of = r < MP ? out + O_YP + (size_t)r * DM : out + O_YS + (size_t)(r - MP) * DM;
#pragma unroll
            for (int j = 0; j < 4; ++j) *((GAS f32x4*)of + F.lane + 64 * j) = v[j] * rstd * gv[j] + bv[j]; } }
    }
}

constexpr int CX_KSTR = 528, CX_VSTR = 544;
static_assert(256 * CX_VSTR <= MISC_OFF, "cross-attention LDS");
__device__ __forceinline__ void cross_unit32(Frame& F, const Args& a, int bh, int qblk) {
    const bf16* QX = (const bf16*)(a.ws + WS_QX); const bf16* MKB = (const bf16*)(a.ws + WS_MKB); const bf16* MVB = (const bf16*)(a.ws + WS_MVB); bf16* OX = (bf16*)(a.ws + WS_OX);
    const int b = bh >> 2, h = bh & 3, tid = F.tid, lane = F.lane, w = F.wave, q32 = lane & 31, hh = lane >> 5, gi = lane >> 4, i16 = lane & 15;
    const size_t qrow = (size_t)b * SEQ + qblk * 256 + 32 * w + q32;
    const int lr = tid >> 5, lc = tid & 31;
    { const bf16* ksrc = MKB + ((size_t)b * MEMT + lr) * DM + h * 256 + lc * 8;
      v4u rk[16];
#pragma unroll
      for (int i = 0; i < 16; ++i) rk[i] = *(const v4u*)(ksrc + (size_t)(16 * i) * DM);
#pragma unroll
      for (int i = 0; i < 16; ++i) *(LAS v4u*)(F.lds + (lr + 16 * i) * CX_KSTR + lc * 16) = rk[i]; }
    __syncthreads();
    f32x16 s[8];
#pragma unroll
    for (int kb = 0; kb < 8; ++kb)
#pragma unroll
        for (int r = 0; r < 16; ++r) s[kb][r] = 0.f;
    const LAS unsigned char* kp = F.lds + q32 * CX_KSTR + 16 * hh;
#pragma unroll
    for (int half = 0; half < 4; ++half) { bf16x8 qf[4];
#pragma unroll
        for (int k8 = 0; k8 < 4; ++k8) qf[k8] = *(const bf16x8*)(QX + qrow * DM + h * 256 + 16 * (4 * half + k8) + 8 * hh);
#pragma unroll
        for (int k8 = 0; k8 < 4; ++k8) {
#pragma unroll
            for (int kb = 0; kb < 8; ++kb) { const bf16x8 kf = *(const LAS bf16x8*)(kp + (32 * kb) * CX_KSTR + 32 * (4 * half + k8)); s[kb] = __builtin_amdgcn_mfma_f32_32x32x16_bf16(kf, qf[k8], s[kb], 0, 0, 0); if (kb == 3) __builtin_amdgcn_sched_barrier(0); }
            __builtin_amdgcn_sched_barrier(0); } }
    float mx = s[0][0];
#pragma unroll
    for (int kb = 0; kb < 8; ++kb)
#pragma unroll
        for (int r = 0; r < 16; ++r) mx = fmaxf(mx, s[kb][r]);
    mx = fmaxf(mx, __shfl_xor(mx, 32));
    unsigned pp[8][8]; float ps = 0.f;
#pragma unroll
    for (int kb = 0; kb < 8; ++kb)
#pragma unroll
        for (int j = 0; j < 8; ++j) { const float e0 = ex2(s[kb][2 * j] - mx), e1 = ex2(s[kb][2 * j + 1] - mx); ps += e0 + e1; pp[kb][j] = pk2(e0, e1); }
    ps += __shfl_xor(ps, 32);
    const float il = 1.0f / ps;
    { const bf16* vsrc = MVB + ((size_t)b * MEMT + lr) * DM + h * 256 + lc * 8;
      v4u rv[16];
#pragma unroll
      for (int i = 0; i < 16; ++i) rv[i] = *(const v4u*)(vsrc + (size_t)(16 * i) * DM);
      __syncthreads();
#pragma unroll
      for (int i = 0; i < 16; ++i) *(LAS v4u*)(F.lds + (lr + 16 * i) * CX_VSTR + lc * 16) = rv[i]; }
    __syncthreads();
    const LAS unsigned char* vb = F.lds + (4 * (gi >> 1) + (i16 >> 2)) * CX_VSTR + (16 * (gi & 1) + 4 * (i16 & 3)) * 2;
#pragma unroll 1
    for (int dh = 0; dh < 2; ++dh) {
        f32x16 o[4];
#pragma unroll
        for (int db = 0; db < 4; ++db)
#pragma unroll
            for (int r = 0; r < 16; ++r) o[db][r] = 0.f;
#pragma unroll
        for (int kb = 0; kb < 8; ++kb)
#pragma unroll
            for (int st = 0; st < 2; ++st) {
                const v4u pw = (v4u){pp[kb][4 * st], pp[kb][4 * st + 1], pp[kb][4 * st + 2], pp[kb][4 * st + 3]};
                const bf16x8 pf = __builtin_bit_cast(bf16x8, pw);
                const LAS unsigned char* vk = vb + (32 * kb + 16 * st) * CX_VSTR + dh * 256;
#pragma unroll
                for (int db = 0; db < 4; ++db) { const s16x4 lo = tr_read(vk + db * 64), hi = tr_read(vk + 8 * CX_VSTR + db * 64);
                    const bf16x8 av = (bf16x8){lo[0], lo[1], lo[2], lo[3], hi[0], hi[1], hi[2], hi[3]};
                    o[db] = __builtin_amdgcn_mfma_f32_32x32x16_bf16(av, pf, o[db], 0, 0, 0); }
                __builtin_amdgcn_sched_barrier(0); }
#pragma unroll
        for (int db = 0; db < 4; ++db)
#pragma unroll
            for (int rg = 0; rg < 4; ++rg) st_bf4(OX + qrow * DM + h * 256 + 128 * dh + 32 * db + 8 * rg + 4 * hh, (f32x4){o[db][4 * rg], o[db][4 * rg + 1], o[db][4 * rg + 2], o[db][4 * rg + 3]} * il);
    }
    __syncthreads();
}

__device__ __forceinline__ void scross_unit(Frame& F, const Args& a, int b, int hp) {
    const bf16* QX = (const bf16*)(a.ws + WS_QX); bf16* OX = (bf16*)(a.ws + WS_OX);
    const int lane = F.lane, w = F.wave, tid = F.tid;
    LAS float* SC = (LAS float*)F.lds;
    LAS float* OP = (LAS float*)(F.lds + 2048);
    const size_t qrow = (size_t)MP + b;
    f32x4 q[2];
#pragma unroll
    for (int j = 0; j < 2; ++j) { const v2u qq = *(const v2u*)(QX + qrow * DM + (2 * hp + j) * 256 + 4 * lane); q[j] = (f32x4){bflo(qq.x), bfhi(qq.x), bflo(qq.y), bfhi(qq.y)}; }
    const float* kb = a.in[I_MEMK] + ((size_t)b * MEMT) * DM + (2 * hp) * 256 + 4 * lane; const float* vb = a.in[I_MEMV] + ((size_t)b * MEMT) * DM + (2 * hp) * 256 + 4 * lane;
#pragma unroll 8
    for (int i = 0; i < 32; ++i) { const int mt = w * 32 + i;
        const f32x4 k0 = __builtin_nontemporal_load((const f32x4*)(kb + (size_t)mt * DM)), k1 = __builtin_nontemporal_load((const f32x4*)(kb + (size_t)mt * DM + 256));
        float d0 = (k0[0] * q[0][0] + k0[1] * q[0][1]) + (k0[2] * q[0][2] + k0[3] * q[0][3]), d1 = (k1[0] * q[1][0] + k1[1] * q[1][1]) + (k1[2] * q[1][2] + k1[3] * q[1][3]);
        d0 = wave_sum(d0); d1 = wave_sum(d1);
        if (lane == 0) { SC[mt] = d0; SC[256 + mt] = d1; } }
    __syncthreads();
    if (w < 2) { f32x4 s = *(const LAS f32x4*)(SC + w * 256 + 4 * lane); const float mx = wave_max(fmaxf(fmaxf(s[0], s[1]), fmaxf(s[2], s[3])));
#pragma unroll
        for (int j = 0; j < 4; ++j) s[j] = ex2(s[j] - mx);
        const float inv = 1.0f / wave_sum((s[0] + s[1]) + (s[2] + s[3]));
        *(LAS f32x4*)(SC + w * 256 + 4 * lane) = s * inv; }
    __syncthreads();
    f32x4 o0 = (f32x4){0.f, 0.f, 0.f, 0.f}, o1 = o0;
#pragma unroll 8
    for (int i = 0; i < 32; ++i) { const int mt = w * 32 + i; const float p0 = SC[mt], p1 = SC[256 + mt];
        const f32x4 v0 = __builtin_nontemporal_load((const f32x4*)(vb + (size_t)mt * DM)), v1 = __builtin_nontemporal_load((const f32x4*)(vb + (size_t)mt * DM + 256));
        o0 += p0 * v0; o1 += p1 * v1; }
    *(LAS f32x4*)(OP + w * 512 + 4 * lane) = o0; *(LAS f32x4*)(OP + w * 512 + 256 + 4 * lane) = o1;
    __syncthreads();
    { float s = 0.f;
#pragma unroll
      for (int k = 0; k < 8; ++k) s += OP[k * 512 + tid];
      OX[qrow * DM + (2 * hp) * 256 + tid] = (bf16)(pk2(s, 0.f) & 0xffffu); }
    __syncthreads();
}

constexpr int MLA_KSTR = 208, MLA_VSTR = 144, MLA_KT = 64 * MLA_KSTR, MLA_BUF = MLA_KT + 64 * MLA_VSTR;
constexpr int DT_STR = 592, DT_BYTES = 16 * DT_STR, P3_T = 2 * MLA_BUF, P3_QL = P3_T + 8 * DT_BYTES, P3_QN = P3_QL + 16 * DT_STR, P3_CTL = P3_QN + 2048, P3_QS0 = P3_CTL + 128;
static_assert(P3_QS0 + 4 * 3072 <= MISC_OFF && P3_T % 16 == 0 && P3_QS0 % 16 == 0, "phase-3 LDS map");
__device__ __forceinline__ void bar4(LAS unsigned* ctr, unsigned& target, int lane) {
    target += 4u;
    asm volatile("s_waitcnt lgkmcnt(0)" ::: "memory");
    if (lane == 0) __hip_atomic_fetch_add(ctr, 1u, __ATOMIC_RELAXED, __HIP_MEMORY_SCOPE_WORKGROUP);
    while (__hip_atomic_load(ctr, __ATOMIC_RELAXED, __HIP_MEMORY_SCOPE_WORKGROUP) < target) __builtin_amdgcn_s_sleep(1);
    asm volatile("" ::: "memory");
}
__device__ __forceinline__ void mla_unit4(Frame& F, const Args& a, int bh, int qblk, LAS unsigned* bctr, unsigned& btgt) {
    const bf16* Q = (const bf16*)(a.ws + WS_Q); const bf16* KN = (const bf16*)(a.ws + WS_KN); const bf16* VV = (const bf16*)(a.ws + WS_VV); const bf16* KR = (const bf16*)(a.ws + WS_KR); bf16* AC = (bf16*)(a.ws + WS_AC);
    const int b = bh >> 3, h = bh & 7, lane = F.lane, aw = F.wave, q32 = lane & 31, hh = lane >> 5, t4 = aw * 64 + lane;
    const size_t rb = (size_t)b * SEQ; const int q0 = qblk * 256, NT = 4 * (qblk + 1);
    const size_t qrow = rb + q0 + 64 * aw + q32;
    bf16x8 qf[3];
    LAS unsigned char* qst = F.lds + P3_T + aw * DT_BYTES + lane * 16; LAS unsigned char* qs0 = F.lds + P3_QS0 + aw * 3072 + lane * 16;
#pragma unroll
    for (int s = 0; s < 6; ++s) { const bf16x8 q0v = *(const bf16x8*)(Q + qrow * QC + h * 96 + 16 * s + 8 * hh); if (s < 3) qf[s] = q0v; else *(LAS bf16x8*)(qs0 + (s - 3) * 1024) = q0v;
        *(LAS bf16x8*)(qst + s * 1024) = *(const bf16x8*)(Q + (qrow + 32) * QC + h * 96 + 16 * s + 8 * hh); }
    f32x16 o[2][2];
#pragma unroll
    for (int r = 0; r < 16; ++r) { o[0][0][r] = 0.f; o[0][1][r] = 0.f; o[1][0][r] = 0.f; o[1][1][r] = 0.f; }
    float m[2] = {-1e30f, -1e30f}, l[2] = {0.f, 0.f};
    const int r0 = t4 >> 3, c0 = t4 & 7, rr = t4 >> 2, cr = t4 & 3;
    const bf16* vsrc = VV + (rb + r0) * 512 + h * 64 + c0 * 8; const bf16* nsrc = KN + (rb + r0) * 512 + h * 64 + c0 * 8; const bf16* rsrc = KR + (rb + rr) * RD + cr * 8;
    const int vdst = MLA_KT + r0 * MLA_VSTR + c0 * 16, ndst = r0 * MLA_KSTR + c0 * 16, rdst = rr * MLA_KSTR + 128 + cr * 16;
    v4u pv0, pv1, pn0, pn1, pr;
#define MLA_LOAD(t_) do { const size_t off_ = (size_t)(t_) * 64; pv0 = *(const v4u*)(vsrc + off_ * 512); pv1 = *(const v4u*)(vsrc + (off_ + 32) * 512); pn0 = *(const v4u*)(nsrc + off_ * 512); pn1 = *(const v4u*)(nsrc + (off_ + 32) * 512); pr = *(const v4u*)(rsrc + off_ * RD); } while (0)
#define MLA_STORE(buf_) do { LAS unsigned char* nb_ = (buf_); *(LAS v4u*)(nb_ + vdst) = pv0; *(LAS v4u*)(nb_ + vdst + 32 * MLA_VSTR) = pv1; *(LAS v4u*)(nb_ + ndst) = pn0; *(LAS v4u*)(nb_ + ndst + 32 * MLA_KSTR) = pn1; *(LAS v4u*)(nb_ + rdst) = pr; } while (0)
    MLA_LOAD(0); MLA_STORE(F.lds);
    bar4(bctr, btgt, lane);
    const int qmin = q0 + 64 * aw, qpos = qmin + q32;
    const int gi = lane >> 4, i16 = lane & 15;
    for (int t = 0; t < NT; ++t) {
        const LAS unsigned char* Kt = F.lds + (t & 1) * MLA_BUF; const LAS unsigned char* Vt = Kt + MLA_KT;
        const bool more = t + 1 < NT;
        if (more) MLA_LOAD(t + 1);
        if (64 * t <= qmin + 63) {
            const bool diag = 64 * t + 63 > qmin;
            const LAS unsigned char* vb = Vt + (4 * (gi >> 1) + (i16 >> 2)) * MLA_VSTR + (16 * (gi & 1) + 4 * (i16 & 3)) * 2;
#pragma unroll
            for (int kb = 0; kb < 2; ++kb) {
                f32x16 s[2];
#pragma unroll
                for (int r = 0; r < 16; ++r) { s[0][r] = 0.f; s[1][r] = 0.f; }
#pragma unroll
                for (int ks = 0; ks < 6; ++ks) { const bf16x8 kf = *(const LAS bf16x8*)(Kt + (32 * kb + q32) * MLA_KSTR + (16 * ks + 8 * hh) * 2); const bf16x8 q1 = *(const LAS bf16x8*)(qst + ks * 1024);
                    const bf16x8 q0 = ks < 3 ? qf[ks < 3 ? ks : 0] : *(const LAS bf16x8*)(qs0 + (ks - 3) * 1024);
                    s[0] = __builtin_amdgcn_mfma_f32_32x32x16_bf16(kf, q0, s[0], 0, 0, 0); s[1] = __builtin_amdgcn_mfma_f32_32x32x16_bf16(kf, q1, s[1], 0, 0, 0);
                    if (ks & 1) __builtin_amdgcn_sched_barrier(0); }
                s16x4 vlo[2][2], vhi[2][2];
#pragma unroll
                for (int st = 0; st < 2; ++st)
#pragma unroll
                    for (int db = 0; db < 2; ++db) { const LAS unsigned char* vk = vb + (32 * kb + 16 * st) * MLA_VSTR + db * 64; vlo[st][db] = tr_read(vk); vhi[st][db] = tr_read(vk + 8 * MLA_VSTR); }
#pragma unroll
                for (int u = 0; u < 2; ++u) {
                    if (diag) {
#pragma unroll
                        for (int r = 0; r < 16; ++r) { const int key = 64 * t + 32 * kb + (r & 3) + 8 * (r >> 2) + 4 * hh; if (key > qpos + 32 * u) s[u][r] = -INFINITY; } }
                    float mx = fmaxf(s[u][0], s[u][1]);
#pragma unroll
                    for (int r = 2; r < 16; ++r) mx = fmaxf(mx, s[u][r]);
                    mx = fmaxf(mx, __shfl_xor(mx, 32));
                    if (__any(mx > m[u])) { const float mn = fmaxf(m[u], mx), al = ex2(m[u] - mn); m[u] = mn; l[u] *= al;
#pragma unroll
                        for (int r = 0; r < 16; ++r) { o[u][0][r] *= al; o[u][1][r] *= al; } }
                    float ps = 0.f; unsigned pp[8];
#pragma unroll
                    for (int j = 0; j < 8; ++j) { const float e0 = ex2(s[u][2 * j] - m[u]), e1 = ex2(s[u][2 * j + 1] - m[u]); ps += e0 + e1; pp[j] = pk2(e0, e1); }
                    l[u] += ps;
#pragma unroll
                    for (int st = 0; st < 2; ++st) {
                        const v4u pw = (v4u){pp[4 * st], pp[4 * st + 1], pp[4 * st + 2], pp[4 * st + 3]};
                        const bf16x8 pf = __builtin_bit_cast(bf16x8, pw);
#pragma unroll
                        for (int db = 0; db < 2; ++db) { const s16x4 lo = vlo[st][db], hi = vhi[st][db];
                            const bf16x8 av = (bf16x8){lo[0], lo[1], lo[2], lo[3], hi[0], hi[1], hi[2], hi[3]};
                            o[u][db] = __builtin_amdgcn_mfma_f32_32x32x16_bf16(av, pf, o[u][db], 0, 0, 0); } }
                }
            }
        }
        if (more) MLA_STORE(F.lds + ((t + 1) & 1) * MLA_BUF);
        bar4(bctr, btgt, lane);
    }
#undef MLA_LOAD
#undef MLA_STORE
#pragma unroll
    for (int u = 0; u < 2; ++u) { const float lt = l[u] + __shfl_xor(l[u], 32), il = 1.0f / lt;
#pragma unroll
        for (int db = 0; db < 2; ++db)
#pragma unroll
            for (int rg = 0; rg < 4; ++rg) st_bf4(AC + (qrow + 32 * u) * DM + h * 64 + 32 * db + 8 * rg + 4 * hh, (f32x4){o[u][db][4 * rg], o[u][db][4 * rg + 1], o[u][db][4 * rg + 2], o[u][db][4 * rg + 3]} * il); }
}

__device__ __forceinline__ void decode_setup4(Frame& F, const Args& a, int b) {
    const bf16* Q = (const bf16*)(a.ws + WS_Q); const float* QLAT = (const float*)(a.ws + WS_QLAT);
    const int lane = F.lane, w4 = F.wave - 4, t4 = w4 * 64 + lane;
    LAS unsigned char* QL = F.lds + P3_QL;
    const size_t qrow = (size_t)MP + b;
#pragma unroll
    for (int hp = 0; hp < 2; ++hp) { const int h = 2 * w4 + hp, l4 = lane * 4; const f32x4 ql = *(const f32x4*)(QLAT + ((size_t)b * 8 + h) * 256 + l4);
      v2u pw; pw.x = pk2(ql[0], ql[1]); pw.y = pk2(ql[2], ql[3]); *(LAS v2u*)(QL + h * DT_STR + l4 * 2) = pw; }
    for (int i = t4; i < 8 * DT_STR / 4; i += 256) ((LAS unsigned*)(QL + 8 * DT_STR))[i] = 0u;
    { const int h = t4 >> 5, r = t4 & 31; *(LAS bf16*)(QL + h * DT_STR + (256 + r) * 2) = Q[qrow * QC + h * 96 + 64 + r]; }
}
__device__ __forceinline__ void decode_stream(Frame& F, const Args& a, int b, int half, LAS unsigned* pctr, f32x4 (&o)[16], float& m, float& l) {
    const int lane = F.lane, w = F.wave, r16 = lane & 15, g = lane >> 4;
    const LAS unsigned char* QL = F.lds + P3_QL; LAS unsigned char* T = F.lds + P3_T + w * DT_BYTES;
    const LAS unsigned char* qlp = QL + r16 * DT_STR + 16 * g;
    const int* pt = (const int*)a.in[I_PT] + b * NPG + half * 32;
    const float* cck = a.in[I_CKV]; const float* ckr = a.in[I_KROPE];
    f32x4 cl[16], rp[2];
#define DEC_LOAD(blk_, pgi_) do { const float* cb_ = cck + ((size_t)(pgi_) * 128 + (blk_) * 16) * KVL + 4 * lane; const float* rb_ = ckr + ((size_t)(pgi_) * 128 + (blk_) * 16 + (lane >> 2)) * RD + (lane & 3) * 8; \
        _Pragma("unroll") for (int i_ = 0; i_ < 16; ++i_) cl[i_] = __builtin_nontemporal_load((const f32x4*)(cb_ + i_ * KVL)); \
        rp[0] = __builtin_nontemporal_load((const f32x4*)rb_); rp[1] = __builtin_nontemporal_load((const f32x4*)(rb_ + 4)); } while (0)
#define DEC_GRAB(dst_) do { unsigned v_ = 0u; if (lane == 0) v_ = __hip_atomic_fetch_add(pctr, 1u, __ATOMIC_RELAXED, __HIP_MEMORY_SCOPE_WORKGROUP); dst_ = (int)__builtin_amdgcn_readfirstlane(v_); } while (0)
    int pcur; DEC_GRAB(pcur);
    bool valid = pcur < 32; int pg = 0, blk = 0;
    if (valid) { pg = __builtin_amdgcn_readfirstlane(pt[pcur]); DEC_LOAD(0, pg); }
#pragma unroll 1
    while (valid) {
#pragma unroll
        for (int i = 0; i < 16; ++i) { v2u pw; pw.x = pk2(cl[i][0], cl[i][1]); pw.y = pk2(cl[i][2], cl[i][3]); *(LAS v2u*)(T + i * DT_STR + lane * 8) = pw; }
        { v4u pw; pw.x = pk2(rp[0][0], rp[0][1]); pw.y = pk2(rp[0][2], rp[0][3]); pw.z = pk2(rp[1][0], rp[1][1]); pw.w = pk2(rp[1][2], rp[1][3]); *(LAS v4u*)(T + (lane >> 2) * DT_STR + 512 + (lane & 3) * 16) = pw; }
        ++blk;
        if (blk == 8) { blk = 0; DEC_GRAB(pcur); valid = pcur < 32; if (valid) pg = __builtin_amdgcn_readfirstlane(pt[pcur]); }
        if (valid) DEC_LOAD(blk, pg);
        f32x4 sa = (f32x4){0.f, 0.f, 0.f, 0.f};
#pragma unroll
        for (int s = 0; s < 9; ++s) { const bf16x8 av = *(const LAS bf16x8*)(T + r16 * DT_STR + (32 * s + 8 * g) * 2); const bf16x8 qv = *(const LAS bf16x8*)(qlp + 64 * s); sa = __builtin_amdgcn_mfma_f32_16x16x32_bf16(av, qv, sa, 0, 0, 0); if (s % 3 == 2) __builtin_amdgcn_sched_barrier(0); }
        float mx = fmaxf(fmaxf(sa[0], sa[1]), fmaxf(sa[2], sa[3])); mx = fmaxf(mx, __shfl_xor(mx, 16)); mx = fmaxf(mx, __shfl_xor(mx, 32));
        if (__any(mx > m)) { const float mn = fmaxf(m, mx), al = ex2(m - mn); m = mn; l *= al;
#pragma unroll
            for (int lb = 0; lb < 16; ++lb) o[lb] = o[lb] * al; }
        float p[4];
#pragma unroll
        for (int r = 0; r < 4; ++r) p[r] = ex2(sa[r] - m);
        l += (p[0] + p[1]) + (p[2] + p[3]);
        v2u pw; pw.x = pk2(p[0], p[1]); pw.y = pk2(p[2], p[3]); const s16x4 pb = __builtin_bit_cast(s16x4, pw);
        const LAS unsigned char* tb = T + (4 * g + (r16 >> 2)) * DT_STR + (4 * (r16 & 3)) * 2;
#pragma unroll
        for (int lb = 0; lb < 16; ++lb) { const s16x4 av = tr_read(tb + lb * 32); o[lb] = __builtin_amdgcn_mfma_f32_16x16x16bf16_1k(av, pb, o[lb], 0, 0, 0); if ((lb & 3) == 3) __builtin_amdgcn_sched_barrier(0); }
    }
#undef DEC_LOAD
#undef DEC_GRAB
}
__device__ __forceinline__ void decode_finish4(Frame& F, const Args& a, int b, int half, const f32x4 (&o)[16], float m, float l, LAS unsigned* dctr, unsigned& dtgt) {
    float* PART = (float*)(a.ws + WS_PART); float* PML = (float*)(a.ws + WS_PML);
    const int lane = F.lane, w4 = F.wave - 4, t4 = w4 * 64 + lane, r16 = lane & 15, g = lane >> 4;
    l += __shfl_xor(l, 16); l += __shfl_xor(l, 32);
    LAS float* CB = (LAS float*)(F.lds + P3_T + 4 * DT_BYTES);
    LAS float* ML = CB + 4 * 8 * 256;
    bar4(dctr, dtgt, lane);
    if (r16 < 8) {
#pragma unroll
        for (int lb = 0; lb < 16; ++lb) *(LAS f32x4*)(CB + (w4 * 8 + r16) * 256 + 16 * lb + 4 * g) = o[lb];
        if (g == 0) { ML[(w4 * 8 + r16) * 2] = m; ML[(w4 * 8 + r16) * 2 + 1] = l; } }
    bar4(dctr, dtgt, lane);
    { const int h = t4 >> 5, l8 = (t4 & 31) * 8; float M = -1e30f;
#pragma unroll
      for (int k = 0; k < 4; ++k) M = fmaxf(M, ML[(k * 8 + h) * 2]);
      float L = 0.f; f32x4 acc0 = (f32x4){0.f, 0.f, 0.f, 0.f}, acc1 = (f32x4){0.f, 0.f, 0.f, 0.f};
#pragma unroll
      for (int k = 0; k < 4; ++k) { const float sc = ex2(ML[(k * 8 + h) * 2] - M); L += ML[(k * 8 + h) * 2 + 1] * sc;
          acc0 += sc * *(const LAS f32x4*)(CB + (k * 8 + h) * 256 + l8); acc1 += sc * *(const LAS f32x4*)(CB + (k * 8 + h) * 256 + l8 + 4); }
      const size_t pu = ((size_t)(b * 2 + half) * 8 + h);
      *(f32x4*)(PART + pu * 256 + l8) = acc0; *(f32x4*)(PART + pu * 256 + l8 + 4) = acc1;
      if ((t4 & 31) == 0) { PML[pu * 2] = M; PML[pu * 2 + 1] = L; } }
}
__device__ __forceinline__ void combine_unit4(Frame& F, const Args& a, int b) {
    const bf16* Q = (const bf16*)(a.ws + WS_Q); const float* PART = (const float*)(a.ws + WS_PART); const float* PML = (const float*)(a.ws + WS_PML); const float* QLAT = (const float*)(a.ws + WS_QLAT); bf16* AC = (bf16*)(a.ws + WS_AC);
    const int w4 = F.wave - 4, j = F.lane;
    LAS float* OL = (LAS float*)(F.lds + P3_T + 4 * DT_BYTES);
    const float* cn = a.out + O_CKVS + (size_t)b * KVL; const float* kn = a.out + O_KRS + (size_t)b * RD;
    const f32x4 c4 = *(const f32x4*)(cn + 4 * j);
#pragma unroll
    for (int hp = 0; hp < 2; ++hp) { const int h = 2 * w4 + hp;
        const f32x4 q4 = *(const f32x4*)(QLAT + ((size_t)b * 8 + h) * 256 + 4 * j);
        float sp = (q4[0] * c4[0] + q4[1] * c4[1]) + (q4[2] * c4[2] + q4[3] * c4[3]);
        if (j < 32) sp += bf2f(Q[((size_t)MP + b) * QC + h * 96 + 64 + j]) * kn[j];
        const float sn = wave_sum(sp);
        const size_t p0 = ((size_t)(b * 2) * 8 + h), p1 = ((size_t)(b * 2 + 1) * 8 + h);
        const float M0 = PML[p0 * 2], L0 = PML[p0 * 2 + 1], M1 = PML[p1 * 2], L1 = PML[p1 * 2 + 1];
        const float M = fmaxf(fmaxf(M0, M1), sn), w0 = ex2(M0 - M), w1 = ex2(M1 - M), wn = ex2(sn - M), il = 1.0f / (L0 * w0 + L1 * w1 + wn);
        const f32x4 a0 = *(const f32x4*)(PART + p0 * 256 + 4 * j), a1 = *(const f32x4*)(PART + p1 * 256 + 4 * j);
        *(LAS f32x4*)(OL + h * 256 + 4 * j) = (a0 * w0 + a1 * w1 + c4 * wn) * il; }
    asm volatile("s_waitcnt lgkmcnt(0)" ::: "memory");
#pragma unroll 1
    for (int hp = 0; hp < 2; ++hp) { const int h = 2 * w4 + hp;
        const float* wuv = a.in[I_WUV] + h * 64 + j; float acc = 0.f, acc2 = 0.f;
#pragma unroll 1
        for (int l0 = 0; l0 < 256; l0 += 64) {
            float wv[64];
#pragma unroll
            for (int i = 0; i < 64; ++i) wv[i] = wuv[(size_t)(l0 + i) * 512];
#pragma unroll
            for (int i = 0; i < 64; i += 2) { acc += OL[h * 256 + l0 + i] * wv[i]; acc2 += OL[h * 256 + l0 + i + 1] * wv[i + 1]; } }
        acc += acc2;
        AC[((size_t)MP + b) * DM + h * 64 + j] = (bf16)(pk2(acc, 0.f) & 0xffffu); }
}
#if defined(PROBE_PH)
#define SUBSTAMP(i, cond) do { if (blockIdx.x == 0 && (cond)) F.MISC[(i)] = (unsigned)__builtin_amdgcn_s_memrealtime(); } while (0)
#else
#define SUBSTAMP(i, cond) do { } while (0)
#endif
__device__ __forceinline__ void p3_phase(Frame& F, const Args& a) {
    LAS unsigned* ctl = (LAS unsigned*)(F.lds + P3_CTL);
    bool first = true;
    for (int du = F.vcu; first || du < NS * 2; du += F.G) {
        const bool has_dec = du < NS * 2; const int b = du >> 1, half = du & 1;
        if (F.tid == 0) { ctl[0] = 0u; ctl[8] = 0u; ctl[16] = 0u; }
        __syncthreads();
        asm volatile("" : "+v"(F.tid)); F.lane = F.tid & 63;
        SUBSTAMP(28, F.tid == 0);
        if (F.wave < 4) {
            if (first) { unsigned btgt = 0u; __builtin_amdgcn_s_setprio(2);
                for (int i = 0;; ++i) { const int n = i * F.G + F.vcu; if (n >= 1024) break;
                    const int r = n >> 8, v = n & 255, bh = v >> 1, s = v & 1, qa = 2 * s + (r >> 1), qblk = (r & 1) ? 7 - qa : qa;
                    mla_unit4(F, a, bh, qblk, ctl, btgt); }
                __builtin_amdgcn_s_setprio(0); SUBSTAMP(29, F.tid == 0); }
        } else if (has_dec) {
            unsigned dtgt = 0u;
            if (first) {
                if (F.wave == 4) { const unsigned nsrw = F.G < NS ? (unsigned)F.G : (unsigned)NS; unsigned sp = 0u;
                    while ((unsigned)__builtin_amdgcn_readfirstlane((int)__hip_atomic_load(F.ctl + CW_SRW, RLX_AGENT)) < nsrw) { __builtin_amdgcn_s_sleep(1); if (++sp > (1u << 22)) break; }
                    __builtin_amdgcn_fence(__ATOMIC_ACQUIRE, "agent"); asm volatile("s_waitcnt vmcnt(0)" ::: "memory"); }
                bar4(ctl + 8, dtgt, F.lane); }
            decode_setup4(F, a, b);
            bar4(ctl + 8, dtgt, F.lane);
            f32x4 o[16];
#pragma unroll
            for (int lb = 0; lb < 16; ++lb) o[lb] = (f32x4){0.f, 0.f, 0.f, 0.f};
            float m = -1e30f, l = 0.f;
            decode_stream(F, a, b, half, ctl + 16, o, m, l);
            SUBSTAMP(10, F.tid == 256);
            decode_finish4(F, a, b, half, o, m, l, ctl + 8, dtgt);
            asm volatile("s_waitcnt vmcnt(0)" ::: "memory");
            bar4(ctl + 8, dtgt, F.lane);
            if (F.wave == 4) { if (F.lane == 0) { __builtin_amdgcn_fence(__ATOMIC_RELEASE, "agent"); asm volatile("s_waitcnt vmcnt(0)" ::: "memory");
                const unsigned old = __hip_atomic_fetch_add((unsigned*)(F.ctl + CW_CMB) + b, 1u, __ATOMIC_RELAXED, __HIP_MEMORY_SCOPE_AGENT);
                if (old == 1u) { __builtin_amdgcn_fence(__ATOMIC_ACQUIRE, "agent"); asm volatile("s_waitcnt vmcnt(0)" ::: "memory"); }
                ctl[24] = old; } }
            bar4(ctl + 8, dtgt, F.lane);
            if (__builtin_amdgcn_readfirstlane((int)ctl[24]) == 1) combine_unit4(F, a, b);
            SUBSTAMP(31, F.tid == 256);
        }
        __syncthreads();
        SUBSTAMP(30, F.tid == 0);
        asm volatile("" : "+v"(F.tid)); F.lane = F.tid & 63;
        first = false;
    }
}


__device__ __forceinline__ void combine_unit(Frame& F, const Args& a, int b) {
    const bf16* Q = (const bf16*)(a.ws + WS_Q); const float* PART = (const float*)(a.ws + WS_PART); const float* PML = (const float*)(a.ws + WS_PML); const float* QLAT = (const float*)(a.ws + WS_QLAT); bf16* AC = (bf16*)(a.ws + WS_AC);
    const int tid = F.tid, h = tid >> 6, j = tid & 63;
    LAS float* OL = (LAS float*)F.lds;
    const float* cn = a.out + O_CKVS + (size_t)b * KVL; const float* kn = a.out + O_KRS + (size_t)b * RD;
    const f32x4 c4 = *(const f32x4*)(cn + 4 * j); const f32x4 q4 = *(const f32x4*)(QLAT + ((size_t)b * 8 + h) * 256 + 4 * j);
    float sp = (q4[0] * c4[0] + q4[1] * c4[1]) + (q4[2] * c4[2] + q4[3] * c4[3]);
    if (j < 32) sp += bf2f(Q[((size_t)MP + b) * QC + h * 96 + 64 + j]) * kn[j];
    const float sn = wave_sum(sp);
    const size_t p0 = ((size_t)(b * 2) * 8 + h), p1 = ((size_t)(b * 2 + 1) * 8 + h);
    const float M0 = PML[p0 * 2], L0 = PML[p0 * 2 + 1], M1 = PML[p1 * 2], L1 = PML[p1 * 2 + 1];
    const float M = fmaxf(fmaxf(M0, M1), sn), w0 = ex2(M0 - M), w1 = ex2(M1 - M), wn = ex2(sn - M), il = 1.0f / (L0 * w0 + L1 * w1 + wn);
    const f32x4 a0 = *(const f32x4*)(PART + p0 * 256 + 4 * j), a1 = *(const f32x4*)(PART + p1 * 256 + 4 * j);
    *(LAS f32x4*)(OL + h * 256 + 4 * j) = (a0 * w0 + a1 * w1 + c4 * wn) * il;
    __syncthreads();
    const float* wuv = a.in[I_WUV] + h * 64 + j; float acc = 0.f, acc2 = 0.f;
#pragma unroll 1
    for (int l0 = 0; l0 < 256; l0 += 64) {
        float wv[64];
#pragma unroll
        for (int i = 0; i < 64; ++i) wv[i] = wuv[(size_t)(l0 + i) * 512];
#pragma unroll
        for (int i = 0; i < 64; i += 2) { acc += OL[h * 256 + l0 + i] * wv[i]; acc2 += OL[h * 256 + l0 + i + 1] * wv[i + 1]; } }
    acc += acc2;
    AC[((size_t)MP + b) * DM + h * 64 + j] = (bf16)(pk2(acc, 0.f) & 0xffffu);
    __syncthreads();
}

constexpr int CV_UB = 62 * CCH * 2, CV_CB = 32 * CCH * 4;
__device__ __forceinline__ void conv_phase(Frame& F, const Args& a) {
    const bf16* U = (const bf16*)(a.ws + WS_U); bf16* AC = (bf16*)(a.ws + WS_AC);
    const int tid = F.tid, lane = F.lane, w = F.wave;
    LAS unsigned char* ub = F.lds;
    LAS float* cb = (LAS float*)(F.lds + CV_UB);
    const int cp = tid & 255, th = tid >> 8;
    f32x2 wt[31];
#pragma unroll
    for (int jj = 0; jj < 31; ++jj) wt[jj] = *(const f32x2*)(a.in[I_CONVW] + jj * CCH + 2 * cp);
    const f32x2 bias = *(const f32x2*)(a.in[I_CONVB] + 2 * cp);
    const f32x4 g0 = *(const f32x4*)(a.in[I_CLNG] + 8 * lane), g1 = *(const f32x4*)(a.in[I_CLNG] + 8 * lane + 4), b0 = *(const f32x4*)(a.in[I_CLNB] + 8 * lane), b1 = *(const f32x4*)(a.in[I_CLNB] + 8 * lane + 4);
    v4u tv[8];
#define CONV_LOAD(n_) do { const int b_ = (n_) >> 6, t0_ = ((n_) & 63) * 32; _Pragma("unroll") for (int i = 0; i < 8; ++i) { const int c = tid + 512 * i, r = c >> 6, ch = c & 63, t = t0_ - 30 + r; tv[i] = (v4u){0u, 0u, 0u, 0u}; \
        if (c < 62 * 64 && t >= 0) tv[i] = *(const v4u*)(U + ((size_t)b_ * SEQ + t) * CCH + ch * 8); } } while (0)
    int n = F.vcu;
    if (n < NBATCH * 64) CONV_LOAD(n);
    while (n < NBATCH * 64) {
        const int b = n >> 6, t0 = (n & 63) * 32;
#pragma unroll
        for (int i = 0; i < 8; ++i) { const int c = tid + 512 * i; if (c < 62 * 64) *(LAS v4u*)(ub + (c >> 6) * 1024 + (c & 63) * 16) = tv[i]; }
        const int nn = n + F.G;
        if (nn < NBATCH * 64) CONV_LOAD(nn);
        __syncthreads();
        {
            const int tb0 = th * 16;
            f32x2 acc[16];
#pragma unroll
            for (int tt = 0; tt < 16; ++tt) acc[tt] = bias;
#pragma unroll
            for (int i = 0; i < 46; ++i) { const unsigned uw = *(const LAS unsigned*)(ub + (tb0 + i) * 1024 + cp * 4); const f32x2 uv = {bflo(uw), bfhi(uw)};
#pragma unroll
                for (int tt = 0; tt < 16; ++tt) { const int jj = i - tt; if (jj >= 0 && jj < 31) acc[tt] += wt[jj] * uv; }
                }
#pragma unroll
            for (int tt = 0; tt < 16; ++tt) *(LAS f32x2*)(cb + (tb0 + tt) * CCH + 2 * cp) = acc[tt];
        }
        __syncthreads();
#pragma unroll
        for (int k = 0; k < 4; ++k) { const int tt = w * 4 + k; f32x4 v0 = *(const LAS f32x4*)(cb + tt * CCH + 8 * lane), v1 = *(const LAS f32x4*)(cb + tt * CCH + 8 * lane + 4);
            const float mean = wave_sum((v0[0] + v0[1]) + (v0[2] + v0[3]) + (v1[0] + v1[1]) + (v1[2] + v1[3])) * (1.0f / CCH);
            v0 = v0 - mean; v1 = v1 - mean;
            const float var = wave_sum((v0[0] * v0[0] + v0[1] * v0[1]) + (v0[2] * v0[2] + v0[3] * v0[3]) + (v1[0] * v1[0] + v1[1] * v1[1]) + (v1[2] * v1[2] + v1[3] * v1[3])) * (1.0f / CCH);
            const float rstd = 1.0f / sqrtf(var + LN_EPS);
            f32x4 y0 = v0 * rstd * g0 + b0, y1 = v1 * rstd * g1 + b1;
#pragma unroll
            for (int e = 0; e < 4; ++e) { y0[e] = y0[e] / (1.0f + __expf(-y0[e])); y1[e] = y1[e] / (1.0f + __expf(-y1[e])); }
            v4u o; o.x = pk2(y0[0], y0[1]); o.y = pk2(y0[2], y0[3]); o.z = pk2(y1[0], y1[1]); o.w = pk2(y1[2], y1[3]);
            *(v4u*)(AC + ((size_t)b * SEQ + t0 + tt) * DM + CCH + 8 * lane) = o; }
        __syncthreads();
        n = nn;
    }
#undef CONV_LOAD
}
__device__ __forceinline__ void srow_wave(Frame& F, const Args& a, int b) {
    bf16* __restrict__ AC = (bf16*)(a.ws + WS_AC); bf16* __restrict__ Q = (bf16*)(a.ws + WS_Q); const float* __restrict__ z = (const float*)(a.ws + WS_ZS) + (size_t)b * NIN; const float* __restrict__ rope = (const float*)(a.ws + WS_ROPE) + 2048 * 32;
    float* __restrict__ out = a.out;
    const int lane = F.lane, rl = lane & 15; const size_t qrow = (size_t)MP + b;
    float qn[8], x1[8], x2[8];
#pragma unroll
    for (int h = 0; h < 8; ++h) { qn[h] = z[h * 96 + lane]; x1[h] = z[h * 96 + 64 + rl]; x2[h] = z[h * 96 + 80 + rl]; }
    const float cs = rope[rl], sn = rope[16 + rl], k1 = z[2048 + rl], k2 = z[2064 + rl];
    const f32x4 c = *(const f32x4*)(z + 768 + 4 * lane), kg = *(const f32x4*)(a.in[I_KVG] + 4 * lane);
    const int c0 = 8 * lane, zb = 1024 + 256 * (c0 >> 7) + (c0 & 127);
    const f32x4 ga0 = *(const f32x4*)(z + zb), ga1 = *(const f32x4*)(z + zb + 4), gg0 = *(const f32x4*)(z + zb + 128), gg1 = *(const f32x4*)(z + zb + 132);
#pragma unroll
    for (int h = 0; h < 8; ++h) { Q[qrow * QC + h * 96 + lane] = (bf16)(pk2(qn[h] * QS_MLA, 0.f) & 0xffffu);
        if (lane < 16) { Q[qrow * QC + h * 96 + 64 + lane] = (bf16)(pk2((x1[h] * cs - x2[h] * sn) * QS_MLA, 0.f) & 0xffffu); Q[qrow * QC + h * 96 + 80 + lane] = (bf16)(pk2((x2[h] * cs + x1[h] * sn) * QS_MLA, 0.f) & 0xffffu); } }
    { const float ss = wave_sum((c[0] * c[0] + c[1] * c[1]) + (c[2] * c[2] + c[3] * c[3]));
      const float rs = 1.0f / sqrtf(ss * (1.0f / 256.0f) + LN_EPS); *(f32x4*)(out + O_CKVS + (size_t)b * KVL + 4 * lane) = c * rs * kg; }
    if (lane < 16) { out[O_KRS + (size_t)b * RD + lane] = k1 * cs - k2 * sn; out[O_KRS + (size_t)b * RD + 16 + lane] = k2 * cs + k1 * sn; }
    f32x4 u0, u1;
#pragma unroll
    for (int e = 0; e < 4; ++e) { u0[e] = ga0[e] / (1.0f + __expf(-gg0[e])); u1[e] = ga1[e] / (1.0f + __expf(-gg1[e])); }
    const float* __restrict__ st = a.in[I_SCONV] + (size_t)b * 30 * CCH + c0; const float* __restrict__ cw = a.in[I_CONVW] + c0; float* __restrict__ os = out + O_CONVS + (size_t)b * 30 * CCH + c0;
    *(f32x4*)(os + 29 * CCH) = u0; *(f32x4*)(os + 29 * CCH + 4) = u1;
    f32x4 a0 = *(const f32x4*)(a.in[I_CONVB] + c0), a1 = *(const f32x4*)(a.in[I_CONVB] + c0 + 4);
#pragma unroll 10
    for (int jj = 0; jj < 30; ++jj) { const f32x4 s0 = *(const f32x4*)(st + jj * CCH), s1 = *(const f32x4*)(st + jj * CCH + 4);
        a0 += s0 * *(const f32x4*)(cw + jj * CCH); a1 += s1 * *(const f32x4*)(cw + jj * CCH + 4); }
#pragma unroll 10
    for (int jj = 1; jj < 30; ++jj) { *(f32x4*)(os + (jj - 1) * CCH) = *(const f32x4*)(st + jj * CCH); *(f32x4*)(os + (jj - 1) * CCH + 4) = *(const f32x4*)(st + jj * CCH + 4); }
    a0 += u0 * *(const f32x4*)(cw + 30 * CCH); a1 += u1 * *(const f32x4*)(cw + 30 * CCH + 4);
    const float mean = wave_sum((a0[0] + a0[1]) + (a0[2] + a0[3]) + (a1[0] + a1[1]) + (a1[2] + a1[3])) * (1.0f / CCH);
    a0 = a0 - mean; a1 = a1 - mean;
    const float var = wave_sum((a0[0] * a0[0] + a0[1] * a0[1]) + (a0[2] * a0[2] + a0[3] * a0[3]) + (a1[0] * a1[0] + a1[1] * a1[1]) + (a1[2] * a1[2] + a1[3] * a1[3])) * (1.0f / CCH);
    const float rstd = 1.0f / sqrtf(var + LN_EPS);
    f32x4 y0 = a0 * rstd * *(const f32x4*)(a.in[I_CLNG] + c0) + *(const f32x4*)(a.in[I_CLNB] + c0), y1 = a1 * rstd * *(const f32x4*)(a.in[I_CLNG] + c0 + 4) + *(const f32x4*)(a.in[I_CLNB] + c0 + 4);
#pragma unroll
    for (int e = 0; e < 4; ++e) { y0[e] = y0[e] / (1.0f + __expf(-y0[e])); y1[e] = y1[e] / (1.0f + __expf(-y1[e])); }
    v4u o; o.x = pk2(y0[0], y0[1]); o.y = pk2(y0[2], y0[3]); o.z = pk2(y1[0], y1[1]); o.w = pk2(y1[2], y1[3]);
    *(v4u*)(AC + qrow * DM + CCH + c0) = o;
}

__device__ __forceinline__ void qlat_wave(Frame& F, const Args& a, int unit) {
    const float* __restrict__ z = (const float*)(a.ws + WS_ZS); const float* __restrict__ wuk = a.in[I_WUK]; float* __restrict__ QLAT = (float*)(a.ws + WS_QLAT);
    const int lane = F.lane, r16 = lane & 15, g = lane >> 4, h = unit >> 4, l0 = (unit & 15) * 16;
    f32x4 af[8][2][2], bf_[2][2];
#pragma unroll
    for (int ks = 0; ks < 2; ++ks) { const float* wp = wuk + ((size_t)(l0 + r16) * 8 + h) * 64 + 32 * ks + 8 * g; bf_[ks][0] = *(const f32x4*)wp; bf_[ks][1] = *(const f32x4*)(wp + 4);
#pragma unroll
        for (int mt = 0; mt < 8; ++mt) { const float* zp = z + (size_t)(16 * mt + r16) * NIN + h * 96 + 32 * ks + 8 * g; af[mt][ks][0] = *(const f32x4*)zp; af[mt][ks][1] = *(const f32x4*)(zp + 4); } }
    f32x4 acc[8];
#pragma unroll
    for (int mt = 0; mt < 8; ++mt) acc[mt] = (f32x4){0.f, 0.f, 0.f, 0.f};
#pragma unroll
    for (int ks = 0; ks < 2; ++ks) { v4u bw; bw.x = pk2(bf_[ks][0][0], bf_[ks][0][1]); bw.y = pk2(bf_[ks][0][2], bf_[ks][0][3]); bw.z = pk2(bf_[ks][1][0], bf_[ks][1][1]); bw.w = pk2(bf_[ks][1][2], bf_[ks][1][3]);
        const bf16x8 bfr = __builtin_bit_cast(bf16x8, bw);
#pragma unroll
        for (int mt = 0; mt < 8; ++mt) { const f32x4 a0 = af[mt][ks][0] * QS_MLA, a1 = af[mt][ks][1] * QS_MLA; v4u aw; aw.x = pk2(a0[0], a0[1]); aw.y = pk2(a0[2], a0[3]); aw.z = pk2(a1[0], a1[1]); aw.w = pk2(a1[2], a1[3]);
            acc[mt] = __builtin_amdgcn_mfma_f32_16x16x32_bf16(__builtin_bit_cast(bf16x8, aw), bfr, acc[mt], 0, 0, 0); } }
#pragma unroll
    for (int mt = 0; mt < 8; ++mt)
#pragma unroll
        for (int r = 0; r < 4; ++r) QLAT[((size_t)(16 * mt + 4 * g + r) * 8 + h) * 256 + l0 + r16] = acc[mt][r];
}

__device__ __forceinline__ f32x4 skinny_tile(Frame& F, const bf16* A, int lda, const bf16* Bt, int K, int n0) {
    const int lane = F.lane, w = F.wave, r16 = lane & 15, g = lane >> 4, kw = K >> 3;
    f32x4 acc[8];
#pragma unroll
    for (int mt = 0; mt < 8; ++mt) acc[mt] = (f32x4){0.f, 0.f, 0.f, 0.f};
    const bf16* ap = A + (size_t)r16 * lda + w * kw + 8 * g; const bf16* bp = Bt + (size_t)(n0 + r16) * K + w * kw + 8 * g;
#pragma unroll 1
    for (int kb = 0; kb < kw; kb += 128) {
        bf16x8 bf[4], af[4][8];
#pragma unroll
        for (int ks = 0; ks < 4; ++ks) { bf[ks] = *(const bf16x8*)(bp + kb + 32 * ks);
#pragma unroll
            for (int mt = 0; mt < 8; ++mt) af[ks][mt] = *(const bf16x8*)(ap + (size_t)(16 * mt) * lda + kb + 32 * ks); }
        __builtin_amdgcn_sched_barrier(0);
#pragma unroll
        for (int ks = 0; ks < 4; ++ks)
#pragma unroll
            for (int mt = 0; mt < 8; ++mt) acc[mt] = __builtin_amdgcn_mfma_f32_16x16x32_bf16(af[ks][mt], bf[ks], acc[mt], 0, 0, 0);
    }
    LAS float* red = (LAS float*)F.lds;
#pragma unroll
    for (int mt = 0; mt < 8; ++mt) *(LAS f32x4*)(red + (w * 16 + r16) * 128 + 16 * mt + 4 * g) = acc[mt];
    __syncthreads();
    const int row = F.tid >> 2, c4 = (F.tid & 3) * 4; f32x4 v = (f32x4){0.f, 0.f, 0.f, 0.f};
#pragma unroll
    for (int k = 0; k < 8; ++k)
#pragma unroll
        for (int j = 0; j < 4; ++j) v[j] += red[(k * 16 + c4 + j) * 128 + row];
    return v;
}
__device__ __forceinline__ void sample_stats(Frame& F, const float* sslot) {
    const int row = F.tid >> 2, part = F.tid & 3; float s1 = 0.f, s2 = 0.f;
#pragma unroll
    for (int i = 0; i < 16; ++i) { const f32x2 p = *(const f32x2*)(sslot + ((size_t)row * 64 + part * 16 + i) * 2); s1 += p[0]; s2 += p[1]; }
    s1 += __shfl_xor(s1, 1); s1 += __shfl_xor(s1, 2); s2 += __shfl_xor(s2, 1); s2 += __shfl_xor(s2, 2);
    const float mean = s1 * (1.0f / DM), var = s2 * (1.0f / DM) - mean * mean;
    if (part == 0) *(LAS f32x2*)(F.lds + 65536 + row * 8) = (f32x2){mean, 1.0f / sqrtf(var + LN_EPS)};
}
__device__ __forceinline__ void slice_stats_store(Frame& F, float* sslot, int unit, f32x4 v) {
    float s1 = (v[0] + v[1]) + (v[2] + v[3]), s2 = (v[0] * v[0] + v[1] * v[1]) + (v[2] * v[2] + v[3] * v[3]);
    s1 += __shfl_xor(s1, 1); s1 += __shfl_xor(s1, 2); s2 += __shfl_xor(s2, 1); s2 += __shfl_xor(s2, 2);
    if ((F.tid & 3) == 0) st_wt8(sslot + ((size_t)(F.tid >> 2) * 64 + unit) * 2, __builtin_bit_cast(unsigned, s1), __builtin_bit_cast(unsigned, s2));
}
template <int WHICH> __device__ __forceinline__ void sample_gemm(Frame& F, const Args& a) {
    unsigned char* ws = a.ws; const float* vec = (const float*)(ws + WS_VEC);
    constexpr int NU = WHICH == 1 ? INC / 16 : (WHICH == 9 ? FF / 16 : DM / 16);
    constexpr bool DYN = true;
    constexpr int PREV = WHICH == 6 ? 5 : (WHICH == 9 ? 8 : (WHICH == 10 ? 9 : -1)), NUPREV = WHICH == 10 ? FF / 16 : DM / 16;
    LAS unsigned* lw = (LAS unsigned*)(F.lds + 67584);
    __syncthreads();
    const bool released = F.G >= 32 && (unsigned)__builtin_amdgcn_readfirstlane((int)F.MISC[10]) == 0xffffffffu;
    const bool one_shot = NU + 16 <= F.G;
    if (released) return;
    bool first = true;
    for (int u = F.vcu;; u += F.G) {
        if (DYN) {
            if (F.wave == 0) { unsigned gv = 0u;
                if (F.lane == 0) gv = __hip_atomic_fetch_add(F.ctl + CW_SKG + 64 * WHICH, 1u, RLX_AGENT);
                gv = (unsigned)__builtin_amdgcn_readfirstlane((int)gv); if (F.lane == 0) lw[0] = gv; }
            __syncthreads(); u = __builtin_amdgcn_readfirstlane((int)lw[0]); __syncthreads(); }
        if (u >= NU) break;
        if (DYN && first && PREV >= 0) wait_count(F, F.ctl + CW_SKD + 64 * (PREV >= 0 ? PREV : 0), (unsigned)NUPREV);
        first = false;
        const int n0 = 16 * u, row = F.tid >> 2, col = n0 + (F.tid & 3) * 4; const size_t ro = (size_t)(MP + row) * DM + col;
        if (WHICH == 1) { const f32x4 v = skinny_tile(F, (const bf16*)(ws + WS_XB) + (size_t)MP * DM, DM, (const bf16*)(ws + WS_WIN), DM, n0); st_wt16((float*)(ws + WS_ZS) + (size_t)row * NIN + col, v); }
        if (WHICH == 5) { const f32x4 xs = *(const f32x4*)(a.in[I_XS] + (size_t)row * DM + col);
            f32x4 v = skinny_tile(F, (const bf16*)(ws + WS_AC) + (size_t)MP * DM, DM, (const bf16*)(ws + WS_WO), DM, n0);
            v += ALPHA * xs;
            st_bf4_wt((bf16*)(ws + WS_X1B) + ro, v); slice_stats_store(F, (float*)(ws + WS_SSL1), u, v); }
        if (WHICH == 6) { sample_stats(F, (const float*)(ws + WS_SSL1)); const f32x4 cs = *(const f32x4*)(vec + VO_CSQ + col), bw = *(const f32x4*)(vec + VO_BWQ + col);
            f32x4 v = skinny_tile(F, (const bf16*)(ws + WS_X1B) + (size_t)MP * DM, DM, (const bf16*)(ws + WS_WXQ), DM, n0);
            const f32x2 st = *(const LAS f32x2*)(F.lds + 65536 + row * 8);
            v = ((v - st[0] * cs) * st[1] + bw) * QS_MEM; st_bf4_wt((bf16*)(ws + WS_QX) + ro, v); }
        if (WHICH == 8) { sample_stats(F, (const float*)(ws + WS_SSL1)); const v2u pw = *(const v2u*)((const bf16*)(ws + WS_X1B) + ro); const f32x4 g1 = *(const f32x4*)(a.in[I_LN1G] + col), b1 = *(const f32x4*)(a.in[I_LN1B] + col);
            f32x4 v = skinny_tile(F, (const bf16*)(ws + WS_OX) + (size_t)MP * DM, DM, (const bf16*)(ws + WS_WXO), DM, n0);
            const f32x2 st = *(const LAS f32x2*)(F.lds + 65536 + row * 8);
            const f32x4 pv = (f32x4){bflo(pw.x), bfhi(pw.x), bflo(pw.y), bfhi(pw.y)};
            const f32x4 x1 = (pv - st[0]) * st[1] * g1 + b1;
            v += ALPHA * x1; st_bf4_wt((bf16*)(ws + WS_X2B) + ro, v); slice_stats_store(F, (float*)(ws + WS_SSL2), u, v); }
        if (WHICH == 9) { sample_stats(F, (const float*)(ws + WS_SSL2)); const f32x4 cs = *(const f32x4*)(vec + VO_CSU + col), bw = *(const f32x4*)(vec + VO_BWU + col);
            f32x4 v = skinny_tile(F, (const bf16*)(ws + WS_X2B) + (size_t)MP * DM, DM, (const bf16*)(ws + WS_WUP), DM, n0);
            const f32x2 st = *(const LAS f32x2*)(F.lds + 65536 + row * 8);
            v = (v - st[0] * cs) * st[1] + bw;
#pragma unroll
            for (int j = 0; j < 4; ++j) { const float t = fmaxf(v[j], 0.f); v[j] = t * t; }
            st_bf4_wt((bf16*)(ws + WS_H) + (size_t)(MP + row) * FF + col, v); }
        if (WHICH == 10) { sample_stats(F, (const float*)(ws + WS_SSL2)); const v2u pw = *(const v2u*)((const bf16*)(ws + WS_X2B) + ro); const f32x4 g2 = *(const f32x4*)(a.in[I_LN2G] + col), b2 = *(const f32x4*)(a.in[I_LN2B] + col);
            f32x4 v = skinny_tile(F, (const bf16*)(ws + WS_H) + (size_t)MP * FF, FF, (const bf16*)(ws + WS_WDN), FF, n0);
            const f32x2 st = *(const LAS f32x2*)(F.lds + 65536 + row * 8);
            const f32x4 pv = (f32x4){bflo(pw.x), bfhi(pw.x), bflo(pw.y), bfhi(pw.y)};
            const f32x4 x2 = (pv - st[0]) * st[1] * g2 + b2;
            v += ALPHA * x2; st_bf4_wt((bf16*)(ws + WS_OX) + ro, v); }
        if (DYN) { asm volatile("s_waitcnt vmcnt(0)" ::: "memory"); }
        __syncthreads();
        if (DYN && F.wave == 0) { if (F.lane == 0) __hip_atomic_fetch_add(F.ctl + CW_SKD + 64 * WHICH, 1u, RLX_AGENT); }
        if (one_shot) break;
    }
}

constexpr int N_PHASES = 11;
#ifndef REP_P0
#define REP_P0 1
#endif
#ifndef REP_CONV
#define REP_CONV 1
#endif
#ifndef REP_SK
#define REP_SK 1
#endif
#ifndef REP_LN
#define REP_LN 1
#endif
#define REPEAT_1(...) __VA_ARGS__
#define REPEAT_2(...) __VA_ARGS__ __VA_ARGS__
#define REPEAT_X(n, ...) REPEAT_##n(__VA_ARGS__)
#define REPEAT(n, ...) REPEAT_X(n, __VA_ARGS__)
#ifndef REP_G1
#define REP_G1 1
#endif
#ifndef REP_G2
#define REP_G2 1
#endif
#ifndef REP_G4
#define REP_G4 1
#endif
#ifndef REP_G5
#define REP_G5 1
#endif
#ifndef REP_G7
#define REP_G7 1
#endif
#ifndef REP_G8
#define REP_G8 1
#endif
#ifndef REP_G9
#define REP_G9 1
#endif

#ifndef REP_DEC
#define REP_DEC 1
#endif
#ifndef REP_MLA
#define REP_MLA 1
#endif
#ifndef REP_CR
#define REP_CR 1
#endif
#ifndef REP_SCR
#define REP_SCR 1
#endif
#if defined(PROBE_PH)
#define STAMP(i) do { if (blockIdx.x == 0 && F.tid == 0) F.MISC[16 + (i)] = (unsigned)__builtin_amdgcn_s_memrealtime(); } while (0)
#ifndef PROBE_A
#define PROBE_A (16 + PROBE_PH)
#endif
#ifndef PROBE_B
#define PROBE_B (17 + PROBE_PH)
#endif
#define GSTAMP(k) do { if (PROBE_PH == (k) && blockIdx.x == 0 && F.tid == 0) F.MISC[11] = (unsigned)__builtin_amdgcn_s_memrealtime(); } while (0)
#else
#define STAMP(i) do { } while (0)
#define GSTAMP(k) do { } while (0)
#endif
__global__ void __launch_bounds__(NWAVES * 64, 2) fwd_kernel(Args args) {
    extern __shared__ __attribute__((aligned(16))) unsigned char lds[];
    Frame F;
    F.lds = (LAS unsigned char*)lds;
    F.MISC = (volatile LAS unsigned*)(F.lds + MISC_OFF);
    F.tid = threadIdx.x; F.lane = F.tid & 63; F.wave = __builtin_amdgcn_readfirstlane(F.tid >> 6);
    F.G = gridDim.x; { const int bx = blockIdx.x; F.vcu = (F.G % 8 == 0) ? (bx % 8) * (F.G / 8) + bx / 8 : bx; }
    unsigned char* ws = args.ws;
    F.ctl = (gu32*)(ws + WS_CTL);
    if (F.tid < 32) F.MISC[F.tid] = 0u;
    __syncthreads();
    XcdBarrier bar = xcd_barrier_post((unsigned*)(F.ctl + CW_BAR), F.MISC + 8);
    STAMP(0);
    const int lo = args.ph_lo, hi = args.ph_hi;
#ifndef PHMASK
#define PHMASK 0x7ff
#endif
#define IN(k) (((PHMASK >> (k)) & 1) && lo <= (k) && (k) < hi)
#define SEAM(k) do { if (IN(k) && IN((k) + 1)) xcd_barrier(bar); STAMP((k) + 1); asm volatile("" : "+v"(F.tid)); F.lane = F.tid & 63; } while (0)
    typedef pg8::bf16_t pb;

    if (IN(0)) { REPEAT(REP_P0, p0_prologue(F, args);) }
    SEAM(0);
    if (IN(1)) {
        pg8::Gemm g{(const pb*)(ws + WS_XB), (const pb*)(ws + WS_WIN), MT + MMEM, NIN + 2048, DM}; InOrder S; S.init(F.G, (int)blockIdx.x);
        EpiIn E{(bf16*)(ws + WS_Q), (bf16*)(ws + WS_CKV), (bf16*)(ws + WS_KR), (bf16*)(ws + WS_U), (bf16*)(ws + WS_MKB), (bf16*)(ws + WS_MVB), args.out, (const float*)(ws + WS_ROPE), args.in[I_KVG], (LAS float*)(F.lds + XL_OFF)};
        REPEAT(REP_G1, pg8::gemm_phase<EpiIn, InOrder, true, true>(F.lds + RING_OFF, g, S, E);)
        GSTAMP(1);
        xcd_arrive(bar);
        { float* vec = (float*)(ws + WS_VEC);
          for (int i = F.vcu * 512 + F.tid; i < 2 * 1024 + 2 * 4096; i += F.G * 512) {
              const float* p; int n, ld; float* o;
              if (i < 1024) { p = vec + VO_PCSQ; n = i; ld = 1024; o = vec + VO_CSQ; } else if (i < 2048) { p = vec + VO_PBWQ; n = i - 1024; ld = 1024; o = vec + VO_BWQ; }
              else if (i < 6144) { p = vec + VO_PCSU; n = i - 2048; ld = 4096; o = vec + VO_CSU; } else { p = vec + VO_PBWU; n = i - 6144; ld = 4096; o = vec + VO_BWU; }
              float sacc = 0.f;
#pragma unroll
              for (int k = 0; k < 16; ++k) sacc += p[k * ld + n];
              o[n] = sacc; } }
        sample_gemm<1>(F, args);
        xcd_wait(bar); STAMP(2); asm volatile("" : "+v"(F.tid)); F.lane = F.tid & 63;
    }
    if (IN(2)) {
        int kk_ = KVL; asm volatile("" : "+s"(kk_));
        pg8::Gemm g{(const pb*)(ws + WS_CKV), (const pb*)(ws + WS_WUKV), MP, 1024, kk_}; pg8::StaticOrder S; S.init(MP, 1024, F.G, (int)blockIdx.x);
        EpiB<0> E{(bf16*)(ws + WS_KN), 512, 512, (size_t)(WS_VV - WS_KN) / 2, 1.0f};
        REPEAT(REP_G2, pg8::gemm_phase<EpiB<0>, pg8::StaticOrder, true, true>(F.lds + RING_OFF, g, S, E);)
        GSTAMP(2);
        __syncthreads();
        REPEAT(REP_CONV, conv_phase(F, args);)
        xcd_arrive(bar);
        if (F.vcu < NS) wait_count(F, F.ctl + CW_SKD + 64 * 1, INC / 16);
        for (int n = F.vcu + F.G * F.wave; n < NS; n += F.G * NWAVES) srow_wave(F, args, n);
        if (F.wave == 1) for (int n = F.vcu; n < 128; n += F.G) qlat_wave(F, args, n);
        if (F.vcu < NS) {
            asm volatile("s_waitcnt vmcnt(0)" ::: "memory"); __syncthreads();
            if (F.wave == 0) { if (F.lane == 0) { __builtin_amdgcn_fence(__ATOMIC_RELEASE, "agent"); asm volatile("s_waitcnt vmcnt(0)" ::: "memory"); __hip_atomic_fetch_add(F.ctl + CW_SRW, 1u, RLX_AGENT); } } }
        xcd_wait(bar); STAMP(3); asm volatile("" : "+v"(F.tid)); F.lane = F.tid & 63;
    }
    if (IN(3)) {
        for (int rep_ = 0; rep_ < REP_MLA; ++rep_) p3_phase(F, args);
    }
    SEAM(3);
    if (IN(4)) {
        pg8::Gemm g{(const pb*)(ws + WS_AC), (const pb*)(ws + WS_WO), MP, DM, DM}; pg8::StaticOrder S; S.init(MP, DM, F.G, (int)blockIdx.x);
        EpiV<0, 2> E{(bf16*)(ws + WS_X1B), (float*)(ws + WS_SL1), (const bf16*)(ws + WS_XB), nullptr, nullptr, nullptr, (LAS float*)(F.lds + XL_OFF)};
        REPEAT(REP_G4, pg8::gemm_phase<EpiV<0, 2>, pg8::StaticOrder, true, true>(F.lds + RING_OFF, g, S, E);)
        GSTAMP(4);
        xcd_arrive(bar);
        sample_gemm<5>(F, args);
        xcd_wait(bar); STAMP(5); asm volatile("" : "+v"(F.tid)); F.lane = F.tid & 63;
    }
    if (IN(5)) {
        pg8::Gemm g{(const pb*)(ws + WS_X1B), (const pb*)(ws + WS_WXQ), MP, DM, DM}; pg8::StaticOrder S; S.init(MP, DM, F.G, (int)blockIdx.x);
        EpiFold<0> E{(bf16*)(ws + WS_QX), DM, (const float*)(ws + WS_SL1), (const float*)(ws + WS_VEC) + VO_CSQ, (const float*)(ws + WS_VEC) + VO_BWQ, QS_MEM};
        REPEAT(REP_G5, pg8::gemm_phase<EpiFold<0>, pg8::StaticOrder, true, true>(F.lds + RING_OFF, g, S, E);)
        GSTAMP(5);
        xcd_arrive(bar);
        sample_gemm<6>(F, args);
        xcd_wait(bar); STAMP(6); asm volatile("" : "+v"(F.tid)); F.lane = F.tid & 63;
    }
    if (IN(6)) {
        for (int rep_ = 0; rep_ < REP_CR; ++rep_) for (int n = F.vcu; n < NBATCH * 4 * 8; n += F.G) cross_unit32(F, args, n >> 3, n & 7);
        wait_count(F, F.ctl + CW_SKD + 64 * 6, DM / 16);
        for (int rep_ = 0; rep_ < REP_SCR; ++rep_) for (int n = F.vcu; n < NS * 2; n += F.G) scross_unit(F, args, n >> 1, n & 1);
    }
    SEAM(6);
    if (IN(7)) {
        pg8::Gemm g{(const pb*)(ws + WS_OX), (const pb*)(ws + WS_WXO), MP, DM, DM}; pg8::StaticOrder S; S.init(MP, DM, F.G, (int)blockIdx.x);
        EpiV<1, 1> E{(bf16*)(ws + WS_X2B), (float*)(ws + WS_SL2), (const bf16*)(ws + WS_X1B), (const float*)(ws + WS_SL1), args.in[I_LN1G], args.in[I_LN1B], (LAS float*)(F.lds + XL_OFF)};
        REPEAT(REP_G7, pg8::gemm_phase<EpiV<1, 1>, pg8::StaticOrder, true, true>(F.lds + RING_OFF, g, S, E);)
        GSTAMP(7);
        xcd_arrive(bar);
        sample_gemm<8>(F, args);
        xcd_wait(bar); STAMP(8); asm volatile("" : "+v"(F.tid)); F.lane = F.tid & 63;
    }
    if (IN(8)) {
        pg8::Gemm g{(const pb*)(ws + WS_X2B), (const pb*)(ws + WS_WUP), MP, FF, DM}; pg8::StaticOrder S; S.init(MP, FF, F.G, (int)blockIdx.x);
        EpiFold<1> E{(bf16*)(ws + WS_H), FF, (const float*)(ws + WS_SL2), (const float*)(ws + WS_VEC) + VO_CSU, (const float*)(ws + WS_VEC) + VO_BWU, 1.0f};
        REPEAT(REP_G8, pg8::gemm_phase<EpiFold<1>, pg8::StaticOrder, true, true>(F.lds + RING_OFF, g, S, E);)
        GSTAMP(8);
        xcd_arrive(bar);
        sample_gemm<9>(F, args);
        xcd_wait(bar); STAMP(9); asm volatile("" : "+v"(F.tid)); F.lane = F.tid & 63;
    }
    if (IN(9)) {
        pg8::Gemm g{(const pb*)(ws + WS_H), (const pb*)(ws + WS_WDN), MP, DM, FF}; pg8::StaticOrder S; S.init(MP, DM, F.G, (int)blockIdx.x);
        EpiV<1, 2> E{(bf16*)(ws + WS_OX), nullptr, (const bf16*)(ws + WS_X2B), (const float*)(ws + WS_SL2), args.in[I_LN2G], args.in[I_LN2B], (LAS float*)(F.lds + XL_OFF)};
        REPEAT(REP_G9, pg8::gemm_phase<EpiV<1, 2>, pg8::StaticOrder, true, true>(F.lds + RING_OFF, g, S, E);)
        GSTAMP(9);
        xcd_arrive(bar);
        sample_gemm<10>(F, args);
        xcd_wait(bar); STAMP(10); asm volatile("" : "+v"(F.tid)); F.lane = F.tid & 63;
    }
    if (IN(10)) {
        REPEAT(REP_LN, ln_final(F, (const bf16*)(ws + WS_OX), args.in[I_LN3G], args.in[I_LN3B], args.out, 0, MREAL, F.ctl + CW_SKD + 64 * 10, DM / 16);)
    }
#if defined(PROBE_PH)
    __syncthreads(); STAMP(11); __syncthreads();
    if (blockIdx.x == 0) { const unsigned dt = F.MISC[PROBE_B] - F.MISC[PROBE_A];
        const float sc = 1.0f + sqrtf((float)dt * 1e-5f);
        for (int i = F.tid; i < NS * RD; i += NWAVES * 64) args.out[O_KRS + i] *= sc; }
#endif
#undef IN
#undef SEAM
}

#ifndef MK_PER_PHASE
#define MK_PER_PHASE 0
#endif
extern "C" void kernel_launch(void* const* d_in, const int* in_sizes, int n_in, void* d_out, int out_size, void* d_ws, size_t ws_size, hipStream_t stream) {
    static int grid = 0;
    if (grid == 0) {
        if (n_in != 30 || out_size != (int)O_END || ws_size < WS_END) { fprintf(stderr, "kernel_launch: unexpected problem (n_in %d, out %d, ws %zu); nothing launched\n", n_in, out_size, ws_size); grid = -1; return; }
        int dev = 0, cus = 0, per_cu = 0;
        if (hipGetDevice(&dev) != hipSuccess || hipDeviceGetAttribute(&cus, hipDeviceAttributeMultiprocessorCount, dev) != hipSuccess) { grid = -1; return; }
        if (hipFuncSetAttribute((const void*)fwd_kernel, hipFuncAttributeMaxDynamicSharedMemorySize, LDS_BYTES) != hipSuccess) { fprintf(stderr, "kernel_launch: hipFuncSetAttribute failed\n"); grid = -1; return; }
        if (hipOccupancyMaxActiveBlocksPerMultiprocessor(&per_cu, (const void*)fwd_kernel, NWAVES * 64, LDS_BYTES) != hipSuccess || per_cu < 1) { fprintf(stderr, "kernel_launch: occupancy query says %d\n", per_cu); }
        (void)hipGetLastError();
        grid = cus;
    }
    if (grid < 0) return;
    if (hipMemsetAsync((char*)d_ws + WS_CTL, 0, CTL_ZERO_BYTES, stream) != hipSuccess) return;
    Args a{};
    for (int i = 0; i < 30; ++i) a.in[i] = (const float*)d_in[i];
    a.out = (float*)d_out; a.ws = (unsigned char*)d_ws;
#if MK_PER_PHASE
    for (int p = 0; p < N_PHASES; ++p) { a.ph_lo = p; a.ph_hi = p + 1; hipLaunchKernelGGL(fwd_kernel, dim3(grid), dim3(NWAVES * 64), LDS_BYTES, stream, a); }
#else
    a.ph_lo = 0; a.ph_hi = N_PHASES;
    hipLaunchKernelGGL(fwd_kernel, dim3(grid), dim3(NWAVES * 64), LDS_BYTES, stream, a);
#endif
    (void)in_sizes;
}
```

```cpp
#include <hip/hip_runtime.h>
#include <cstdio>
#include <cstdint>
namespace pg8 {
#define PG8_LAS __attribute__((address_space(3)))
typedef unsigned short bf16_t;
typedef short bf16x8 __attribute__((ext_vector_type(8)));
typedef float f32x4 __attribute__((ext_vector_type(4)));
typedef unsigned u32x4 __attribute__((ext_vector_type(4)));
constexpr int BM = 256, BK = 64, HALF = 128, HTB = HALF * BK * 2  , STAGE_BYTES = 8 * HTB, NXCD = 8, WGM = 8;

__host__ __device__ __forceinline__ int lds_byte(int r, int c) { const int st = (r >> 4) * 2 + (c >> 5), rr = r & 15, cc = c & 31, ob = rr * 64 + cc * 2; return st * 1024 + (ob ^ (((ob >> 9) & 1) << 5)); }
__host__ __device__ __forceinline__ void stage_rc(int b, int& R, int& C) { const int st = b / 1024, sb = b % 1024, swz = sb ^ (((sb >> 9) & 1) << 5); R = (st >> 1) * 16 + swz / 64; C = (st & 1) * 32 + (swz % 64) / 2; }
__host__ __device__ __forceinline__ int perm32(int rho) { const int n = rho >> 4, i = rho & 15; return 8 * (i >> 2) + 4 * n + (i & 3); }

struct Unit { int pm, pn; };
struct Gemm { const bf16_t* A; const bf16_t* Bt; int M, N, K; };

struct StaticOrder {
    int nM, nN, nwg, G, c;
    __host__ __device__ void init(int M, int N, int G_, int c_) { nM = M / BM; nN = N / BM; nwg = nM * nN; G = G_; c = c_; }
    __host__ __device__ bool next(int i, Unit& u) const {
        const long L = (long)i * G + c; if (L >= nwg) return false;
        int wgid = (int)L; { const int q = nwg / NXCD, r = nwg % NXCD, xcd = wgid % NXCD, off = wgid / NXCD; wgid = (xcd < r ? xcd * (q + 1) : r * (q + 1) + (xcd - r) * q) + off; }
        const int nig = WGM * nN, gid = wgid / nig, fm = gid * WGM, gsz = (nM - fm) < WGM ? (nM - fm) : WGM;
        u.pm = fm + ((wgid % nig) % gsz); u.pn = (wgid % nig) / gsz; return true;
    }
    __device__ __forceinline__ void a_ready(const Unit&) const {}
    __device__ __forceinline__ void done(const Unit&) const {}
};


template <class Epi, class Sched, bool ALIGN_EPI = false, bool SP2 = false>
__device__ __forceinline__ void gemm_phase(PG8_LAS unsigned char* lds, const Gemm g, const Sched& S, const Epi& E) {
    const int tid = threadIdx.x, wid = __builtin_amdgcn_readfirstlane(tid >> 6), lane = tid & 63, wr = wid >> 2, wc = wid & 3, fr = lane & 15, fq = lane >> 4;
    const int K = g.K, nt = K / BK;
    unsigned voffA[2], voffB[2];
#pragma unroll
    for (int i = 0; i < 2; ++i) { int R, C; stage_rc(tid * 16 + i * 8192, R, C); const int Rb = Epi::PERM ? ((R & ~31) + perm32(R & 31)) : R;
        voffA[i] = (unsigned)(R * K + C) * 2u; voffB[i] = (unsigned)(Rb * K + C) * 2u; }
    const size_t kstep = (size_t)(BK * 2);
    const size_t hstep = (size_t)HALF * K * 2;
    const size_t tstep = 2 * hstep;
    const unsigned ldsw = (unsigned)wid * 1024u;
    const int aoff = lds_byte(wr * 64 + fr, fq * 8), boff = lds_byte(wc * 32 + fr, fq * 8);
#define PG8_SA(b, h) (((b) * 2 + (h)) * HTB)
#define PG8_SB(b, h) ((4 + (b) * 2 + (h)) * HTB)
#define PG8_STAGE(bufoff, gbase, voff) do { _Pragma("unroll") for (int _i = 0; _i < 2; ++_i) \
        __builtin_amdgcn_global_load_lds((const unsigned*)((const char*)(gbase) + (voff)[_i]), (PG8_LAS unsigned*)(lds + (bufoff) + ldsw + _i * 8192), 16, 0, 0); } while (0)
#define PG8_LDA(dst, b, h) do { _Pragma("unroll") for (int m = 0; m < 4; ++m) _Pragma("unroll") for (int k = 0; k < 2; ++k) dst[m][k] = *(const PG8_LAS bf16x8*)(lds + PG8_SA(b, h) + aoff + m * 2048 + k * 1024); } while (0)
#define PG8_LDB(dst, b, h) do { _Pragma("unroll") for (int n = 0; n < 2; ++n) _Pragma("unroll") for (int k = 0; k < 2; ++k) dst[n][k] = *(const PG8_LAS bf16x8*)(lds + PG8_SB(b, h) + boff + n * 2048 + k * 1024); } while (0)
#define PG8_MMA(ai, bj, At, Bt) do { __builtin_amdgcn_s_setprio(1); _Pragma("unroll") for (int m = 0; m < 4; ++m) _Pragma("unroll") for (int n = 0; n < 2; ++n) _Pragma("unroll") for (int k = 0; k < 2; ++k) \
        acc[ai][bj][m][n] = __builtin_amdgcn_mfma_f32_16x16x32_bf16(Bt[n][k], At[m][k], acc[ai][bj][m][n], 0, 0, 0); __builtin_amdgcn_s_setprio(0); } while (0)
#define PG8_WAIT_V(n) asm volatile("s_waitcnt vmcnt(" #n ")" ::: "memory")
#define PG8_WAIT_L(n) asm volatile("s_waitcnt lgkmcnt(" #n ")" ::: "memory")
#define PG8_BAR __builtin_amdgcn_s_barrier()
#define PG8_SCHED __builtin_amdgcn_sched_barrier(0)
    Unit cur, nxt; int ui = 0;
    if (!S.next(0, cur)) return;
    f32x4 acc[2][2][4][2];
#pragma unroll
    for (int a = 0; a < 2; ++a)
#pragma unroll
        for (int b = 0; b < 2; ++b)
#pragma unroll
            for (int m = 0; m < 4; ++m)
#pragma unroll
                for (int n = 0; n < 2; ++n) acc[a][b][m][n] = (f32x4){0.f, 0.f, 0.f, 0.f};
    bf16x8 At[4][2], B0[2][2], B1[2][2];
    const char* cA = (const char*)g.A + (size_t)cur.pm * tstep; const char* cB = (const char*)g.Bt + (size_t)cur.pn * tstep;
    S.a_ready(cur);
    if constexpr (SP2) {
        PG8_STAGE(PG8_SB(0, 0), cB, voffB); PG8_STAGE(PG8_SB(0, 1), cB + hstep, voffB); PG8_STAGE(PG8_SA(0, 0), cA, voffA); PG8_STAGE(PG8_SA(0, 1), cA + hstep, voffA);
        if (wr == 1) PG8_BAR;
        PG8_WAIT_V(2); PG8_BAR;
        PG8_STAGE(PG8_SB(1, 0), cB + kstep, voffB); PG8_STAGE(PG8_SA(1, 0), cA + kstep, voffA); PG8_STAGE(PG8_SB(1, 1), cB + hstep + kstep, voffB);
        PG8_WAIT_V(6); PG8_BAR;
    } else {
        PG8_STAGE(PG8_SB(0, 0), cB, voffB); PG8_STAGE(PG8_SA(0, 0), cA, voffA); PG8_STAGE(PG8_SB(0, 1), cB + hstep, voffB); PG8_STAGE(PG8_SA(0, 1), cA + hstep, voffA);
        if (wr == 1) PG8_BAR;
        PG8_WAIT_V(4); PG8_BAR;
        PG8_STAGE(PG8_SB(1, 0), cB + kstep, voffB); PG8_STAGE(PG8_SA(1, 0), cA + kstep, voffA); PG8_STAGE(PG8_SB(1, 1), cB + hstep + kstep, voffB);
        PG8_WAIT_V(6); PG8_BAR;
    }
    for (;;) {
        const bool has_next = S.next(ui + 1, nxt);
        const char* nA = has_next ? (const char*)g.A + (size_t)nxt.pm * tstep : cA; const char* nB = has_next ? (const char*)g.Bt + (size_t)nxt.pn * tstep : cB;
        for (int t = 0; t < nt; t += 2) {
            const bool last = (t == nt - 2);
            const char* a1 = cA + (size_t)(t + 1) * kstep;
            const char* a2 = last ? nA : cA + (size_t)(t + 2) * kstep; const char* b2 = last ? nB : cB + (size_t)(t + 2) * kstep;
            const char* a3 = a2 + kstep; const char* b3 = b2 + kstep;
            if (last && has_next) S.a_ready(nxt);
            if constexpr (SP2) {
            PG8_LDB(B0, 0, 0); PG8_LDB(B1, 0, 1); PG8_SCHED; PG8_LDA(At, 0, 0); PG8_STAGE(PG8_SA(1, 1), a1 + hstep, voffA);
            PG8_WAIT_V(8); PG8_WAIT_L(0); PG8_BAR; PG8_MMA(0, 0, At, B0); PG8_MMA(0, 1, At, B1); PG8_BAR; PG8_SCHED;
            PG8_LDA(At, 0, 1); PG8_STAGE(PG8_SB(0, 0), b2, voffB); PG8_STAGE(PG8_SB(0, 1), b2 + hstep, voffB); PG8_STAGE(PG8_SA(0, 0), a2, voffA);
            PG8_WAIT_V(8); PG8_WAIT_L(0); PG8_BAR; PG8_MMA(1, 0, At, B0); PG8_MMA(1, 1, At, B1); PG8_BAR; PG8_SCHED;
            PG8_LDB(B0, 1, 0); PG8_LDB(B1, 1, 1); PG8_SCHED; PG8_LDA(At, 1, 0); PG8_STAGE(PG8_SA(0, 1), a2 + hstep, voffA);
            PG8_WAIT_V(8); PG8_WAIT_L(0); PG8_BAR; PG8_MMA(0, 0, At, B0); PG8_MMA(0, 1, At, B1); PG8_BAR; PG8_SCHED;
            PG8_LDA(At, 1, 1); PG8_STAGE(PG8_SB(1, 0), b3, voffB); PG8_STAGE(PG8_SB(1, 1), b3 + hstep, voffB); PG8_STAGE(PG8_SA(1, 0), a3, voffA);
            PG8_WAIT_V(8); PG8_WAIT_L(0); PG8_BAR; PG8_MMA(1, 0, At, B0); PG8_MMA(1, 1, At, B1); PG8_BAR; PG8_SCHED;
            } else {
            PG8_LDB(B0, 0, 0); PG8_SCHED; PG8_LDA(At, 0, 0); PG8_STAGE(PG8_SA(1, 1), a1 + hstep, voffA);
            PG8_WAIT_L(8); PG8_BAR; PG8_WAIT_L(0); PG8_MMA(0, 0, At, B0); PG8_BAR; PG8_SCHED;
            PG8_LDB(B1, 0, 1); PG8_STAGE(PG8_SB(0, 0), b2, voffB);
            PG8_BAR; PG8_WAIT_L(0); PG8_MMA(0, 1, At, B1); PG8_BAR;
            PG8_LDA(At, 0, 1); PG8_STAGE(PG8_SA(0, 0), a2, voffA);
            PG8_BAR; PG8_WAIT_L(0); PG8_MMA(1, 0, At, B0); PG8_BAR; PG8_SCHED;
            PG8_STAGE(PG8_SB(0, 1), b2 + hstep, voffB);
            PG8_WAIT_V(6); PG8_BAR; PG8_MMA(1, 1, At, B1); PG8_BAR;
            PG8_LDB(B0, 1, 0); PG8_SCHED; PG8_LDA(At, 1, 0); PG8_STAGE(PG8_SA(0, 1), a2 + hstep, voffA);
            PG8_WAIT_L(8); PG8_BAR; PG8_WAIT_L(0); PG8_MMA(0, 0, At, B0); PG8_BAR; PG8_SCHED;
            PG8_LDB(B1, 1, 1); PG8_STAGE(PG8_SB(1, 0), b3, voffB);
            PG8_BAR; PG8_WAIT_L(0); PG8_MMA(0, 1, At, B1); PG8_BAR;
            PG8_LDA(At, 1, 1); PG8_STAGE(PG8_SA(1, 0), a3, voffA);
            PG8_BAR; PG8_WAIT_L(0); PG8_MMA(1, 0, At, B0); PG8_BAR; PG8_SCHED;
            PG8_STAGE(PG8_SB(1, 1), b3 + hstep, voffB);
            PG8_WAIT_V(6); PG8_BAR; PG8_MMA(1, 1, At, B1); PG8_BAR;
            }
        }
        if constexpr (ALIGN_EPI) { if (wr == 0) PG8_BAR; }
        if constexpr (!Epi::AFTER_DRAIN) { E(acc, cur, wr, wc, fr, fq); S.done(cur); }
        if (!has_next) break;
#pragma unroll
        for (int a = 0; a < 2; ++a)
#pragma unroll
            for (int b = 0; b < 2; ++b)
#pragma unroll
                for (int m = 0; m < 4; ++m)
#pragma unroll
                    for (int n = 0; n < 2; ++n) acc[a][b][m][n] = (f32x4){0.f, 0.f, 0.f, 0.f};
        cur = nxt; cA = nA; cB = nB; ++ui;
        if constexpr (ALIGN_EPI) { if (wr == 1) PG8_BAR; }
    }
    PG8_WAIT_V(0);
    if constexpr (!ALIGN_EPI) { if (wr == 0) PG8_BAR; }
    PG8_BAR;
    if constexpr (Epi::AFTER_DRAIN) { E.fused(acc, cur, wr, wc, fr, fq, lds, wid, lane); S.done(cur); }
#undef PG8_SA
#undef PG8_SB
#undef PG8_STAGE
#undef PG8_LDA
#undef PG8_LDB
#undef PG8_MMA
#undef PG8_WAIT_V
#undef PG8_WAIT_L
#undef PG8_BAR
#undef PG8_SCHED
}
}

constexpr int DM = 1024, NBATCH = 16, SEQ = 2048, MP = NBATCH * SEQ, NS = 128, MT = 33024  , MREAL = MP + NS;
constexpr int MMEM = 4096, MEMT = 256;
constexpr int QC = 768, KVL = 256, RD = 32, CCH = 512, NIN = 2304, FF = 4096, INC = 2080;
constexpr int NPG = 64;
constexpr float LN_EPS = 1e-5f;
constexpr float ALPHA = 1.189207115002721f;
constexpr float LOG2E = 1.4426950408889634f;
constexpr float QS_MLA = 0.10206207261596577f * LOG2E;
constexpr float QS_MEM = 0.0625f * LOG2E;
constexpr size_t O_YP = 0, O_YS = O_YP + (size_t)MP * DM, O_CKVP = O_YS + (size_t)NS * DM, O_KRP = O_CKVP + (size_t)MP * KVL, O_CONVP = O_KRP + (size_t)MP * RD,
                 O_MKP = O_CONVP + (size_t)NBATCH * 30 * CCH, O_MVP = O_MKP + (size_t)MMEM * DM, O_CKVS = O_MVP + (size_t)MMEM * DM, O_KRS = O_CKVS + (size_t)NS * KVL,
                 O_CONVS = O_KRS + (size_t)NS * RD, O_END = O_CONVS + (size_t)NS * 30 * CCH;
static_assert(O_END == 53760000, "output size");

constexpr size_t MiB = 1u << 20;
constexpr size_t WS_CTL = 0, CTL_ZERO_BYTES = 128 * 1024;
constexpr size_t WS_WIN = 2 * MiB;
constexpr size_t WS_WXKV = WS_WIN + (size_t)NIN * DM * 2;
constexpr size_t WS_WUKV = 11 * MiB, WS_WO = 12 * MiB, WS_WXQ = 14 * MiB, WS_WXO = 16 * MiB, WS_WUP = 18 * MiB, WS_WDN = 26 * MiB;
constexpr size_t WS_ROPE = 34 * MiB;
constexpr size_t WS_PART = 35 * MiB, WS_PML = 37 * MiB, WS_QLAT = 38 * MiB;
constexpr size_t WS_VEC = 39 * MiB;
constexpr int VO_CSQ = 0, VO_BWQ = 1024, VO_CSU = 2048, VO_BWU = 6144, VO_PCSQ = 10240, VO_PBWQ = VO_PCSQ + 16 * 1024, VO_PCSU = VO_PBWQ + 16 * 1024, VO_PBWU = VO_PCSU + 16 * 4096, VO_END = VO_PBWU + 16 * 4096;
static_assert(VO_END * 4 <= (int)MiB, "vector region");
constexpr size_t WS_XB = 40 * MiB;
constexpr size_t WS_Q = 113 * MiB, WS_CKV = 162 * MiB, WS_KR = 179 * MiB, WS_U = 182 * MiB, WS_KN = 215 * MiB, WS_VV = 247 * MiB, WS_MKB = 279 * MiB, WS_MVB = 287 * MiB;
constexpr size_t WS_AC = 295 * MiB, WS_V = 360 * MiB, WS_X1 = 489 * MiB, WS_X1B = 618 * MiB, WS_QX = 683 * MiB, WS_OX = 748 * MiB, WS_X2 = 813 * MiB, WS_X2B = 942 * MiB, WS_H = 1007 * MiB;
constexpr size_t WS_SL1 = 1266 * MiB, WS_SL2 = 1268 * MiB;
constexpr size_t WS_SSL1 = 1270 * MiB, WS_SSL2 = 1271 * MiB;
constexpr size_t WS_ZS = 1272 * MiB, WS_XCH = 1274 * MiB, WS_END = 1276 * MiB;
static_assert(WS_WXKV + (size_t)2048 * DM * 2 <= WS_WUKV && WS_XB + (size_t)(MT + MMEM) * DM * 2 <= WS_Q && WS_Q + (size_t)MT * QC * 2 <= WS_CKV && WS_CKV + (size_t)MT * KVL * 2 <= WS_KR &&
              WS_KR + (size_t)MT * RD * 2 <= WS_U && WS_U + (size_t)MT * CCH * 2 <= WS_KN && WS_AC + (size_t)MT * DM * 2 <= WS_V && WS_V + (size_t)MT * DM * 4 <= WS_X1 && WS_X1 + (size_t)MT * DM * 4 <= WS_X1B &&
              WS_X1B + (size_t)MT * DM * 2 <= WS_QX && WS_X2 + (size_t)MT * DM * 4 <= WS_X2B && WS_H + (size_t)MT * FF * 2 <= WS_END, "d_ws map");
constexpr int CW_TMO = 0, CW_CODE = 1, CW_BAR = 4096, CW_CMB = 8192  , CW_SKG = 9216  , CW_SKD = 10240  , CW_SRW = 11264  , CW_SEAM = 16384;

constexpr int RING_OFF = 0, RING_BYTES = 131072;
constexpr int XL_OFF = 131072;
constexpr int LDS_BYTES = 147456, MISC_OFF = LDS_BYTES - 128;
constexpr int NWAVES = 8;

#define GAS __attribute__((address_space(1)))
#define LAS __attribute__((address_space(3)))
typedef unsigned short bf16;
typedef unsigned v4u __attribute__((ext_vector_type(4)));
typedef unsigned v2u __attribute__((ext_vector_type(2)));
typedef float f32x4 __attribute__((ext_vector_type(4)));
typedef float f32x2 __attribute__((ext_vector_type(2)));
typedef float f32x16 __attribute__((ext_vector_type(16)));
typedef short bf16x8 __attribute__((ext_vector_type(8)));
typedef short s16x4 __attribute__((ext_vector_type(4)));
typedef __bf16 bf16x2_t __attribute__((ext_vector_type(2)));
typedef GAS unsigned gu32;
#define RLX_AGENT __ATOMIC_RELAXED, __HIP_MEMORY_SCOPE_AGENT
#define LDS_WAIT() asm volatile("s_waitcnt lgkmcnt(0)" ::: "memory")
#define VM_WAIT() asm volatile("s_waitcnt vmcnt(0)" ::: "memory")
__device__ __forceinline__ unsigned pk2(float lo, float hi) { f32x2 v = {lo, hi}; bf16x2_t b = __builtin_convertvector(v, bf16x2_t); return __builtin_bit_cast(unsigned, b); }
__device__ __forceinline__ float bf2f(unsigned short h) { return __builtin_bit_cast(float, (unsigned)h << 16); }
__device__ __forceinline__ float bflo(unsigned w) { return __builtin_bit_cast(float, w << 16); }
__device__ __forceinline__ float bfhi(unsigned w) { return __builtin_bit_cast(float, w & 0xffff0000u); }
__device__ __forceinline__ float ex2(float x) { return __builtin_amdgcn_exp2f(x); }
__device__ __forceinline__ float wave_sum(float v) {
#pragma unroll
    for (int o = 1; o < 64; o <<= 1) v += __shfl_xor(v, o);
    return v;
}
__device__ __forceinline__ float wave_max(float v) {
#pragma unroll
    for (int o = 1; o < 64; o <<= 1) v = fmaxf(v, __shfl_xor(v, o));
    return v;
}
__device__ __forceinline__ s16x4 tr_read(const LAS unsigned char* p) { return __builtin_bit_cast(s16x4, __builtin_amdgcn_ds_read_tr16_b64_v4i16((LAS s16x4*)p)); }

#define XB_TMO      128
#define XB_XCNT(j)  (256  + 64 * (j))
#define XB_XSUB(j)  (1280 + 64 * (j))
#define XB_XGEN(j)  (2304 + 64 * (j))
#define XB_TOP      3328
#define XB_TOPGEN   3392
#define XCD_BAR_WORDS 3456
#define XB_SPIN_CAP (1u << 18)

__device__ __forceinline__ unsigned xb_ld(unsigned* p)              { return __hip_atomic_load(p, __ATOMIC_RELAXED, __HIP_MEMORY_SCOPE_AGENT); }
__device__ __forceinline__ unsigned xb_add(unsigned* p, unsigned v) { return __hip_atomic_fetch_add(p, v, __ATOMIC_RELAXED, __HIP_MEMORY_SCOPE_AGENT); }
__device__ __forceinline__ unsigned xb_xcc_id() { return (unsigned)__builtin_amdgcn_s_getreg((3 << 11) | 20) & 0xFu; }
#define XB_SPIN(cond, bar) do { unsigned _sp = 0; while (cond) { __builtin_amdgcn_s_sleep(1); \
    if ((++_sp & 255u) == 0u) { if (xb_ld(&(bar)[XB_TMO])) break; if (_sp > XB_SPIN_CAP) { atomicAdd(&(bar)[XB_TMO], 1u); break; } } } } while (0)

struct XcdBarrier {
    unsigned* bar; unsigned x;
    volatile LAS unsigned* st;
};

__device__ __forceinline__ XcdBarrier xcd_barrier_post(unsigned* bar, volatile LAS unsigned* st) {
    XcdBarrier b; b.bar = bar; b.x = xb_xcc_id(); b.st = st;
    if (threadIdx.x == 0) (void)xb_add(&bar[XB_XCNT(b.x)], 1u);
    return b;
}
__device__ __forceinline__ void xcd_barrier_complete(unsigned* bar, unsigned x, unsigned& nloc, unsigned& nx) {
    const unsigned G = gridDim.x * gridDim.y * gridDim.z;
    unsigned sum, cnt, mine, sp = 0u;
    for (;;) {
        sum = 0u; cnt = 0u; mine = 0u;
#pragma unroll
        for (unsigned j = 0; j < 16; ++j) { const unsigned c = xb_ld(&bar[XB_XCNT(j)]); sum += c; cnt += (c > 0u) ? 1u : 0u; mine = (j == x) ? c : mine; }
        if (sum == G) break;
        __builtin_amdgcn_s_sleep(1);
        if ((++sp & 255u) == 0u) { if (xb_ld(&bar[XB_TMO])) break; if (sp > XB_SPIN_CAP) { atomicAdd(&bar[XB_TMO], 1u); break; } }
    }
    nloc = mine > 0u ? mine : 1u; nx = cnt > 0u ? cnt : 1u;
}

__device__ __forceinline__ void xcd_barrier(const XcdBarrier& b) {
    asm volatile("s_waitcnt vmcnt(0)" ::: "memory");
    __syncthreads();
    if (threadIdx.x == 0) {
        unsigned* bar = b.bar;
        __builtin_amdgcn_s_waitcnt(0);
        unsigned nloc = b.st[0], nx = b.st[1];
        if (nloc == 0u) { xcd_barrier_complete(bar, b.x, nloc, nx); b.st[0] = nloc; b.st[1] = nx; }
        const unsigned old = xb_add(&bar[XB_XSUB(b.x)], 1u);
        const unsigned gen = old / nloc;
        if (old + 1u == (gen + 1u) * nloc) {
            __builtin_amdgcn_fence(__ATOMIC_RELEASE, "agent");
            asm volatile("s_waitcnt vmcnt(0)" ::: "memory");
            const unsigned og = xb_add(&bar[XB_TOP], 1u);
            const unsigned tg = og / nx;
            if (og + 1u == (tg + 1u) * nx) xb_add(&bar[XB_TOPGEN], 1u);
            else XB_SPIN(xb_ld(&bar[XB_TOPGEN]) == tg, bar);
            __builtin_amdgcn_fence(__ATOMIC_ACQUIRE, "agent");
            xb_add(&bar[XB_XGEN(b.x)], 1u);
            asm volatile("s_waitcnt vmcnt(0)" ::: "memory");
        } else {
            XB_SPIN(xb_ld(&bar[XB_XGEN(b.x)]) == gen, bar);
            __builtin_amdgcn_fence(__ATOMIC_ACQUIRE, "agent");
            asm volatile("s_waitcnt vmcnt(0)" ::: "memory");
        }
    }
    __syncthreads();
}

struct Args { const float* in[30]; float* out; unsigned char* ws; int ph_lo, ph_hi; };
static_assert(sizeof(Args) == 30 * 8 + 8 + 8 + 8, "Args has no padding");
enum { I_XP = 0, I_XS, I_CKV, I_KROPE, I_SCONV, I_MEMK, I_MEMV, I_PT, I_MEMP, I_WIN, I_KVG, I_WUK, I_WUV, I_CONVW, I_CONVB, I_CLNG, I_CLNB, I_WO, I_LN1G, I_LN1B,
       I_WXQ, I_WXK, I_WXV, I_WXO, I_LN2G, I_LN2B, I_WUP, I_WDN, I_LN3G, I_LN3B };
struct Frame {
    LAS unsigned char* lds;
    volatile LAS unsigned* MISC;
    gu32* ctl;
    int tid, lane, wave, vcu, G;
};

__device__ __forceinline__ void xcd_arrive(const XcdBarrier& b) {
    asm volatile("s_waitcnt vmcnt(0)" ::: "memory");
    __syncthreads();
    if (threadIdx.x == 0) {
        unsigned* bar = b.bar;
        __builtin_amdgcn_s_waitcnt(0);
        unsigned nloc = b.st[0], nx = b.st[1];
        if (nloc == 0u) { xcd_barrier_complete(bar, b.x, nloc, nx); b.st[0] = nloc; b.st[1] = nx; }
        const unsigned old = xb_add(&bar[XB_XSUB(b.x)], 1u);
        const unsigned gen = old / nloc;
        if (old + 1u == (gen + 1u) * nloc) {
            __builtin_amdgcn_fence(__ATOMIC_RELEASE, "agent");
            asm volatile("s_waitcnt vmcnt(0)" ::: "memory");
            const unsigned og = xb_add(&bar[XB_TOP], 1u);
            const unsigned tg = og / nx;
            if (og + 1u == (tg + 1u) * nx) xb_add(&bar[XB_TOPGEN], 1u);
            else XB_SPIN(xb_ld(&bar[XB_TOPGEN]) == tg, bar);
            __builtin_amdgcn_fence(__ATOMIC_ACQUIRE, "agent");
            xb_add(&bar[XB_XGEN(b.x)], 1u);
            asm volatile("s_waitcnt vmcnt(0)" ::: "memory");
            b.st[2] = 0xffffffffu;
        } else b.st[2] = gen;
    }
}
__device__ __forceinline__ void xcd_wait(const XcdBarrier& b) {
    if (threadIdx.x == 0) {
        unsigned* bar = b.bar; const unsigned gen = b.st[2];
        if (gen != 0xffffffffu) { XB_SPIN(xb_ld(&bar[XB_XGEN(b.x)]) == gen, bar); __builtin_amdgcn_fence(__ATOMIC_ACQUIRE, "agent"); asm volatile("s_waitcnt vmcnt(0)" ::: "memory"); }
    }
    __syncthreads();
}
__device__ __forceinline__ void st_wt8(void* p, unsigned lo, unsigned hi) { __hip_atomic_store((unsigned long long*)p, ((unsigned long long)hi << 32) | lo, __ATOMIC_RELAXED, __HIP_MEMORY_SCOPE_AGENT); }
__device__ __forceinline__ void st_bf4_wt(bf16* p, f32x4 v) { st_wt8(p, pk2(v[0], v[1]), pk2(v[2], v[3])); }
__device__ __forceinline__ void st_wt16(float* p, f32x4 v) { asm volatile("global_store_dwordx4 %0, %1, off sc1" :: "v"(p), "v"(v) : "memory"); }
__device__ __forceinline__ void wait_count(Frame& F, gu32* cnt, unsigned n) {
    if (F.wave == 0) {
        unsigned sp = 0u; while ((unsigned)__builtin_amdgcn_readfirstlane((int)__hip_atomic_load(cnt, RLX_AGENT)) < n) { __builtin_amdgcn_s_sleep(1); if (++sp > (1u << 22)) break; }
        __builtin_amdgcn_fence(__ATOMIC_ACQUIRE, "agent"); asm volatile("s_waitcnt vmcnt(0)" ::: "memory"); }
    __syncthreads();
}

template <bool FOLD>
__device__ __forceinline__ void transpose_item(const float* W, int N, int K, bf16* WT, int k0, int n0, int dst_row0, LAS float* scr, int lane, const float* g = nullptr, const float* b = nullptr, float* pcs = nullptr, float* pbw = nullptr) {
    float pc = 0.f, pb = 0.f;
#pragma unroll 8
    for (int i = 0; i < 32; ++i) { const int kk = 2 * i + (lane >> 5); float v = W[(size_t)(k0 + kk) * N + n0 + (lane & 31)];
        if (FOLD) { pb += v * b[k0 + kk]; v *= g[k0 + kk]; pc += v; }
        scr[kk * 33 + (lane & 31)] = v; }
    if (FOLD) { pc += __shfl_xor(pc, 32); pb += __shfl_xor(pb, 32); if (lane < 32) { pcs[n0 + lane] = pc; pbw[n0 + lane] = pb; } }
    LDS_WAIT(); asm volatile("" ::: "memory");
    const int c = lane & 7;
#pragma unroll
    for (int j = 0; j < 4; ++j) { const int n = (lane >> 3) + 8 * j; const LAS float* s = scr + (8 * c) * 33 + n;
        v4u o; o.x = pk2(s[0 * 33], s[1 * 33]); o.y = pk2(s[2 * 33], s[3 * 33]); o.z = pk2(s[4 * 33], s[5 * 33]); o.w = pk2(s[6 * 33], s[7 * 33]);
        *(GAS v4u*)(WT + (size_t)(dst_row0 + n) * K + k0 + 8 * c) = o; }
    LDS_WAIT(); asm volatile("" ::: "memory");
}
__device__ __forceinline__ int win_dst_row(int n0) {
    if (n0 < 1024) return n0;
    if (n0 < 1056) return 2048 + (n0 - 1024);
    if (n0 < 1568) { const int a = n0 - 1056; return 1024 + 256 * (a >> 7) + (a & 127); }
    const int g = n0 - 1568; return 1024 + 256 * (g >> 7) + 128 + (g & 127);
}
__device__ __forceinline__ void p0_prologue(Frame& F, const Args& a) {
    LAS float* scr = (LAS float*)(F.lds + F.wave * 16384);
    const int gw = F.vcu * NWAVES + F.wave, NGW = F.G * NWAVES;
    unsigned char* ws = a.ws; float* vec = (float*)(ws + WS_VEC);
    constexpr int C0 = 1040, C1 = C0 + 512, C2 = C1 + 512, C3 = C2 + 64, C4 = C3 + 64, C5 = C4 + 512, C6 = C5 + 512, C7 = C6 + 512, C8 = C7 + 2048, C9 = C8 + 2048;
    for (int it = gw; it < C9; it += NGW) {
        if (it < C0) { const int kb = it / 65, nb = it % 65; transpose_item<false>(a.in[I_WIN], INC, DM, (bf16*)(ws + WS_WIN), kb * 64, nb * 32, win_dst_row(nb * 32), scr, F.lane); }
        else if (it < C1) { const int r = it - C0; transpose_item<false>(a.in[I_WXK], DM, DM, (bf16*)(ws + WS_WXKV), (r >> 5) * 64, (r & 31) * 32, (r & 31) * 32, scr, F.lane); }
        else if (it < C2) { const int r = it - C1; transpose_item<false>(a.in[I_WXV], DM, DM, (bf16*)(ws + WS_WXKV), (r >> 5) * 64, (r & 31) * 32, 1024 + (r & 31) * 32, scr, F.lane); }
        else if (it < C3) { const int r = it - C2; transpose_item<false>(a.in[I_WUK], 512, KVL, (bf16*)(ws + WS_WUKV), (r >> 4) * 64, (r & 15) * 32, (r & 15) * 32, scr, F.lane); }
        else if (it < C4) { const int r = it - C3; transpose_item<false>(a.in[I_WUV], 512, KVL, (bf16*)(ws + WS_WUKV), (r >> 4) * 64, (r & 15) * 32, 512 + (r & 15) * 32, scr, F.lane); }
        else if (it < C5) { const int r = it - C4; transpose_item<false>(a.in[I_WO], DM, DM, (bf16*)(ws + WS_WO), (r >> 5) * 64, (r & 31) * 32, (r & 31) * 32, scr, F.lane); }
        else if (it < C6) { const int r = it - C5; transpose_item<true>(a.in[I_WXQ], DM, DM, (bf16*)(ws + WS_WXQ), (r >> 5) * 64, (r & 31) * 32, (r & 31) * 32, scr, F.lane, a.in[I_LN1G], a.in[I_LN1B], vec + VO_PCSQ + (r >> 5) * 1024, vec + VO_PBWQ + (r >> 5) * 1024); }
        else if (it < C7) { const int r = it - C6; transpose_item<false>(a.in[I_WXO], DM, DM, (bf16*)(ws + WS_WXO), (r >> 5) * 64, (r & 31) * 32, (r & 31) * 32, scr, F.lane); }
        else if (it < C8) { const int r = it - C7; transpose_item<true>(a.in[I_WUP], FF, DM, (bf16*)(ws + WS_WUP), (r >> 7) * 64, (r & 127) * 32, (r & 127) * 32, scr, F.lane, a.in[I_LN2G], a.in[I_LN2B], vec + VO_PCSU + (r >> 7) * 4096, vec + VO_PBWU + (r >> 7) * 4096); }
        else { const int r = it - C8; transpose_item<false>(a.in[I_WDN], DM, FF, (bf16*)(ws + WS_WDN), (r >> 5) * 64, (r & 31) * 32, (r & 31) * 32, scr, F.lane); }
    }
    { GAS v4u* z = (GAS v4u*)(ws + WS_WIN + (size_t)INC * DM * 2); const int n16 = (NIN - INC) * DM * 2 / 16;
      for (int i = F.vcu * 512 + F.tid; i < n16; i += F.G * 512) z[i] = (v4u){0u, 0u, 0u, 0u}; }
    bf16* XB = (bf16*)(ws + WS_XB);
    for (int rbase = gw; rbase < MT + MMEM; rbase += 4 * NGW) {
        f32x4 v[4][4];
#pragma unroll
        for (int q = 0; q < 4; ++q) { const int r = rbase + q * NGW;
            if (r < MT + MMEM && !(r >= MREAL && r < MT)) {
                const float* src = r < MP ? a.in[I_XP] + (size_t)r * DM : (r < MREAL ? a.in[I_XS] + (size_t)(r - MP) * DM : a.in[I_MEMP] + (size_t)(r - MT) * DM);
                const GAS f32x4* xr = (const GAS f32x4*)src + F.lane;
#pragma unroll
                for (int j = 0; j < 4; ++j) v[q][j] = xr[64 * j]; }
            else {
#pragma unroll
                for (int j = 0; j < 4; ++j) v[q][j] = (f32x4){0.f, 0.f, 0.f, 0.f}; } }
#pragma unroll
        for (int q = 0; q < 4; ++q) { const int r = rbase + q * NGW; if (r < MT + MMEM) { GAS unsigned long long* o8 = (GAS unsigned long long*)(XB + (size_t)r * DM) + F.lane;
#pragma unroll
            for (int j = 0; j < 4; ++j) o8[64 * j] = (unsigned long long)pk2(v[q][j].x, v[q][j].y) | ((unsigned long long)pk2(v[q][j].z, v[q][j].w) << 32); } }
    }
    float* rope = (float*)(ws + WS_ROPE);
    for (int idx = F.vcu * 512 + F.tid; idx < 2049 * 16; idx += F.G * 512) {
        const int p = idx >> 4, i = idx & 15; const double pos = (p == 2048) ? 8192.0 : (double)p;
        double f = 1.0; for (int k = 0; k < i; ++k) f *= 0.5623413251903491;
        const double x = pos * f; const double kq = __builtin_rint(x * 0.6366197723675814);
        double y = __builtin_fma(-kq, 1.5707963267948966, x); y = __builtin_fma(-kq, 6.123233995736766e-17, y);
        const int q = (int)((long long)kq & 3ll); const double y2 = y * y;
        const double sn = y * (1.0 + y2 * (-1.0 / 6 + y2 * (1.0 / 120 + y2 * (-1.0 / 5040 + y2 * (1.0 / 362880 + y2 * (-1.0 / 39916800 + y2 * (1.0 / 6227020800.0 + y2 * (-1.0 / 1307674368000.0))))))));
        const double cs = 1.0 + y2 * (-0.5 + y2 * (1.0 / 24 + y2 * (-1.0 / 720 + y2 * (1.0 / 40320 + y2 * (-1.0 / 3628800 + y2 * (1.0 / 479001600.0 + y2 * (-1.0 / 87178291200.0 + y2 * (1.0 / 20922789888000.0))))))));
        const double s = (q == 0) ? sn : (q == 1) ? cs : (q == 2) ? -sn : -cs;
        const double c = (q == 0) ? cs : (q == 1) ? -sn : (q == 2) ? -cs : sn;
        rope[p * 32 + i] = (float)c; rope[p * 32 + 16 + i] = (float)s;
    }
}

struct InOrder {
    pg8::StaticOrder s1, s2; int G, c;
    __device__ __forceinline__ void init(int G_, int c_) { s1.init(MP, NIN, 1, 0); s2.init(MMEM, 2048, 1, 0); G = G_; c = c_; }
    __device__ __forceinline__ bool next(int i, pg8::Unit& u) const {
        const int L = i * G + c;
        if (L < s1.nwg) return s1.next(L, u);
        if (!s2.next(L - s1.nwg, u)) return false;
        u.pm += MT / 256; u.pn += NIN / 256; return true;
    }
    __device__ __forceinline__ void a_ready(const pg8::Unit&) const {}
    __device__ __forceinline__ void done(const pg8::Unit&) const {}
};

__device__ __forceinline__ void st_bf4(bf16* p, f32x4 v) { v2u w; w.x = pk2(v[0], v[1]); w.y = pk2(v[2], v[3]); *(v2u*)p = w; }

struct EpiIn {
    static constexpr bool PERM = false, AFTER_DRAIN = false;
    bf16 *Q, *CKV, *KR, *U, *MKB, *MVB; float* out; const float* rope; const float* kvg; LAS float* xl;
    __device__ __forceinline__ void operator()(const pg8::f32x4 (&acc)[2][2][4][2], const pg8::Unit& u, int wr, int wc, int fr, int fq) const {
        const int row0 = u.pm * 256 + wr * 64 + fr;
        if (u.pm >= MT / 256) {
            const int cb = (u.pn - NIN / 256) * 256; const bool isv = cb >= 1024; const int c0 = (isv ? cb - 1024 : cb) + wc * 32 + 4 * fq;
            float* of = out + (isv ? O_MVP : O_MKP); bf16* ob = isv ? MVB : MKB;
#pragma unroll
            for (int ai = 0; ai < 2; ++ai)
#pragma unroll
                for (int m = 0; m < 4; ++m) { const size_t ro = (size_t)(row0 - MT + ai * 128 + m * 16) * DM;
#pragma unroll
                    for (int bj = 0; bj < 2; ++bj)
#pragma unroll
                        for (int n = 0; n < 2; ++n) { const int c = c0 + bj * 128 + n * 16; const f32x4 v = acc[ai][bj][m][n]; *(f32x4*)(of + ro + c) = v; st_bf4(ob + ro + c, v); } }
        } else if (u.pn < 3) {
#pragma unroll
            for (int bj = 0; bj < 2; ++bj) { const int grp = u.pn * 8 + bj * 4 + wc; const bool isr = (grp % 3) == 2; const int colb = grp * 32 + 4 * fq;
#pragma unroll
                for (int ai = 0; ai < 2; ++ai)
#pragma unroll
                    for (int m = 0; m < 4; ++m) { const int row = row0 + ai * 128 + m * 16; f32x4 v0 = acc[ai][bj][m][0], v1 = acc[ai][bj][m][1];
                        if (isr) { const int pidx = row >= MP ? 2048 : (row & 2047); const f32x4 cs = *(const f32x4*)(rope + pidx * 32 + 4 * fq), sn = *(const f32x4*)(rope + pidx * 32 + 16 + 4 * fq);
                            const f32x4 o0 = v0 * cs - v1 * sn, o1 = v1 * cs + v0 * sn; v0 = o0; v1 = o1; }
                        st_bf4(Q + (size_t)row * QC + colb, v0 * QS_MLA); st_bf4(Q + (size_t)row * QC + colb + 16, v1 * QS_MLA); } }
        } else if (u.pn == 3) {
#pragma unroll
            for (int ai = 0; ai < 2; ++ai)
#pragma unroll
                for (int m = 0; m < 4; ++m) { float ss = 0.f;
#pragma unroll
                    for (int bj = 0; bj < 2; ++bj)
#pragma unroll
                        for (int n = 0; n < 2; ++n) { const f32x4 v = acc[ai][bj][m][n]; ss += (v[0] * v[0] + v[1] * v[1]) + (v[2] * v[2] + v[3] * v[3]); }
                    ss += __shfl_xor(ss, 16); ss += __shfl_xor(ss, 32);
                    if (fq == 0) xl[(ai * 128 + wr * 64 + m * 16 + fr) * 4 + wc] = ss; }
            asm volatile("s_waitcnt lgkmcnt(0)" ::: "memory"); __builtin_amdgcn_s_barrier(); asm volatile("" ::: "memory");
#pragma unroll
            for (int ai = 0; ai < 2; ++ai)
#pragma unroll
                for (int m = 0; m < 4; ++m) { const int rl = ai * 128 + wr * 64 + m * 16 + fr, row = u.pm * 256 + rl; const f32x4 p = *(const LAS f32x4*)(xl + rl * 4);
                    const float rs = 1.0f / sqrtf(((p[0] + p[1]) + (p[2] + p[3])) * (1.0f / 256.0f) + LN_EPS);
                    float* of = row < MP ? out + O_CKVP + (size_t)row * KVL : out + O_CKVS + (size_t)(row - MP) * KVL;
#pragma unroll
                    for (int bj = 0; bj < 2; ++bj)
#pragma unroll
                        for (int n = 0; n < 2; ++n) { const int c = bj * 128 + wc * 32 + n * 16 + 4 * fq; const f32x4 o = acc[ai][bj][m][n] * rs * *(const f32x4*)(kvg + c);
                            st_bf4(CKV + (size_t)row * KVL + c, o); if (row < MREAL) *(f32x4*)(of + c) = o; } }
            asm volatile("s_waitcnt lgkmcnt(0)" ::: "memory"); __builtin_amdgcn_s_barrier(); asm volatile("" ::: "memory");
        } else if (u.pn < 8) {
            const int cb = (u.pn - 4) * 128 + wc * 32 + 4 * fq;
#pragma unroll
            for (int ai = 0; ai < 2; ++ai)
#pragma unroll
                for (int m = 0; m < 4; ++m) { const int row = row0 + ai * 128 + m * 16, t = row & 2047;
#pragma unroll
                    for (int n = 0; n < 2; ++n) { const f32x4 av = acc[ai][0][m][n], gv = acc[ai][1][m][n]; f32x4 o;
#pragma unroll
                        for (int j = 0; j < 4; ++j) o[j] = av[j] / (1.0f + __expf(-gv[j]));
                        const int c = cb + n * 16; st_bf4(U + (size_t)row * CCH + c, o);
                        if (row < MP) { if (t >= SEQ - 30) *(f32x4*)(out + O_CONVP + ((size_t)(row >> 11) * 30 + (t - (SEQ - 30))) * CCH + c) = o; }
                        else if (row < MREAL) *(f32x4*)(out + O_CONVS + ((size_t)(row - MP) * 30 + 29) * CCH + c) = o; } }
        } else {
            if (wc == 0) {
#pragma unroll
                for (int ai = 0; ai < 2; ++ai)
#pragma unroll
                    for (int m = 0; m < 4; ++m) { const int row = row0 + ai * 128 + m * 16; const f32x4 v0 = acc[ai][0][m][0], v1 = acc[ai][0][m][1];
                        const int pidx = row >= MP ? 2048 : (row & 2047); const f32x4 cs = *(const f32x4*)(rope + pidx * 32 + 4 * fq), sn = *(const f32x4*)(rope + pidx * 32 + 16 + 4 * fq);
                        const f32x4 o0 = v0 * cs - v1 * sn, o1 = v1 * cs + v0 * sn;
                        st_bf4(KR + (size_t)row * RD + 4 * fq, o0); st_bf4(KR + (size_t)row * RD + 16 + 4 * fq, o1);
                        if (row < MREAL) { float* of = row < MP ? out + O_KRP + (size_t)row * RD : out + O_KRS + (size_t)(row - MP) * RD; *(f32x4*)(of + 4 * fq) = o0; *(f32x4*)(of + 16 + 4 * fq) = o1; } }
            }
        }
    }
};

template <int ACT  > struct EpiB {
    static constexpr bool PERM = true, AFTER_DRAIN = false;
    bf16* O; int ldc; int split_cols; size_t split_stride; float scale;
    __device__ __forceinline__ void operator()(const pg8::f32x4 (&acc)[2][2][4][2], const pg8::Unit& u, int wr, int wc, int fr, int fq) const {
        const int row0 = u.pm * 256 + wr * 64 + fr; int colt = u.pn * 256; bf16* base = O;
        if (split_cols) { const int t = colt / split_cols; base += (size_t)t * split_stride; colt -= t * split_cols; }
        const int col0 = colt + wc * 32 + 8 * fq;
#pragma unroll
        for (int ai = 0; ai < 2; ++ai)
#pragma unroll
            for (int m = 0; m < 4; ++m) { bf16* rowp = base + (size_t)(row0 + ai * 128 + m * 16) * ldc + col0;
#pragma unroll
                for (int bj = 0; bj < 2; ++bj) { f32x4 v0 = acc[ai][bj][m][0], v1 = acc[ai][bj][m][1];
                    if (ACT == 1) {
#pragma unroll
                        for (int j = 0; j < 4; ++j) { const float a0 = fmaxf(v0[j], 0.f), a1 = fmaxf(v1[j], 0.f); v0[j] = a0 * a0; v1[j] = a1 * a1; } }
                    v0 = v0 * scale; v1 = v1 * scale; v4u w; w.x = pk2(v0[0], v0[1]); w.y = pk2(v0[2], v0[3]); w.z = pk2(v1[0], v1[1]); w.w = pk2(v1[2], v1[3]);
                    *(v4u*)(rowp + bj * 128) = w; } }
    }
};
__device__ __forceinline__ f32x2 row_stats4(const float* slot, int row) {
    const f32x4 a = *(const f32x4*)(slot + (size_t)row * 8), b = *(const f32x4*)(slot + (size_t)row * 8 + 4);
    const float mean = ((a[0] + a[2]) + (b[0] + b[2])) * (1.0f / DM), var = ((a[1] + a[3]) + (b[1] + b[3])) * (1.0f / DM) - mean * mean;
    return (f32x2){mean, 1.0f / sqrtf(var + LN_EPS)};
}
template <int MODE, int GRP  > struct EpiV {
    static constexpr bool PERM = true, AFTER_DRAIN = false;
    bf16* VB; float* slot; const bf16* r0; const float* pslot; const float* pg; const float* pb; LAS float* xl;
    __device__ __forceinline__ void operator()(const pg8::f32x4 (&acc)[2][2][4][2], const pg8::Unit& u, int wr, int wc, int fr, int fq) const {
        const int row0 = u.pm * 256 + wr * 64 + fr, col0 = u.pn * 256 + wc * 32 + 8 * fq;
        f32x4 gv[2][2], bv[2][2];
        if (MODE == 1) {
#pragma unroll
            for (int bj = 0; bj < 2; ++bj)
#pragma unroll
                for (int n = 0; n < 2; ++n) { gv[bj][n] = *(const f32x4*)(pg + col0 + bj * 128 + 4 * n); bv[bj][n] = *(const f32x4*)(pb + col0 + bj * 128 + 4 * n); } }
#pragma unroll
        for (int am = 0; am < 8 / GRP; ++am) {
            v4u rws[GRP][2]; f32x2 sts[GRP];
#pragma unroll
            for (int mm = 0; mm < GRP; ++mm) { const int ai = (am * GRP + mm) >> 2, m = (am * GRP + mm) & 3; const int row = row0 + ai * 128 + m * 16; const size_t ro = (size_t)row * DM + col0;
                rws[mm][0] = *(const v4u*)(r0 + ro); rws[mm][1] = *(const v4u*)(r0 + ro + 128);
                sts[mm] = (f32x2){0.f, 0.f}; if (MODE == 1) sts[mm] = row_stats4(pslot, row); }
#pragma unroll
            for (int mm = 0; mm < GRP; ++mm) { const int ai = (am * GRP + mm) >> 2, m = (am * GRP + mm) & 3; const int row = row0 + ai * 128 + m * 16; const size_t ro = (size_t)row * DM + col0; float s1 = 0.f, s2 = 0.f;
                const f32x2 st = sts[mm];
#pragma unroll
                for (int bj = 0; bj < 2; ++bj) { const v4u rw = rws[mm][bj];
                    f32x4 ra = (f32x4){bflo(rw.x), bfhi(rw.x), bflo(rw.y), bfhi(rw.y)}, rb = (f32x4){bflo(rw.z), bfhi(rw.z), bflo(rw.w), bfhi(rw.w)};
                    if (MODE == 1) { const float nm = -st[0] * st[1]; ra = (ra * st[1] + nm) * gv[bj][0] + bv[bj][0]; rb = (rb * st[1] + nm) * gv[bj][1] + bv[bj][1]; }
                    const f32x4 v0 = acc[ai][bj][m][0] + ALPHA * ra, v1 = acc[ai][bj][m][1] + ALPHA * rb;
                    v4u w; w.x = pk2(v0[0], v0[1]); w.y = pk2(v0[2], v0[3]); w.z = pk2(v1[0], v1[1]); w.w = pk2(v1[2], v1[3]); *(v4u*)(VB + ro + bj * 128) = w;
                    s1 += ((v0[0] + v0[1]) + (v0[2] + v0[3])) + ((v1[0] + v1[1]) + (v1[2] + v1[3]));
                    s2 += ((v0[0] * v0[0] + v0[1] * v0[1]) + (v0[2] * v0[2] + v0[3] * v0[3])) + ((v1[0] * v1[0] + v1[1] * v1[1]) + (v1[2] * v1[2] + v1[3] * v1[3])); }
                if (slot) { s1 += __shfl_xor(s1, 16); s1 += __shfl_xor(s1, 32); s2 += __shfl_xor(s2, 16); s2 += __shfl_xor(s2, 32);
                    if (fq == 0) *(LAS f32x2*)(xl + ((ai * 128 + wr * 64 + m * 16 + fr) * 4 + wc) * 2) = (f32x2){s1, s2}; } } }
        if (slot) {
            asm volatile("s_waitcnt lgkmcnt(0)" ::: "memory"); __builtin_amdgcn_s_barrier(); asm volatile("" ::: "memory");
            if (wc == 0 && fq == 0) {
#pragma unroll
                for (int ai = 0; ai < 2; ++ai)
#pragma unroll
                    for (int m = 0; m < 4; ++m) { const int rl = ai * 128 + wr * 64 + m * 16 + fr; const f32x4 a = *(const LAS f32x4*)(xl + rl * 8), b = *(const LAS f32x4*)(xl + rl * 8 + 4);
                        *(f32x2*)(slot + ((size_t)(u.pm * 256 + rl) * 4 + u.pn) * 2) = (f32x2){(a[0] + a[2]) + (b[0] + b[2]), (a[1] + a[3]) + (b[1] + b[3])}; } }
            asm volatile("s_waitcnt lgkmcnt(0)" ::: "memory"); __builtin_amdgcn_s_barrier(); asm volatile("" ::: "memory");
        }
    }
};
template <int ACT  > struct EpiFold {
    static constexpr bool PERM = true, AFTER_DRAIN = false;
    bf16* O; int ldc; const float* pslot; const float* cs; const float* bw; float scale;
    __device__ __forceinline__ void operator()(const pg8::f32x4 (&acc)[2][2][4][2], const pg8::Unit& u, int wr, int wc, int fr, int fq) const {
        const int row0 = u.pm * 256 + wr * 64 + fr, col0 = u.pn * 256 + wc * 32 + 8 * fq;
        f32x4 cv[2][2], bv[2][2];
#pragma unroll
        for (int bj = 0; bj < 2; ++bj)
#pragma unroll
            for (int n = 0; n < 2; ++n) { cv[bj][n] = *(const f32x4*)(cs + col0 + bj * 128 + 4 * n); bv[bj][n] = *(const f32x4*)(bw + col0 + bj * 128 + 4 * n); }
#pragma unroll
        for (int ai = 0; ai < 2; ++ai)
#pragma unroll
            for (int m = 0; m < 4; ++m) { const int row = row0 + ai * 128 + m * 16; const f32x2 st = row_stats4(pslot, row); bf16* rowp = O + (size_t)row * ldc + col0;
#pragma unroll
                for (int bj = 0; bj < 2; ++bj) { f32x4 v0 = (acc[ai][bj][m][0] - st[0] * cv[bj][0]) * st[1] + bv[bj][0], v1 = (acc[ai][bj][m][1] - st[0] * cv[bj][1]) * st[1] + bv[bj][1];
                    if (ACT == 1) {
#pragma unroll
                        for (int j = 0; j < 4; ++j) { const float a0 = fmaxf(v0[j], 0.f), a1 = fmaxf(v1[j], 0.f); v0[j] = a0 * a0; v1[j] = a1 * a1; } }
                    v0 = v0 * scale; v1 = v1 * scale; v4u w; w.x = pk2(v0[0], v0[1]); w.y = pk2(v0[2], v0[3]); w.z = pk2(v1[0], v1[1]); w.w = pk2(v1[2], v1[3]);
                    *(v4u*)(rowp + bj * 128) = w; } }
    }
};

__device__ __forceinline__ void ln_final(Frame& F, const bf16* V, const float* g, const float* b, float* out, int r_lo, int r_hi, gu32* cnt, unsigned cnt_n) {
    const int gw = F.vcu * NWAVES + F.wave, NGW = F.G * NWAVES;
    f32x4 gv[4], bv[4];
#pragma unroll
    for (int j = 0; j < 4; ++j) { gv[j] = *((const GAS f32x4*)g + F.lane + 64 * j); bv[j] = *((const GAS f32x4*)b + F.lane + 64 * j); }
    for (int rbase = r_lo + gw; rbase < r_hi; rbase += 4 * NGW) {
        if (rbase >= MP) { unsigned sp = 0u;
            while ((unsigned)__builtin_amdgcn_readfirstlane((int)__hip_atomic_load(cnt, RLX_AGENT)) < cnt_n) { __builtin_amdgcn_s_sleep(1); if (++sp > (1u << 22)) break; }
            __builtin_amdgcn_fence(__ATOMIC_ACQUIRE, "agent"); asm volatile("s_waitcnt vmcnt(0)" ::: "memory"); }
        v2u w[4][4];
#pragma unroll
        for (int q = 0; q < 4; ++q) { const int r = rbase + q * NGW; if (r < r_hi) { const GAS v2u* xr = (const GAS v2u*)(V + (size_t)r * DM) + F.lane;
#pragma unroll
            for (int j = 0; j < 4; ++j) w[q][j] = xr[64 * j]; } }
#pragma unroll
        for (int q = 0; q < 4; ++q) { const int r = rbase + q * NGW; if (r < r_hi) {
            f32x4 v[4]; float s = 0.f;
#pragma unroll
            for (int j = 0; j < 4; ++j) { v[j] = (f32x4){bflo(w[q][j].x), bfhi(w[q][j].x), bflo(w[q][j].y), bfhi(w[q][j].y)}; s += (v[j].x + v[j].y) + (v[j].z + v[j].w); }
            const float mean = wave_sum(s) * (1.f / DM); float s2 = 0.f;
#pragma unroll
            for (int j = 0; j < 4; ++j) { v[j] = v[j] - mean; s2 += (v[j].x * v[j].x + v[j].y * v[j].y) + (v[j].z * v[j].z + v[j].w * v[j].w); }
            const float rstd = 1.f / sqrtf(wave_sum(s2) * (1.f / DM) + LN_EPS);
            float* of = r < MP ? out + O_YP + (size_t)r * DM : out + O_YS + (size_t)(r - MP) * DM;
#pragma unroll
            for (int j = 0; j < 4; ++j) *((GAS f32x4*)of + F.lane + 64 * j) = v[j] * rstd * gv[j] + bv[j]; } }
    }
}

constexpr int CX_KSTR = 528, CX_VSTR = 544;
static_assert(256 * CX_VSTR <= MISC_OFF, "cross-attention LDS");
__device__ __forceinline__ void cross_unit32(Frame& F, const Args& a, int bh, int qblk) {
    const bf16* QX = (const bf16*)(a.ws + WS_QX); const bf16* MKB = (const bf16*)(a.ws + WS_MKB); const bf16* MVB = (const bf16*)(a.ws + WS_MVB); bf16* OX = (bf16*)(a.ws + WS_OX);
    const int b = bh >> 2, h = bh & 3, tid = F.tid, lane = F.lane, w = F.wave, q32 = lane & 31, hh = lane >> 5, gi = lane >> 4, i16 = lane & 15;
    const size_t qrow = (size_t)b * SEQ + qblk * 256 + 32 * w + q32;
    const int lr = tid >> 5, lc = tid & 31;
    { const bf16* ksrc = MKB + ((size_t)b * MEMT + lr) * DM + h * 256 + lc * 8;
      v4u rk[16];
#pragma unroll
      for (int i = 0; i < 16; ++i) rk[i] = *(const v4u*)(ksrc + (size_t)(16 * i) * DM);
#pragma unroll
      for (int i = 0; i < 16; ++i) *(LAS v4u*)(F.lds + (lr + 16 * i) * CX_KSTR + lc * 16) = rk[i]; }
    __syncthreads();
    f32x16 s[8];
#pragma unroll
    for (int kb = 0; kb < 8; ++kb)
#pragma unroll
        for (int r = 0; r < 16; ++r) s[kb][r] = 0.f;
    const LAS unsigned char* kp = F.lds + q32 * CX_KSTR + 16 * hh;
#pragma unroll
    for (int half = 0; half < 4; ++half) { bf16x8 qf[4];
#pragma unroll
        for (int k8 = 0; k8 < 4; ++k8) qf[k8] = *(const bf16x8*)(QX + qrow * DM + h * 256 + 16 * (4 * half + k8) + 8 * hh);
#pragma unroll
        for (int k8 = 0; k8 < 4; ++k8) {
#pragma unroll
            for (int kb = 0; kb < 8; ++kb) { const bf16x8 kf = *(const LAS bf16x8*)(kp + (32 * kb) * CX_KSTR + 32 * (4 * half + k8)); s[kb] = __builtin_amdgcn_mfma_f32_32x32x16_bf16(kf, qf[k8], s[kb], 0, 0, 0); if (kb == 3) __builtin_amdgcn_sched_barrier(0); }
            __builtin_amdgcn_sched_barrier(0); } }
    float mx = s[0][0];
#pragma unroll
    for (int kb = 0; kb < 8; ++kb)
#pragma unroll
        for (int r = 0; r < 16; ++r) mx = fmaxf(mx, s[kb][r]);
    mx = fmaxf(mx, __shfl_xor(mx, 32));
    unsigned pp[8][8]; float ps = 0.f;
#pragma unroll
    for (int kb = 0; kb < 8; ++kb)
#pragma unroll
        for (int j = 0; j < 8; ++j) { const float e0 = ex2(s[kb][2 * j] - mx), e1 = ex2(s[kb][2 * j + 1] - mx); ps += e0 + e1; pp[kb][j] = pk2(e0, e1); }
    ps += __shfl_xor(ps, 32);
    const float il = 1.0f / ps;
    { const bf16* vsrc = MVB + ((size_t)b * MEMT + lr) * DM + h * 256 + lc * 8;
      v4u rv[16];
#pragma unroll
      for (int i = 0; i < 16; ++i) rv[i] = *(const v4u*)(vsrc + (size_t)(16 * i) * DM);
      __syncthreads();
#pragma unroll
      for (int i = 0; i < 16; ++i) *(LAS v4u*)(F.lds + (lr + 16 * i) * CX_VSTR + lc * 16) = rv[i]; }
    __syncthreads();
    const LAS unsigned char* vb = F.lds + (4 * (gi >> 1) + (i16 >> 2)) * CX_VSTR + (16 * (gi & 1) + 4 * (i16 & 3)) * 2;
#pragma unroll 1
    for (int dh = 0; dh < 2; ++dh) {
        f32x16 o[4];
#pragma unroll
        for (int db = 0; db < 4; ++db)
#pragma unroll
            for (int r = 0; r < 16; ++r) o[db][r] = 0.f;
#pragma unroll
        for (int kb = 0; kb < 8; ++kb)
#pragma unroll
            for (int st = 0; st < 2; ++st) {
                const v4u pw = (v4u){pp[kb][4 * st], pp[kb][4 * st + 1], pp[kb][4 * st + 2], pp[kb][4 * st + 3]};
                const bf16x8 pf = __builtin_bit_cast(bf16x8, pw);
                const LAS unsigned char* vk = vb + (32 * kb + 16 * st) * CX_VSTR + dh * 256;
#pragma unroll
                for (int db = 0; db < 4; ++db) { const s16x4 lo = tr_read(vk + db * 64), hi = tr_read(vk + 8 * CX_VSTR + db * 64);
                    const bf16x8 av = (bf16x8){lo[0], lo[1], lo[2], lo[3], hi[0], hi[1], hi[2], hi[3]};
                    o[db] = __builtin_amdgcn_mfma_f32_32x32x16_bf16(av, pf, o[db], 0, 0, 0); }
                __builtin_amdgcn_sched_barrier(0); }
#pragma unroll
        for (int db = 0; db < 4; ++db)
#pragma unroll
            for (int rg = 0; rg < 4; ++rg) st_bf4(OX + qrow * DM + h * 256 + 128 * dh + 32 * db + 8 * rg + 4 * hh, (f32x4){o[db][4 * rg], o[db][4 * rg + 1], o[db][4 * rg + 2], o[db][4 * rg + 3]} * il);
    }
    __syncthreads();
}

__device__ __forceinline__ void scross_unit(Frame& F, const Args& a, int b, int hp) {
    const bf16* QX = (const bf16*)(a.ws + WS_QX); bf16* OX = (bf16*)(a.ws + WS_OX);
    const int lane = F.lane, w = F.wave, tid = F.tid;
    LAS float* SC = (LAS float*)F.lds;
    LAS float* OP = (LAS float*)(F.lds + 2048);
    const size_t qrow = (size_t)MP + b;
    f32x4 q[2];
#pragma unroll
    for (int j = 0; j < 2; ++j) { const v2u qq = *(const v2u*)(QX + qrow * DM + (2 * hp + j) * 256 + 4 * lane); q[j] = (f32x4){bflo(qq.x), bfhi(qq.x), bflo(qq.y), bfhi(qq.y)}; }
    const float* kb = a.in[I_MEMK] + ((size_t)b * MEMT) * DM + (2 * hp) * 256 + 4 * lane; const float* vb = a.in[I_MEMV] + ((size_t)b * MEMT) * DM + (2 * hp) * 256 + 4 * lane;
#pragma unroll 8
    for (int i = 0; i < 32; ++i) { const int mt = w * 32 + i;
        const f32x4 k0 = __builtin_nontemporal_load((const f32x4*)(kb + (size_t)mt * DM)), k1 = __builtin_nontemporal_load((const f32x4*)(kb + (size_t)mt * DM + 256));
        float d0 = (k0[0] * q[0][0] + k0[1] * q[0][1]) + (k0[2] * q[0][2] + k0[3] * q[0][3]), d1 = (k1[0] * q[1][0] + k1[1] * q[1][1]) + (k1[2] * q[1][2] + k1[3] * q[1][3]);
        d0 = wave_sum(d0); d1 = wave_sum(d1);
        if (lane == 0) { SC[mt] = d0; SC[256 + mt] = d1; } }
    __syncthreads();
    if (w < 2) { f32x4 s = *(const LAS f32x4*)(SC + w * 256 + 4 * lane); const float mx = wave_max(fmaxf(fmaxf(s[0], s[1]), fmaxf(s[2], s[3])));
#pragma unroll
        for (int j = 0; j < 4; ++j) s[j] = ex2(s[j] - mx);
        const float inv = 1.0f / wave_sum((s[0] + s[1]) + (s[2] + s[3]));
        *(LAS f32x4*)(SC + w * 256 + 4 * lane) = s * inv; }
    __syncthreads();
    f32x4 o0 = (f32x4){0.f, 0.f, 0.f, 0.f}, o1 = o0;
#pragma unroll 8
    for (int i = 0; i < 32; ++i) { const int mt = w * 32 + i; const float p0 = SC[mt], p1 = SC[256 + mt];
        const f32x4 v0 = __builtin_nontemporal_load((const f32x4*)(vb + (size_t)mt * DM)), v1 = __builtin_nontemporal_load((const f32x4*)(vb + (size_t)mt * DM + 256));
        o0 += p0 * v0; o1 += p1 * v1; }
    *(LAS f32x4*)(OP + w * 512 + 4 * lane) = o0; *(LAS f32x4*)(OP + w * 512 + 256 + 4 * lane) = o1;
    __syncthreads();
    { float s = 0.f;
#pragma unroll
      for (int k = 0; k < 8; ++k) s += OP[k * 512 + tid];
      OX[qrow * DM + (2 * hp) * 256 + tid] = (bf16)(pk2(s, 0.f) & 0xffffu); }
    __syncthreads();
}

constexpr int MLA_KSTR = 208, MLA_VSTR = 144, MLA_KT = 64 * MLA_KSTR, MLA_BUF = MLA_KT + 64 * MLA_VSTR;
constexpr int DT_STR = 592, DT_BYTES = 16 * DT_STR, P3_T = 2 * MLA_BUF, P3_QL = P3_T + 8 * DT_BYTES, P3_QN = P3_QL + 16 * DT_STR, P3_CTL = P3_QN + 2048, P3_QS0 = P3_CTL + 128;
static_assert(P3_QS0 + 4 * 3072 <= MISC_OFF && P3_T % 16 == 0 && P3_QS0 % 16 == 0, "phase-3 LDS map");
__device__ __forceinline__ void bar4(LAS unsigned* ctr, unsigned& target, int lane) {
    target += 4u;
    asm volatile("s_waitcnt lgkmcnt(0)" ::: "memory");
    if (lane == 0) __hip_atomic_fetch_add(ctr, 1u, __ATOMIC_RELAXED, __HIP_MEMORY_SCOPE_WORKGROUP);
    while (__hip_atomic_load(ctr, __ATOMIC_RELAXED, __HIP_MEMORY_SCOPE_WORKGROUP) < target) __builtin_amdgcn_s_sleep(1);
    asm volatile("" ::: "memory");
}
__device__ __forceinline__ void mla_unit4(Frame& F, const Args& a, int bh, int qblk, LAS unsigned* bctr, unsigned& btgt) {
    const bf16* Q = (const bf16*)(a.ws + WS_Q); const bf16* KN = (const bf16*)(a.ws + WS_KN); const bf16* VV = (const bf16*)(a.ws + WS_VV); const bf16* KR = (const bf16*)(a.ws + WS_KR); bf16* AC = (bf16*)(a.ws + WS_AC);
    const int b = bh >> 3, h = bh & 7, lane = F.lane, aw = F.wave, q32 = lane & 31, hh = lane >> 5, t4 = aw * 64 + lane;
    const size_t rb = (size_t)b * SEQ; const int q0 = qblk * 256, NT = 4 * (qblk + 1);
    const size_t qrow = rb + q0 + 64 * aw + q32;
    bf16x8 qf[3];
    LAS unsigned char* qst = F.lds + P3_T + aw * DT_BYTES + lane * 16; LAS unsigned char* qs0 = F.lds + P3_QS0 + aw * 3072 + lane * 16;
#pragma unroll
    for (int s = 0; s < 6; ++s) { const bf16x8 q0v = *(const bf16x8*)(Q + qrow * QC + h * 96 + 16 * s + 8 * hh); if (s < 3) qf[s] = q0v; else *(LAS bf16x8*)(qs0 + (s - 3) * 1024) = q0v;
        *(LAS bf16x8*)(qst + s * 1024) = *(const bf16x8*)(Q + (qrow + 32) * QC + h * 96 + 16 * s + 8 * hh); }
    f32x16 o[2][2];
#pragma unroll
    for (int r = 0; r < 16; ++r) { o[0][0][r] = 0.f; o[0][1][r] = 0.f; o[1][0][r] = 0.f; o[1][1][r] = 0.f; }
    float m[2] = {-1e30f, -1e30f}, l[2] = {0.f, 0.f};
    const int r0 = t4 >> 3, c0 = t4 & 7, rr = t4 >> 2, cr = t4 & 3;
    const bf16* vsrc = VV + (rb + r0) * 512 + h * 64 + c0 * 8; const bf16* nsrc = KN + (rb + r0) * 512 + h * 64 + c0 * 8; const bf16* rsrc = KR + (rb + rr) * RD + cr * 8;
    const int vdst = MLA_KT + r0 * MLA_VSTR + c0 * 16, ndst = r0 * MLA_KSTR + c0 * 16, rdst = rr * MLA_KSTR + 128 + cr * 16;
    v4u pv0, pv1, pn0, pn1, pr;
#define MLA_LOAD(t_) do { const size_t off_ = (size_t)(t_) * 64; pv0 = *(const v4u*)(vsrc + off_ * 512); pv1 = *(const v4u*)(vsrc + (off_ + 32) * 512); pn0 = *(const v4u*)(nsrc + off_ * 512); pn1 = *(const v4u*)(nsrc + (off_ + 32) * 512); pr = *(const v4u*)(rsrc + off_ * RD); } while (0)
#define MLA_STORE(buf_) do { LAS unsigned char* nb_ = (buf_); *(LAS v4u*)(nb_ + vdst) = pv0; *(LAS v4u*)(nb_ + vdst + 32 * MLA_VSTR) = pv1; *(LAS v4u*)(nb_ + ndst) = pn0; *(LAS v4u*)(nb_ + ndst + 32 * MLA_KSTR) = pn1; *(LAS v4u*)(nb_ + rdst) = pr; } while (0)
    MLA_LOAD(0); MLA_STORE(F.lds);
    bar4(bctr, btgt, lane);
    const int qmin = q0 + 64 * aw, qpos = qmin + q32;
    const int gi = lane >> 4, i16 = lane & 15;
    for (int t = 0; t < NT; ++t) {
        const LAS unsigned char* Kt = F.lds + (t & 1) * MLA_BUF; const LAS unsigned char* Vt = Kt + MLA_KT;
        const bool more = t + 1 < NT;
        if (more) MLA_LOAD(t + 1);
        if (64 * t <= qmin + 63) {
            const bool diag = 64 * t + 63 > qmin;
            const LAS unsigned char* vb = Vt + (4 * (gi >> 1) + (i16 >> 2)) * MLA_VSTR + (16 * (gi & 1) + 4 * (i16 & 3)) * 2;
#pragma unroll
            for (int kb = 0; kb < 2; ++kb) {
                f32x16 s[2];
#pragma unroll
                for (int r = 0; r < 16; ++r) { s[0][r] = 0.f; s[1][r] = 0.f; }
#pragma unroll
                for (int ks = 0; ks < 6; ++ks) { const bf16x8 kf = *(const LAS bf16x8*)(Kt + (32 * kb + q32) * MLA_KSTR + (16 * ks + 8 * hh) * 2); const bf16x8 q1 = *(const LAS bf16x8*)(qst + ks * 1024);
                    const bf16x8 q0 = ks < 3 ? qf[ks < 3 ? ks : 0] : *(const LAS bf16x8*)(qs0 + (ks - 3) * 1024);
                    s[0] = __builtin_amdgcn_mfma_f32_32x32x16_bf16(kf, q0, s[0], 0, 0, 0); s[1] = __builtin_amdgcn_mfma_f32_32x32x16_bf16(kf, q1, s[1], 0, 0, 0);
                    if (ks & 1) __builtin_amdgcn_sched_barrier(0); }
                s16x4 vlo[2][2], vhi[2][2];
#pragma unroll
                for (int st = 0; st < 2; ++st)
#pragma unroll
                    for (int db = 0; db < 2; ++db) { const LAS unsigned char* vk = vb + (32 * kb + 16 * st) * MLA_VSTR + db * 64; vlo[st][db] = tr_read(vk); vhi[st][db] = tr_read(vk + 8 * MLA_VSTR); }
#pragma unroll
                for (int u = 0; u < 2; ++u) {
                    if (diag) {
#pragma unroll
                        for (int r = 0; r < 16; ++r) { const int key = 64 * t + 32 * kb + (r & 3) + 8 * (r >> 2) + 4 * hh; if (key > qpos + 32 * u) s[u][r] = -INFINITY; } }
                    float mx = fmaxf(s[u][0], s[u][1]);
#pragma unroll
                    for (int r = 2; r < 16; ++r) mx = fmaxf(mx, s[u][r]);
                    mx = fmaxf(mx, __shfl_xor(mx, 32));
                    if (__any(mx > m[u])) { const float mn = fmaxf(m[u], mx), al = ex2(m[u] - mn); m[u] = mn; l[u] *= al;
#pragma unroll
                        for (int r = 0; r < 16; ++r) { o[u][0][r] *= al; o[u][1][r] *= al; } }
                    float ps = 0.f; unsigned pp[8];
#pragma unroll
                    for (int j = 0; j < 8; ++j) { const float e0 = ex2(s[u][2 * j] - m[u]), e1 = ex2(s[u][2 * j + 1] - m[u]); ps += e0 + e1; pp[j] = pk2(e0, e1); }
                    l[u] += ps;
#pragma unroll
                    for (int st = 0; st < 2; ++st) {
                        const v4u pw = (v4u){pp[4 * st], pp[4 * st + 1], pp[4 * st + 2], pp[4 * st + 3]};
                        const bf16x8 pf = __builtin_bit_cast(bf16x8, pw);
#pragma unroll
                        for (int db = 0; db < 2; ++db) { const s16x4 lo = vlo[st][db], hi = vhi[st][db];
                            const bf16x8 av = (bf16x8){lo[0], lo[1], lo[2], lo[3], hi[0], hi[1], hi[2], hi[3]};
                            o[u][db] = __builtin_amdgcn_mfma_f32_32x32x16_bf16(av, pf, o[u][db], 0, 0, 0); } }
                }
            }
        }
        if (more) MLA_STORE(F.lds + ((t + 1) & 1) * MLA_BUF);
        bar4(bctr, btgt, lane);
    }
#undef MLA_LOAD
#undef MLA_STORE
#pragma unroll
    for (int u = 0; u < 2; ++u) { const float lt = l[u] + __shfl_xor(l[u], 32), il = 1.0f / lt;
#pragma unroll
        for (int db = 0; db < 2; ++db)
#pragma unroll
            for (int rg = 0; rg < 4; ++rg) st_bf4(AC + (qrow + 32 * u) * DM + h * 64 + 32 * db + 8 * rg + 4 * hh, (f32x4){o[u][db][4 * rg], o[u][db][4 * rg + 1], o[u][db][4 * rg + 2], o[u][db][4 * rg + 3]} * il); }
}

__device__ __forceinline__ void decode_setup4(Frame& F, const Args& a, int b) {
    const bf16* Q = (const bf16*)(a.ws + WS_Q); const float* QLAT = (const float*)(a.ws + WS_QLAT);
    const int lane = F.lane, w4 = F.wave - 4, t4 = w4 * 64 + lane;
    LAS unsigned char* QL = F.lds + P3_QL;
    const size_t qrow = (size_t)MP + b;
#pragma unroll
    for (int hp = 0; hp < 2; ++hp) { const int h = 2 * w4 + hp, l4 = lane * 4; const f32x4 ql = *(const f32x4*)(QLAT + ((size_t)b * 8 + h) * 256 + l4);
      v2u pw; pw.x = pk2(ql[0], ql[1]); pw.y = pk2(ql[2], ql[3]); *(LAS v2u*)(QL + h * DT_STR + l4 * 2) = pw; }
    for (int i = t4; i < 8 * DT_STR / 4; i += 256) ((LAS unsigned*)(QL + 8 * DT_STR))[i] = 0u;
    { const int h = t4 >> 5, r = t4 & 31; *(LAS bf16*)(QL + h * DT_STR + (256 + r) * 2) = Q[qrow * QC + h * 96 + 64 + r]; }
}
__device__ __forceinline__ void decode_stream(Frame& F, const Args& a, int b, int half, LAS unsigned* pctr, f32x4 (&o)[16], float& m, float& l) {
    const int lane = F.lane, w = F.wave, r16 = lane & 15, g = lane >> 4;
    const LAS unsigned char* QL = F.lds + P3_QL; LAS unsigned char* T = F.lds + P3_T + w * DT_BYTES;
    const LAS unsigned char* qlp = QL + r16 * DT_STR + 16 * g;
    const int* pt = (const int*)a.in[I_PT] + b * NPG + half * 32;
    const float* cck = a.in[I_CKV]; const float* ckr = a.in[I_KROPE];
    f32x4 cl[16], rp[2];
#define DEC_LOAD(blk_, pgi_) do { const float* cb_ = cck + ((size_t)(pgi_) * 128 + (blk_) * 16) * KVL + 4 * lane; const float* rb_ = ckr + ((size_t)(pgi_) * 128 + (blk_) * 16 + (lane >> 2)) * RD + (lane & 3) * 8; \
        _Pragma("unroll") for (int i_ = 0; i_ < 16; ++i_) cl[i_] = __builtin_nontemporal_load((const f32x4*)(cb_ + i_ * KVL)); \
        rp[0] = __builtin_nontemporal_load((const f32x4*)rb_); rp[1] = __builtin_nontemporal_load((const f32x4*)(rb_ + 4)); } while (0)
#define DEC_GRAB(dst_) do { unsigned v_ = 0u; if (lane == 0) v_ = __hip_atomic_fetch_add(pctr, 1u, __ATOMIC_RELAXED, __HIP_MEMORY_SCOPE_WORKGROUP); dst_ = (int)__builtin_amdgcn_readfirstlane(v_); } while (0)
    int pcur; DEC_GRAB(pcur);
    bool valid = pcur < 32; int pg = 0, blk = 0;
    if (valid) { pg = __builtin_amdgcn_readfirstlane(pt[pcur]); DEC_LOAD(0, pg); }
#pragma unroll 1
    while (valid) {
#pragma unroll
        for (int i = 0; i < 16; ++i) { v2u pw; pw.x = pk2(cl[i][0], cl[i][1]); pw.y = pk2(cl[i][2], cl[i][3]); *(LAS v2u*)(T + i * DT_STR + lane * 8) = pw; }
        { v4u pw; pw.x = pk2(rp[0][0], rp[0][1]); pw.y = pk2(rp[0][2], rp[0][3]); pw.z = pk2(rp[1][0], rp[1][1]); pw.w = pk2(rp[1][2], rp[1][3]); *(LAS v4u*)(T + (lane >> 2) * DT_STR + 512 + (lane & 3) * 16) = pw; }
        ++blk;
        if (blk == 8) { blk = 0; DEC_GRAB(pcur); valid = pcur < 32; if (valid) pg = __builtin_amdgcn_readfirstlane(pt[pcur]); }
        if (valid) DEC_LOAD(blk, pg);
        f32x4 sa = (f32x4){0.f, 0.f, 0.f, 0.f};
#pragma unroll
        for (int s = 0; s < 9; ++s) { const bf16x8 av = *(const LAS bf16x8*)(T + r16 * DT_STR + (32 * s + 8 * g) * 2); const bf16x8 qv = *(const LAS bf16x8*)(qlp + 64 * s); sa = __builtin_amdgcn_mfma_f32_16x16x32_bf16(av, qv, sa, 0, 0, 0); if (s % 3 == 2) __builtin_amdgcn_sched_barrier(0); }
        float mx = fmaxf(fmaxf(sa[0], sa[1]), fmaxf(sa[2], sa[3])); mx = fmaxf(mx, __shfl_xor(mx, 16)); mx = fmaxf(mx, __shfl_xor(mx, 32));
        if (__any(mx > m)) { const float mn = fmaxf(m, mx), al = ex2(m - mn); m = mn; l *= al;
#pragma unroll
            for (int lb = 0; lb < 16; ++lb) o[lb] = o[lb] * al; }
        float p[4];
#pragma unroll
        for (int r = 0; r < 4; ++r) p[r] = ex2(sa[r] - m);
        l += (p[0] + p[1]) + (p[2] + p[3]);
        v2u pw; pw.x = pk2(p[0], p[1]); pw.y = pk2(p[2], p[3]); const s16x4 pb = __builtin_bit_cast(s16x4, pw);
        const LAS unsigned char* tb = T + (4 * g + (r16 >> 2)) * DT_STR + (4 * (r16 & 3)) * 2;
#pragma unroll
        for (int lb = 0; lb < 16; ++lb) { const s16x4 av = tr_read(tb + lb * 32); o[lb] = __builtin_amdgcn_mfma_f32_16x16x16bf16_1k(av, pb, o[lb], 0, 0, 0); if ((lb & 3) == 3) __builtin_amdgcn_sched_barrier(0); }
    }
#undef DEC_LOAD
#undef DEC_GRAB
}
__device__ __forceinline__ void decode_finish4(Frame& F, const Args& a, int b, int half, const f32x4 (&o)[16], float m, float l, LAS unsigned* dctr, unsigned& dtgt) {
    float* PART = (float*)(a.ws + WS_PART); float* PML = (float*)(a.ws + WS_PML);
    const int lane = F.lane, w4 = F.wave - 4, t4 = w4 * 64 + lane, r16 = lane & 15, g = lane >> 4;
    l += __shfl_xor(l, 16); l += __shfl_xor(l, 32);
    LAS float* CB = (LAS float*)(F.lds + P3_T + 4 * DT_BYTES);
    LAS float* ML = CB + 4 * 8 * 256;
    bar4(dctr, dtgt, lane);
    if (r16 < 8) {
#pragma unroll
        for (int lb = 0; lb < 16; ++lb) *(LAS f32x4*)(CB + (w4 * 8 + r16) * 256 + 16 * lb + 4 * g) = o[lb];
        if (g == 0) { ML[(w4 * 8 + r16) * 2] = m; ML[(w4 * 8 + r16) * 2 + 1] = l; } }
    bar4(dctr, dtgt, lane);
    { const int h = t4 >> 5, l8 = (t4 & 31) * 8; float M = -1e30f;
#pragma unroll
      for (int k = 0; k < 4; ++k) M = fmaxf(M, ML[(k * 8 + h) * 2]);
      float L = 0.f; f32x4 acc0 = (f32x4){0.f, 0.f, 0.f, 0.f}, acc1 = (f32x4){0.f, 0.f, 0.f, 0.f};
#pragma unroll
      for (int k = 0; k < 4; ++k) { const float sc = ex2(ML[(k * 8 + h) * 2] - M); L += ML[(k * 8 + h) * 2 + 1] * sc;
          acc0 += sc * *(const LAS f32x4*)(CB + (k * 8 + h) * 256 + l8); acc1 += sc * *(const LAS f32x4*)(CB + (k * 8 + h) * 256 + l8 + 4); }
      const size_t pu = ((size_t)(b * 2 + half) * 8 + h);
      *(f32x4*)(PART + pu * 256 + l8) = acc0; *(f32x4*)(PART + pu * 256 + l8 + 4) = acc1;
      if ((t4 & 31) == 0) { PML[pu * 2] = M; PML[pu * 2 + 1] = L; } }
}
__device__ __forceinline__ void combine_unit4(Frame& F, const Args& a, int b) {
    const bf16* Q = (const bf16*)(a.ws + WS_Q); const float* PART = (const float*)(a.ws + WS_PART); const float* PML = (const float*)(a.ws + WS_PML); const float* QLAT = (const float*)(a.ws + WS_QLAT); bf16* AC = (bf16*)(a.ws + WS_AC);
    const int w4 = F.wave - 4, j = F.lane;
    LAS float* OL = (LAS float*)(F.lds + P3_T + 4 * DT_BYTES);
    const float* cn = a.out + O_CKVS + (size_t)b * KVL; const float* kn = a.out + O_KRS + (size_t)b * RD;
    const f32x4 c4 = *(const f32x4*)(cn + 4 * j);
#pragma unroll
    for (int hp = 0; hp < 2; ++hp) { const int h = 2 * w4 + hp;
        const f32x4 q4 = *(const f32x4*)(QLAT + ((size_t)b * 8 + h) * 256 + 4 * j);
        float sp = (q4[0] * c4[0] + q4[1] * c4[1]) + (q4[2] * c4[2] + q4[3] * c4[3]);
        if (j < 32) sp += bf2f(Q[((size_t)MP + b) * QC + h * 96 + 64 + j]) * kn[j];
        const float sn = wave_sum(sp);
        const size_t p0 = ((size_t)(b * 2) * 8 + h), p1 = ((size_t)(b * 2 + 1) * 8 + h);
        const float M0 = PML[p0 * 2], L0 = PML[p0 * 2 + 1], M1 = PML[p1 * 2], L1 = PML[p1 * 2 + 1];
        const float M = fmaxf(fmaxf(M0, M1), sn), w0 = ex2(M0 - M), w1 = ex2(M1 - M), wn = ex2(sn - M), il = 1.0f / (L0 * w0 + L1 * w1 + wn);
        const f32x4 a0 = *(const f32x4*)(PART + p0 * 256 + 4 * j), a1 = *(const f32x4*)(PART + p1 * 256 + 4 * j);
        *(LAS f32x4*)(OL + h * 256 + 4 * j) = (a0 * w0 + a1 * w1 + c4 * wn) * il; }
    asm volatile("s_waitcnt lgkmcnt(0)" ::: "memory");
#pragma unroll 1
    for (int hp = 0; hp < 2; ++hp) { const int h = 2 * w4 + hp;
        const float* wuv = a.in[I_WUV] + h * 64 + j; float acc = 0.f, acc2 = 0.f;
#pragma unroll 1
        for (int l0 = 0; l0 < 256; l0 += 64) {
            float wv[64];
#pragma unroll
            for (int i = 0; i < 64; ++i) wv[i] = wuv[(size_t)(l0 + i) * 512];
#pragma unroll
            for (int i = 0; i < 64; i += 2) { acc += OL[h * 256 + l0 + i] * wv[i]; acc2 += OL[h * 256 + l0 + i + 1] * wv[i + 1]; } }
        acc += acc2;
        AC[((size_t)MP + b) * DM + h * 64 + j] = (bf16)(pk2(acc, 0.f) & 0xffffu); }
}
#if defined(PROBE_PH)
#define SUBSTAMP(i, cond) do { if (blockIdx.x == 0 && (cond)) F.MISC[(i)] = (unsigned)__builtin_amdgcn_s_memrealtime(); } while (0)
#else
#define SUBSTAMP(i, cond) do { } while (0)
#endif
__device__ __forceinline__ void p3_phase(Frame& F, const Args& a) {
    LAS unsigned* ctl = (LAS unsigned*)(F.lds + P3_CTL);
    bool first = true;
    for (int du = F.vcu; first || du < NS * 2; du += F.G) {
        const bool has_dec = du < NS * 2; const int b = du >> 1, half = du & 1;
        if (F.tid == 0) { ctl[0] = 0u; ctl[8] = 0u; ctl[16] = 0u; }
        __syncthreads();
        asm volatile("" : "+v"(F.tid)); F.lane = F.tid & 63;
        SUBSTAMP(28, F.tid == 0);
        if (F.wave < 4) {
            if (first) { unsigned btgt = 0u; __builtin_amdgcn_s_setprio(2);
                for (int i = 0;; ++i) { const int n = i * F.G + F.vcu; if (n >= 1024) break;
                    const int r = n >> 8, v = n & 255, bh = v >> 1, s = v & 1, qa = 2 * s + (r >> 1), qblk = (r & 1) ? 7 - qa : qa;
                    mla_unit4(F, a, bh, qblk, ctl, btgt); }
                __builtin_amdgcn_s_setprio(0); SUBSTAMP(29, F.tid == 0); }
        } else if (has_dec) {
            unsigned dtgt = 0u;
            if (first) {
                if (F.wave == 4) { const unsigned nsrw = F.G < NS ? (unsigned)F.G : (unsigned)NS; unsigned sp = 0u;
                    while ((unsigned)__builtin_amdgcn_readfirstlane((int)__hip_atomic_load(F.ctl + CW_SRW, RLX_AGENT)) < nsrw) { __builtin_amdgcn_s_sleep(1); if (++sp > (1u << 22)) break; }
                    __builtin_amdgcn_fence(__ATOMIC_ACQUIRE, "agent"); asm volatile("s_waitcnt vmcnt(0)" ::: "memory"); }
                bar4(ctl + 8, dtgt, F.lane); }
            decode_setup4(F, a, b);
            bar4(ctl + 8, dtgt, F.lane);
            f32x4 o[16];
#pragma unroll
            for (int lb = 0; lb < 16; ++lb) o[lb] = (f32x4){0.f, 0.f, 0.f, 0.f};
            float m = -1e30f, l = 0.f;
            decode_stream(F, a, b, half, ctl + 16, o, m, l);
            SUBSTAMP(10, F.tid == 256);
            decode_finish4(F, a, b, half, o, m, l, ctl + 8, dtgt);
            asm volatile("s_waitcnt vmcnt(0)" ::: "memory");
            bar4(ctl + 8, dtgt, F.lane);
            if (F.wave == 4) { if (F.lane == 0) { __builtin_amdgcn_fence(__ATOMIC_RELEASE, "agent"); asm volatile("s_waitcnt vmcnt(0)" ::: "memory");
                const unsigned old = __hip_atomic_fetch_add((unsigned*)(F.ctl + CW_CMB) + b, 1u, __ATOMIC_RELAXED, __HIP_MEMORY_SCOPE_AGENT);
                if (old == 1u) { __builtin_amdgcn_fence(__ATOMIC_ACQUIRE, "agent"); asm volatile("s_waitcnt vmcnt(0)" ::: "memory"); }
                ctl[24] = old; } }
            bar4(ctl + 8, dtgt, F.lane);
            if (__builtin_amdgcn_readfirstlane((int)ctl[24]) == 1) combine_unit4(F, a, b);
            SUBSTAMP(31, F.tid == 256);
        }
        __syncthreads();
        SUBSTAMP(30, F.tid == 0);
        asm volatile("" : "+v"(F.tid)); F.lane = F.tid & 63;
        first = false;
    }
}


__device__ __forceinline__ void combine_unit(Frame& F, const Args& a, int b) {
    const bf16* Q = (const bf16*)(a.ws + WS_Q); const float* PART = (const float*)(a.ws + WS_PART); const float* PML = (const float*)(a.ws + WS_PML); const float* QLAT = (const float*)(a.ws + WS_QLAT); bf16* AC = (bf16*)(a.ws + WS_AC);
    const int tid = F.tid, h = tid >> 6, j = tid & 63;
    LAS float* OL = (LAS float*)F.lds;
    const float* cn = a.out + O_CKVS + (size_t)b * KVL; const float* kn = a.out + O_KRS + (size_t)b * RD;
    const f32x4 c4 = *(const f32x4*)(cn + 4 * j); const f32x4 q4 = *(const f32x4*)(QLAT + ((size_t)b * 8 + h) * 256 + 4 * j);
    float sp = (q4[0] * c4[0] + q4[1] * c4[1]) + (q4[2] * c4[2] + q4[3] * c4[3]);
    if (j < 32) sp += bf2f(Q[((size_t)MP + b) * QC + h * 96 + 64 + j]) * kn[j];
    const float sn = wave_sum(sp);
    const size_t p0 = ((size_t)(b * 2) * 8 + h), p1 = ((size_t)(b * 2 + 1) * 8 + h);
    const float M0 = PML[p0 * 2], L0 = PML[p0 * 2 + 1], M1 = PML[p1 * 2], L1 = PML[p1 * 2 + 1];
    const float M = fmaxf(fmaxf(M0, M1), sn), w0 = ex2(M0 - M), w1 = ex2(M1 - M), wn = ex2(sn - M), il = 1.0f / (L0 * w0 + L1 * w1 + wn);
    const f32x4 a0 = *(const f32x4*)(PART + p0 * 256 + 4 * j), a1 = *(const f32x4*)(PART + p1 * 256 + 4 * j);
    *(LAS f32x4*)(OL + h * 256 + 4 * j) = (a0 * w0 + a1 * w1 + c4 * wn) * il;
    __syncthreads();
    const float* wuv = a.in[I_WUV] + h * 64 + j; float acc = 0.f, acc2 = 0.f;
#pragma unroll 1
    for (int l0 = 0; l0 < 256; l0 += 64) {
        float wv[64];
#pragma unroll
        for (int i = 0; i < 64; ++i) wv[i] = wuv[(size_t)(l0 + i) * 512];
#pragma unroll
        for (int i = 0; i < 64; i += 2) { acc += OL[h * 256 + l0 + i] * wv[i]; acc2 += OL[h * 256 + l0 + i + 1] * wv[i + 1]; } }
    acc += acc2;
    AC[((size_t)MP + b) * DM + h * 64 + j] = (bf16)(pk2(acc, 0.f) & 0xffffu);
    __syncthreads();
}

constexpr int CV_UB = 62 * CCH * 2, CV_CB = 32 * CCH * 4;
__device__ __forceinline__ void conv_phase(Frame& F, const Args& a) {
    const bf16* U = (const bf16*)(a.ws + WS_U); bf16* AC = (bf16*)(a.ws + WS_AC);
    const int tid = F.tid, lane = F.lane, w = F.wave;
    LAS unsigned char* ub = F.lds;
    LAS float* cb = (LAS float*)(F.lds + CV_UB);
    const int cp = tid & 255, th = tid >> 8;
    f32x2 wt[31];
#pragma unroll
    for (int jj = 0; jj < 31; ++jj) wt[jj] = *(const f32x2*)(a.in[I_CONVW] + jj * CCH + 2 * cp);
    const f32x2 bias = *(const f32x2*)(a.in[I_CONVB] + 2 * cp);
    const f32x4 g0 = *(const f32x4*)(a.in[I_CLNG] + 8 * lane), g1 = *(const f32x4*)(a.in[I_CLNG] + 8 * lane + 4), b0 = *(const f32x4*)(a.in[I_CLNB] + 8 * lane), b1 = *(const f32x4*)(a.in[I_CLNB] + 8 * lane + 4);
    v4u tv[8];
#define CONV_LOAD(n_) do { const int b_ = (n_) >> 6, t0_ = ((n_) & 63) * 32; _Pragma("unroll") for (int i = 0; i < 8; ++i) { const int c = tid + 512 * i, r = c >> 6, ch = c & 63, t = t0_ - 30 + r; tv[i] = (v4u){0u, 0u, 0u, 0u}; \
        if (c < 62 * 64 && t >= 0) tv[i] = *(const v4u*)(U + ((size_t)b_ * SEQ + t) * CCH + ch * 8); } } while (0)
    int n = F.vcu;
    if (n < NBATCH * 64) CONV_LOAD(n);
    while (n < NBATCH * 64) {
        const int b = n >> 6, t0 = (n & 63) * 32;
#pragma unroll
        for (int i = 0; i < 8; ++i) { const int c = tid + 512 * i; if (c < 62 * 64) *(LAS v4u*)(ub + (c >> 6) * 1024 + (c & 63) * 16) = tv[i]; }
        const int nn = n + F.G;
        if (nn < NBATCH * 64) CONV_LOAD(nn);
        __syncthreads();
        {
            const int tb0 = th * 16;
            f32x2 acc[16];
#pragma unroll
            for (int tt = 0; tt < 16; ++tt) acc[tt] = bias;
#pragma unroll
            for (int i = 0; i < 46; ++i) { const unsigned uw = *(const LAS unsigned*)(ub + (tb0 + i) * 1024 + cp * 4); const f32x2 uv = {bflo(uw), bfhi(uw)};
#pragma unroll
                for (int tt = 0; tt < 16; ++tt) { const int jj = i - tt; if (jj >= 0 && jj < 31) acc[tt] += wt[jj] * uv; }
                }
#pragma unroll
            for (int tt = 0; tt < 16; ++tt) *(LAS f32x2*)(cb + (tb0 + tt) * CCH + 2 * cp) = acc[tt];
        }
        __syncthreads();
#pragma unroll
        for (int k = 0; k < 4; ++k) { const int tt = w * 4 + k; f32x4 v0 = *(const LAS f32x4*)(cb + tt * CCH + 8 * lane), v1 = *(const LAS f32x4*)(cb + tt * CCH + 8 * lane + 4);
            const float mean = wave_sum((v0[0] + v0[1]) + (v0[2] + v0[3]) + (v1[0] + v1[1]) + (v1[2] + v1[3])) * (1.0f / CCH);
            v0 = v0 - mean; v1 = v1 - mean;
            const float var = wave_sum((v0[0] * v0[0] + v0[1] * v0[1]) + (v0[2] * v0[2] + v0[3] * v0[3]) + (v1[0] * v1[0] + v1[1] * v1[1]) + (v1[2] * v1[2] + v1[3] * v1[3])) * (1.0f / CCH);
            const float rstd = 1.0f / sqrtf(var + LN_EPS);
            f32x4 y0 = v0 * rstd * g0 + b0, y1 = v1 * rstd * g1 + b1;
#pragma unroll
            for (int e = 0; e < 4; ++e) { y0[e] = y0[e] / (1.0f + __expf(-y0[e])); y1[e] = y1[e] / (1.0f + __expf(-y1[e])); }
            v4u o; o.x = pk2(y0[0], y0[1]); o.y = pk2(y0[2], y0[3]); o.z = pk2(y1[0], y1[1]); o.w = pk2(y1[2], y1[3]);
            *(v4u*)(AC + ((size_t)b * SEQ + t0 + tt) * DM + CCH + 8 * lane) = o; }
        __syncthreads();
        n = nn;
    }
#undef CONV_LOAD
}
__device__ __forceinline__ void srow_wave(Frame& F, const Args& a, int b) {
    bf16* __restrict__ AC = (bf16*)(a.ws + WS_AC); bf16* __restrict__ Q = (bf16*)(a.ws + WS_Q); const float* __restrict__ z = (const float*)(a.ws + WS_ZS) + (size_t)b * NIN; const float* __restrict__ rope = (const float*)(a.ws + WS_ROPE) + 2048 * 32;
    float* __restrict__ out = a.out;
    const int lane = F.lane, rl = lane & 15; const size_t qrow = (size_t)MP + b;
    float qn[8], x1[8], x2[8];
#pragma unroll
    for (int h = 0; h < 8; ++h) { qn[h] = z[h * 96 + lane]; x1[h] = z[h * 96 + 64 + rl]; x2[h] = z[h * 96 + 80 + rl]; }
    const float cs = rope[rl], sn = rope[16 + rl], k1 = z[2048 + rl], k2 = z[2064 + rl];
    const f32x4 c = *(const f32x4*)(z + 768 + 4 * lane), kg = *(const f32x4*)(a.in[I_KVG] + 4 * lane);
    const int c0 = 8 * lane, zb = 1024 + 256 * (c0 >> 7) + (c0 & 127);
    const f32x4 ga0 = *(const f32x4*)(z + zb), ga1 = *(const f32x4*)(z + zb + 4), gg0 = *(const f32x4*)(z + zb + 128), gg1 = *(const f32x4*)(z + zb + 132);
#pragma unroll
    for (int h = 0; h < 8; ++h) { Q[qrow * QC + h * 96 + lane] = (bf16)(pk2(qn[h] * QS_MLA, 0.f) & 0xffffu);
        if (lane < 16) { Q[qrow * QC + h * 96 + 64 + lane] = (bf16)(pk2((x1[h] * cs - x2[h] * sn) * QS_MLA, 0.f) & 0xffffu); Q[qrow * QC + h * 96 + 80 + lane] = (bf16)(pk2((x2[h] * cs + x1[h] * sn) * QS_MLA, 0.f) & 0xffffu); } }
    { const float ss = wave_sum((c[0] * c[0] + c[1] * c[1]) + (c[2] * c[2] + c[3] * c[3]));
      const float rs = 1.0f / sqrtf(ss * (1.0f / 256.0f) + LN_EPS); *(f32x4*)(out + O_CKVS + (size_t)b * KVL + 4 * lane) = c * rs * kg; }
    if (lane < 16) { out[O_KRS + (size_t)b * RD + lane] = k1 * cs - k2 * sn; out[O_KRS + (size_t)b * RD + 16 + lane] = k2 * cs + k1 * sn; }
    f32x4 u0, u1;
#pragma unroll
    for (int e = 0; e < 4; ++e) { u0[e] = ga0[e] / (1.0f + __expf(-gg0[e])); u1[e] = ga1[e] / (1.0f + __expf(-gg1[e])); }
    const float* __restrict__ st = a.in[I_SCONV] + (size_t)b * 30 * CCH + c0; const float* __restrict__ cw = a.in[I_CONVW] + c0; float* __restrict__ os = out + O_CONVS + (size_t)b * 30 * CCH + c0;
    *(f32x4*)(os + 29 * CCH) = u0; *(f32x4*)(os + 29 * CCH + 4) = u1;
    f32x4 a0 = *(const f32x4*)(a.in[I_CONVB] + c0), a1 = *(const f32x4*)(a.in[I_CONVB] + c0 + 4);
#pragma unroll 10
    for (int jj = 0; jj < 30; ++jj) { const f32x4 s0 = *(const f32x4*)(st + jj * CCH), s1 = *(const f32x4*)(st + jj * CCH + 4);
        a0 += s0 * *(const f32x4*)(cw + jj * CCH); a1 += s1 * *(const f32x4*)(cw + jj * CCH + 4); }
#pragma unroll 10
    for (int jj = 1; jj < 30; ++jj) { *(f32x4*)(os + (jj - 1) * CCH) = *(const f32x4*)(st + jj * CCH); *(f32x4*)(os + (jj - 1) * CCH + 4) = *(const f32x4*)(st + jj * CCH + 4); }
    a0 += u0 * *(const f32x4*)(cw + 30 * CCH); a1 += u1 * *(const f32x4*)(cw + 30 * CCH + 4);
    const float mean = wave_sum((a0[0] + a0[1]) + (a0[2] + a0[3]) + (a1[0] + a1[1]) + (a1[2] + a1[3])) * (1.0f / CCH);
    a0 = a0 - mean; a1 = a1 - mean;
    const float var = wave_sum((a0[0] * a0[0] + a0[1] * a0[1]) + (a0[2] * a0[2] + a0[3] * a0[3]) + (a1[0] * a1[0] + a1[1] * a1[1]) + (a1[2] * a1[2] + a1[3] * a1[3])) * (1.0f / CCH);
    const float rstd = 1.0f / sqrtf(var + LN_EPS);
    f32x4 y0 = a0 * rstd * *(const f32x4*)(a.in[I_CLNG] + c0) + *(const f32x4*)(a.in[I_CLNB] + c0), y1 = a1 * rstd * *(const f32x4*)(a.in[I_CLNG] + c0 + 4) + *(const f32x4*)(a.in[I_CLNB] + c0 + 4);
#pragma unroll
    for (int e = 0; e < 4; ++e) { y0[e] = y0[e] / (1.0f + __expf(-y0[e])); y1[e] = y1[e] / (1.0f + __expf(-y1[e])); }
    v4u o; o.x = pk2(y0[0], y0[1]); o.y = pk2(y0[2], y0[3]); o.z = pk2(y1[0], y1[1]); o.w = pk2(y1[2], y1[3]);
    *(v4u*)(AC + qrow * DM + CCH + c0) = o;
}

__device__ __forceinline__ void qlat_wave(Frame& F, const Args& a, int unit) {
    const float* __restrict__ z = (const float*)(a.ws + WS_ZS); const float* __restrict__ wuk = a.in[I_WUK]; float* __restrict__ QLAT = (float*)(a.ws + WS_QLAT);
    const int lane = F.lane, r16 = lane & 15, g = lane >> 4, h = unit >> 4, l0 = (unit & 15) * 16;
    f32x4 af[8][2][2], bf_[2][2];
#pragma unroll
    for (int ks = 0; ks < 2; ++ks) { const float* wp = wuk + ((size_t)(l0 + r16) * 8 + h) * 64 + 32 * ks + 8 * g; bf_[ks][0] = *(const f32x4*)wp; bf_[ks][1] = *(const f32x4*)(wp + 4);
#pragma unroll
        for (int mt = 0; mt < 8; ++mt) { const float* zp = z + (size_t)(16 * mt + r16) * NIN + h * 96 + 32 * ks + 8 * g; af[mt][ks][0] = *(const f32x4*)zp; af[mt][ks][1] = *(const f32x4*)(zp + 4); } }
    f32x4 acc[8];
#pragma unroll
    for (int mt = 0; mt < 8; ++mt) acc[mt] = (f32x4){0.f, 0.f, 0.f, 0.f};
#pragma unroll
    for (int ks = 0; ks < 2; ++ks) { v4u bw; bw.x = pk2(bf_[ks][0][0], bf_[ks][0][1]); bw.y = pk2(bf_[ks][0][2], bf_[ks][0][3]); bw.z = pk2(bf_[ks][1][0], bf_[ks][1][1]); bw.w = pk2(bf_[ks][1][2], bf_[ks][1][3]);
        const bf16x8 bfr = __builtin_bit_cast(bf16x8, bw);
#pragma unroll
        for (int mt = 0; mt < 8; ++mt) { const f32x4 a0 = af[mt][ks][0] * QS_MLA, a1 = af[mt][ks][1] * QS_MLA; v4u aw; aw.x = pk2(a0[0], a0[1]); aw.y = pk2(a0[2], a0[3]); aw.z = pk2(a1[0], a1[1]); aw.w = pk2(a1[2], a1[3]);
            acc[mt] = __builtin_amdgcn_mfma_f32_16x16x32_bf16(__builtin_bit_cast(bf16x8, aw), bfr, acc[mt], 0, 0, 0); } }
#pragma unroll
    for (int mt = 0; mt < 8; ++mt)
#pragma unroll
        for (int r = 0; r < 4; ++r) QLAT[((size_t)(16 * mt + 4 * g + r) * 8 + h) * 256 + l0 + r16] = acc[mt][r];
}

__device__ __forceinline__ f32x4 skinny_tile(Frame& F, const bf16* A, int lda, const bf16* Bt, int K, int n0) {
    const int lane = F.lane, w = F.wave, r16 = lane & 15, g = lane >> 4, kw = K >> 3;
    f32x4 acc[8];
#pragma unroll
    for (int mt = 0; mt < 8; ++mt) acc[mt] = (f32x4){0.f, 0.f, 0.f, 0.f};
    const bf16* ap = A + (size_t)r16 * lda + w * kw + 8 * g; const bf16* bp = Bt + (size_t)(n0 + r16) * K + w * kw + 8 * g;
#pragma unroll 1
    for (int kb = 0; kb < kw; kb += 128) {
        bf16x8 bf[4], af[4][8];
#pragma unroll
        for (int ks = 0; ks < 4; ++ks) { bf[ks] = *(const bf16x8*)(bp + kb + 32 * ks);
#pragma unroll
            for (int mt = 0; mt < 8; ++mt) af[ks][mt] = *(const bf16x8*)(ap + (size_t)(16 * mt) * lda + kb + 32 * ks); }
        __builtin_amdgcn_sched_barrier(0);
#pragma unroll
        for (int ks = 0; ks < 4; ++ks)
#pragma unroll
            for (int mt = 0; mt < 8; ++mt) acc[mt] = __builtin_amdgcn_mfma_f32_16x16x32_bf16(af[ks][mt], bf[ks], acc[mt], 0, 0, 0);
    }
    LAS float* red = (LAS float*)F.lds;
#pragma unroll
    for (int mt = 0; mt < 8; ++mt) *(LAS f32x4*)(red + (w * 16 + r16) * 128 + 16 * mt + 4 * g) = acc[mt];
    __syncthreads();
    const int row = F.tid >> 2, c4 = (F.tid & 3) * 4; f32x4 v = (f32x4){0.f, 0.f, 0.f, 0.f};
#pragma unroll
    for (int k = 0; k < 8; ++k)
#pragma unroll
        for (int j = 0; j < 4; ++j) v[j] += red[(k * 16 + c4 + j) * 128 + row];
    return v;
}
__device__ __forceinline__ void sample_stats(Frame& F, const float* sslot) {
    const int row = F.tid >> 2, part = F.tid & 3; float s1 = 0.f, s2 = 0.f;
#pragma unroll
    for (int i = 0; i < 16; ++i) { const f32x2 p = *(const f32x2*)(sslot + ((size_t)row * 64 + part * 16 + i) * 2); s1 += p[0]; s2 += p[1]; }
    s1 += __shfl_xor(s1, 1); s1 += __shfl_xor(s1, 2); s2 += __shfl_xor(s2, 1); s2 += __shfl_xor(s2, 2);
    const float mean = s1 * (1.0f / DM), var = s2 * (1.0f / DM) - mean * mean;
    if (part == 0) *(LAS f32x2*)(F.lds + 65536 + row * 8) = (f32x2){mean, 1.0f / sqrtf(var + LN_EPS)};
}
__device__ __forceinline__ void slice_stats_store(Frame& F, float* sslot, int unit, f32x4 v) {
    float s1 = (v[0] + v[1]) + (v[2] + v[3]), s2 = (v[0] * v[0] + v[1] * v[1]) + (v[2] * v[2] + v[3] * v[3]);
    s1 += __shfl_xor(s1, 1); s1 += __shfl_xor(s1, 2); s2 += __shfl_xor(s2, 1); s2 += __shfl_xor(s2, 2);
    if ((F.tid & 3) == 0) st_wt8(sslot + ((size_t)(F.tid >> 2) * 64 + unit) * 2, __builtin_bit_cast(unsigned, s1), __builtin_bit_cast(unsigned, s2));
}
template <int WHICH> __device__ __forceinline__ void sample_gemm(Frame& F, const Args& a) {
    unsigned char* ws = a.ws; const float* vec = (const float*)(ws + WS_VEC);
    constexpr int NU = WHICH == 1 ? INC / 16 : (WHICH == 9 ? FF / 16 : DM / 16);
    constexpr bool DYN = true;
    constexpr int PREV = WHICH == 6 ? 5 : (WHICH == 9 ? 8 : (WHICH == 10 ? 9 : -1)), NUPREV = WHICH == 10 ? FF / 16 : DM / 16;
    LAS unsigned* lw = (LAS unsigned*)(F.lds + 67584);
    __syncthreads();
    const bool released = F.G >= 32 && (unsigned)__builtin_amdgcn_readfirstlane((int)F.MISC[10]) == 0xffffffffu;
    const int keep = NU - (F.G - 16);
    if (released) return;
    bool first = true; int u0 = -1;
    for (int u = F.vcu;; u += F.G) {
        if (DYN) {
            if (F.wave == 0) { unsigned gv = 0u;
                if (F.lane == 0) gv = __hip_atomic_fetch_add(F.ctl + CW_SKG + 64 * WHICH, 1u, RLX_AGENT);
                gv = (unsigned)__builtin_amdgcn_readfirstlane((int)gv); if (F.lane == 0) lw[0] = gv; }
            __syncthreads(); u = __builtin_amdgcn_readfirstlane((int)lw[0]); __syncthreads(); }
        if (u >= NU) break;
        if (DYN && first && PREV >= 0) wait_count(F, F.ctl + CW_SKD + 64 * (PREV >= 0 ? PREV : 0), (unsigned)NUPREV);
        first = false;
        const int n0 = 16 * u, row = F.tid >> 2, col = n0 + (F.tid & 3) * 4; const size_t ro = (size_t)(MP + row) * DM + col;
        if (WHICH == 1) { const f32x4 v = skinny_tile(F, (const bf16*)(ws + WS_XB) + (size_t)MP * DM, DM, (const bf16*)(ws + WS_WIN), DM, n0); st_wt16((float*)(ws + WS_ZS) + (size_t)row * NIN + col, v); }
        if (WHICH == 5) { const f32x4 xs = *(const f32x4*)(a.in[I_XS] + (size_t)row * DM + col);
            f32x4 v = skinny_tile(F, (const bf16*)(ws + WS_AC) + (size_t)MP * DM, DM, (const bf16*)(ws + WS_WO), DM, n0);
            v += ALPHA * xs;
            st_bf4_wt((bf16*)(ws + WS_X1B) + ro, v); slice_stats_store(F, (float*)(ws + WS_SSL1), u, v); }
        if (WHICH == 6) { sample_stats(F, (const float*)(ws + WS_SSL1)); const f32x4 cs = *(const f32x4*)(vec + VO_CSQ + col), bw = *(const f32x4*)(vec + VO_BWQ + col);
            f32x4 v = skinny_tile(F, (const bf16*)(ws + WS_X1B) + (size_t)MP * DM, DM, (const bf16*)(ws + WS_WXQ), DM, n0);
            const f32x2 st = *(const LAS f32x2*)(F.lds + 65536 + row * 8);
            v = ((v - st[0] * cs) * st[1] + bw) * QS_MEM; st_bf4_wt((bf16*)(ws + WS_QX) + ro, v); }
        if (WHICH == 8) { sample_stats(F, (const float*)(ws + WS_SSL1)); const v2u pw = *(const v2u*)((const bf16*)(ws + WS_X1B) + ro); const f32x4 g1 = *(const f32x4*)(a.in[I_LN1G] + col), b1 = *(const f32x4*)(a.in[I_LN1B] + col);
            f32x4 v = skinny_tile(F, (const bf16*)(ws + WS_OX) + (size_t)MP * DM, DM, (const bf16*)(ws + WS_WXO), DM, n0);
            const f32x2 st = *(const LAS f32x2*)(F.lds + 65536 + row * 8);
            const f32x4 pv = (f32x4){bflo(pw.x), bfhi(pw.x), bflo(pw.y), bfhi(pw.y)};
            const f32x4 x1 = (pv - st[0]) * st[1] * g1 + b1;
            v += ALPHA * x1; st_bf4_wt((bf16*)(ws + WS_X2B) + ro, v); slice_stats_store(F, (float*)(ws + WS_SSL2), u, v); }
        if (WHICH == 9) { sample_stats(F, (const float*)(ws + WS_SSL2)); const f32x4 cs = *(const f32x4*)(vec + VO_CSU + col), bw = *(const f32x4*)(vec + VO_BWU + col);
            f32x4 v = skinny_tile(F, (const bf16*)(ws + WS_X2B) + (size_t)MP * DM, DM, (const bf16*)(ws + WS_WUP), DM, n0);
            const f32x2 st = *(const LAS f32x2*)(F.lds + 65536 + row * 8);
            v = (v - st[0] * cs) * st[1] + bw;
#pragma unroll
            for (int j = 0; j < 4; ++j) { const float t = fmaxf(v[j], 0.f); v[j] = t * t; }
            st_bf4_wt((bf16*)(ws + WS_H) + (size_t)(MP + row) * FF + col, v); }
        if (WHICH == 10) { sample_stats(F, (const float*)(ws + WS_SSL2)); const v2u pw = *(const v2u*)((const bf16*)(ws + WS_X2B) + ro); const f32x4 g2 = *(const f32x4*)(a.in[I_LN2G] + col), b2 = *(const f32x4*)(a.in[I_LN2B] + col);
            f32x4 v = skinny_tile(F, (const bf16*)(ws + WS_H) + (size_t)MP * FF, FF, (const bf16*)(ws + WS_WDN), FF, n0);
            const f32x2 st = *(const LAS f32x2*)(F.lds + 65536 + row * 8);
            const f32x4 pv = (f32x4){bflo(pw.x), bfhi(pw.x), bflo(pw.y), bfhi(pw.y)};
            const f32x4 x2 = (pv - st[0]) * st[1] * g2 + b2;
            v += ALPHA * x2; st_bf4_wt((bf16*)(ws + WS_OX) + ro, v); }
        if (DYN) { asm volatile("s_waitcnt vmcnt(0)" ::: "memory"); }
        __syncthreads();
        if (DYN && F.wave == 0) { if (F.lane == 0) __hip_atomic_fetch_add(F.ctl + CW_SKD + 64 * WHICH, 1u, RLX_AGENT); }
        if (u0 < 0) u0 = u;
        if (u0 >= keep) break;
    }
}

constexpr int N_PHASES = 11;
#ifndef REP_P0
#define REP_P0 1
#endif
#ifndef REP_CONV
#define REP_CONV 1
#endif
#ifndef REP_SK
#define REP_SK 1
#endif
#ifndef REP_LN
#define REP_LN 1
#endif
#define REPEAT_1(...) __VA_ARGS__
#define REPEAT_2(...) __VA_ARGS__ __VA_ARGS__
#define REPEAT_X(n, ...) REPEAT_##n(__VA_ARGS__)
#define REPEAT(n, ...) REPEAT_X(n, __VA_ARGS__)
#ifndef REP_G1
#define REP_G1 1
#endif
#ifndef REP_G2
#define REP_G2 1
#endif
#ifndef REP_G4
#define REP_G4 1
#endif
#ifndef REP_G5
#define REP_G5 1
#endif
#ifndef REP_G7
#define REP_G7 1
#endif
#ifndef REP_G8
#define REP_G8 1
#endif
#ifndef REP_G9
#define REP_G9 1
#endif

#ifndef REP_DEC
#define REP_DEC 1
#endif
#ifndef REP_MLA
#define REP_MLA 1
#endif
#ifndef REP_CR
#define REP_CR 1
#endif
#ifndef REP_SCR
#define REP_SCR 1
#endif
#if defined(PROBE_PH)
#define STAMP(i) do { if (blockIdx.x == 0 && F.tid == 0) F.MISC[16 + (i)] = (unsigned)__builtin_amdgcn_s_memrealtime(); } while (0)
#ifndef PROBE_A
#define PROBE_A (16 + PROBE_PH)
#endif
#ifndef PROBE_B
#define PROBE_B (17 + PROBE_PH)
#endif
#define GSTAMP(k) do { if (PROBE_PH == (k) && blockIdx.x == 0 && F.tid == 0) F.MISC[11] = (unsigned)__builtin_amdgcn_s_memrealtime(); } while (0)
#else
#define STAMP(i) do { } while (0)
#define GSTAMP(k) do { } while (0)
#endif
__global__ void __launch_bounds__(NWAVES * 64, 2) fwd_kernel(Args args) {
    extern __shared__ __attribute__((aligned(16))) unsigned char lds[];
    Frame F;
    F.lds = (LAS unsigned char*)lds;
    F.MISC = (volatile LAS unsigned*)(F.lds + MISC_OFF);
    F.tid = threadIdx.x; F.lane = F.tid & 63; F.wave = __builtin_amdgcn_readfirstlane(F.tid >> 6);
    F.G = gridDim.x; { const int bx = blockIdx.x; F.vcu = (F.G % 8 == 0) ? (bx % 8) * (F.G / 8) + bx / 8 : bx; }
    unsigned char* ws = args.ws;
    F.ctl = (gu32*)(ws + WS_CTL);
    if (F.tid < 32) F.MISC[F.tid] = 0u;
    __syncthreads();
    XcdBarrier bar = xcd_barrier_post((unsigned*)(F.ctl + CW_BAR), F.MISC + 8);
    STAMP(0);
    const int lo = args.ph_lo, hi = args.ph_hi;
#ifndef PHMASK
#define PHMASK 0x7ff
#endif
#define IN(k) (((PHMASK >> (k)) & 1) && lo <= (k) && (k) < hi)
#define SEAM(k) do { if (IN(k) && IN((k) + 1)) xcd_barrier(bar); STAMP((k) + 1); asm volatile("" : "+v"(F.tid)); F.lane = F.tid & 63; } while (0)
    typedef pg8::bf16_t pb;

    if (IN(0)) { REPEAT(REP_P0, p0_prologue(F, args);) }
    SEAM(0);
    if (IN(1)) {
        pg8::Gemm g{(const pb*)(ws + WS_XB), (const pb*)(ws + WS_WIN), MT + MMEM, NIN + 2048, DM}; InOrder S; S.init(F.G, (int)blockIdx.x);
        EpiIn E{(bf16*)(ws + WS_Q), (bf16*)(ws + WS_CKV), (bf16*)(ws + WS_KR), (bf16*)(ws + WS_U), (bf16*)(ws + WS_MKB), (bf16*)(ws + WS_MVB), args.out, (const float*)(ws + WS_ROPE), args.in[I_KVG], (LAS float*)(F.lds + XL_OFF)};
        REPEAT(REP_G1, pg8::gemm_phase<EpiIn, InOrder, true, true>(F.lds + RING_OFF, g, S, E);)
        GSTAMP(1);
        xcd_arrive(bar);
        { float* vec = (float*)(ws + WS_VEC);
          for (int i = F.vcu * 512 + F.tid; i < 2 * 1024 + 2 * 4096; i += F.G * 512) {
              const float* p; int n, ld; float* o;
              if (i < 1024) { p = vec + VO_PCSQ; n = i; ld = 1024; o = vec + VO_CSQ; } else if (i < 2048) { p = vec + VO_PBWQ; n = i - 1024; ld = 1024; o = vec + VO_BWQ; }
              else if (i < 6144) { p = vec + VO_PCSU; n = i - 2048; ld = 4096; o = vec + VO_CSU; } else { p = vec + VO_PBWU; n = i - 6144; ld = 4096; o = vec + VO_BWU; }
              float sacc = 0.f;
#pragma unroll
              for (int k = 0; k < 16; ++k) sacc += p[k * ld + n];
              o[n] = sacc; } }
        sample_gemm<1>(F, args);
        xcd_wait(bar); STAMP(2); asm volatile("" : "+v"(F.tid)); F.lane = F.tid & 63;
    }
    if (IN(2)) {
        int kk_ = KVL; asm volatile("" : "+s"(kk_));
        pg8::Gemm g{(const pb*)(ws + WS_CKV), (const pb*)(ws + WS_WUKV), MP, 1024, kk_}; pg8::StaticOrder S; S.init(MP, 1024, F.G, (int)blockIdx.x);
        EpiB<0> E{(bf16*)(ws + WS_KN), 512, 512, (size_t)(WS_VV - WS_KN) / 2, 1.0f};
        REPEAT(REP_G2, pg8::gemm_phase<EpiB<0>, pg8::StaticOrder, true, true>(F.lds + RING_OFF, g, S, E);)
        GSTAMP(2);
        __syncthreads();
        REPEAT(REP_CONV, conv_phase(F, args);)
        xcd_arrive(bar);
        if (F.vcu < NS) wait_count(F, F.ctl + CW_SKD + 64 * 1, INC / 16);
        for (int n = F.vcu + F.G * F.wave; n < NS; n += F.G * NWAVES) srow_wave(F, args, n);
        if (F.wave == 1) for (int n = F.vcu; n < 128; n += F.G) qlat_wave(F, args, n);
        if (F.vcu < NS) {
            asm volatile("s_waitcnt vmcnt(0)" ::: "memory"); __syncthreads();
            if (F.wave == 0) { if (F.lane == 0) { __builtin_amdgcn_fence(__ATOMIC_RELEASE, "agent"); asm volatile("s_waitcnt vmcnt(0)" ::: "memory"); __hip_atomic_fetch_add(F.ctl + CW_SRW, 1u, RLX_AGENT); } } }
        xcd_wait(bar); STAMP(3); asm volatile("" : "+v"(F.tid)); F.lane = F.tid & 63;
    }
    if (IN(3)) {
        for (int rep_ = 0; rep_ < REP_MLA; ++rep_) p3_phase(F, args);
    }
    SEAM(3);
    if (IN(4)) {
        pg8::Gemm g{(const pb*)(ws + WS_AC), (const pb*)(ws + WS_WO), MP, DM, DM}; pg8::StaticOrder S; S.init(MP, DM, F.G, (int)blockIdx.x);
        EpiV<0, 2> E{(bf16*)(ws + WS_X1B), (float*)(ws + WS_SL1), (const bf16*)(ws + WS_XB), nullptr, nullptr, nullptr, (LAS float*)(F.lds + XL_OFF)};
        REPEAT(REP_G4, pg8::gemm_phase<EpiV<0, 2>, pg8::StaticOrder, true, true>(F.lds + RING_OFF, g, S, E);)
        GSTAMP(4);
        xcd_arrive(bar);
        sample_gemm<5>(F, args);
        xcd_wait(bar); STAMP(5); asm volatile("" : "+v"(F.tid)); F.lane = F.tid & 63;
    }
    if (IN(5)) {
        pg8::Gemm g{(const pb*)(ws + WS_X1B), (const pb*)(ws + WS_WXQ), MP, DM, DM}; pg8::StaticOrder S; S.init(MP, DM, F.G, (int)blockIdx.x);
        EpiFold<0> E{(bf16*)(ws + WS_QX), DM, (const float*)(ws + WS_SL1), (const float*)(ws + WS_VEC) + VO_CSQ, (const float*)(ws + WS_VEC) + VO_BWQ, QS_MEM};
        REPEAT(REP_G5, pg8::gemm_phase<EpiFold<0>, pg8::StaticOrder, true, true>(F.lds + RING_OFF, g, S, E);)
        GSTAMP(5);
        xcd_arrive(bar);
        sample_gemm<6>(F, args);
        xcd_wait(bar); STAMP(6); asm volatile("" : "+v"(F.tid)); F.lane = F.tid & 63;
    }
    if (IN(6)) {
        for (int rep_ = 0; rep_ < REP_CR; ++rep_) for (int n = F.vcu; n < NBATCH * 4 * 8; n += F.G) cross_unit32(F, args, n >> 3, n & 7);
        wait_count(F, F.ctl + CW_SKD + 64 * 6, DM / 16);
        for (int rep_ = 0; rep_ < REP_SCR; ++rep_) for (int n = F.vcu; n < NS * 2; n += F.G) scross_unit(F, args, n >> 1, n & 1);
    }
    SEAM(6);
    if (IN(7)) {
        pg8::Gemm g{(const pb*)(ws + WS_OX), (const pb*)(ws + WS_WXO), MP, DM, DM}; pg8::StaticOrder S; S.init(MP, DM, F.G, (int)blockIdx.x);
        EpiV<1, 1> E{(bf16*)(ws + WS_X2B), (float*)(ws + WS_SL2), (const bf16*)(ws + WS_X1B), (const float*)(ws + WS_SL1), args.in[I_LN1G], args.in[I_LN1B], (LAS float*)(F.lds + XL_OFF)};
        REPEAT(REP_G7, pg8::gemm_phase<EpiV<1, 1>, pg8::StaticOrder, true, true>(F.lds + RING_OFF, g, S, E);)
        GSTAMP(7);
        xcd_arrive(bar);
        sample_gemm<8>(F, args);
        xcd_wait(bar); STAMP(8); asm volatile("" : "+v"(F.tid)); F.lane = F.tid & 63;
    }
    if (IN(8)) {
        pg8::Gemm g{(const pb*)(ws + WS_X2B), (const pb*)(ws + WS_WUP), MP, FF, DM}; pg8::StaticOrder S; S.init(MP, FF, F.G, (int)blockIdx.x);
        EpiFold<1> E{(bf16*)(ws + WS_H), FF, (const float*)(ws + WS_SL2), (const float*)(ws + WS_VEC) + VO_CSU, (const float*)(ws + WS_VEC) + VO_BWU, 1.0f};
        REPEAT(REP_G8, pg8::gemm_phase<EpiFold<1>, pg8::StaticOrder, true, true>(F.lds + RING_OFF, g, S, E);)
        GSTAMP(8);
        xcd_arrive(bar);
        sample_gemm<9>(F, args);
        xcd_wait(bar); STAMP(9); asm volatile("" : "+v"(F.tid)); F.lane = F.tid & 63;
    }
    if (IN(9)) {
        pg8::Gemm g{(const pb*)(ws + WS_H), (const pb*)(ws + WS_WDN), MP, DM, FF}; pg8::StaticOrder S; S.init(MP, DM, F.G, (int)blockIdx.x);
        EpiV<1, 2> E{(bf16*)(ws + WS_OX), nullptr, (const bf16*)(ws + WS_X2B), (const float*)(ws + WS_SL2), args.in[I_LN2G], args.in[I_LN2B], (LAS float*)(F.lds + XL_OFF)};
        REPEAT(REP_G9, pg8::gemm_phase<EpiV<1, 2>, pg8::StaticOrder, true, true>(F.lds + RING_OFF, g, S, E);)
        GSTAMP(9);
        xcd_arrive(bar);
        sample_gemm<10>(F, args);
        xcd_wait(bar); STAMP(10); asm volatile("" : "+v"(F.tid)); F.lane = F.tid & 63;
    }
    if (IN(10)) {
        REPEAT(REP_LN, ln_final(F, (const bf16*)(ws + WS_OX), args.in[I_LN3G], args.in[I_LN3B], args.out, 0, MREAL, F.ctl + CW_SKD + 64 * 10, DM / 16);)
    }
#if defined(PROBE_PH)
    __syncthreads(); STAMP(11); __syncthreads();
    if (blockIdx.x == 0) { const unsigned dt = F.MISC[PROBE_B] - F.MISC[PROBE_A];
        const float sc = 1.0f + sqrtf((float)dt * 1e-5f);
        for (int i = F.tid; i < NS * RD; i += NWAVES * 64) args.out[O_KRS + i] *= sc; }
#endif
#undef IN
#undef SEAM
}

#ifndef MK_PER_PHASE
#define MK_PER_PHASE 0
#endif
extern "C" void kernel_launch(void* const* d_in, const int* in_sizes, int n_in, void* d_out, int out_size, void* d_ws, size_t ws_size, hipStream_t stream) {
    static int grid = 0;
    if (grid == 0) {
        if (n_in != 30 || out_size != (int)O_END || ws_size < WS_END) { fprintf(stderr, "kernel_launch: unexpected problem (n_in %d, out %d, ws %zu); nothing launched\n", n_in, out_size, ws_size); grid = -1; return; }
        int dev = 0, cus = 0, per_cu = 0;
        if (hipGetDevice(&dev) != hipSuccess || hipDeviceGetAttribute(&cus, hipDeviceAttributeMultiprocessorCount, dev) != hipSuccess) { grid = -1; return; }
        if (hipFuncSetAttribute((const void*)fwd_kernel, hipFuncAttributeMaxDynamicSharedMemorySize, LDS_BYTES) != hipSuccess) { fprintf(stderr, "kernel_launch: hipFuncSetAttribute failed\n"); grid = -1; return; }
        if (hipOccupancyMaxActiveBlocksPerMultiprocessor(&per_cu, (const void*)fwd_kernel, NWAVES * 64, LDS_BYTES) != hipSuccess || per_cu < 1) { fprintf(stderr, "kernel_launch: occupancy query says %d\n", per_cu); }
        (void)hipGetLastError();
        grid = cus;
    }
    if (grid < 0) return;
    if (hipMemsetAsync((char*)d_ws + WS_CTL, 0, CTL_ZERO_BYTES, stream) != hipSuccess) return;
    Args a{};
    for (int i = 0; i < 30; ++i) a.in[i] = (const float*)d_in[i];
    a.out = (float*)d_out; a.ws = (unsigned char*)d_ws;
#if MK_PER_PHASE
    for (int p = 0; p < N_PHASES; ++p) { a.ph_lo = p; a.ph_hi = p + 1; hipLaunchKernelGGL(fwd_kernel, dim3(grid), dim3(NWAVES * 64), LDS_BYTES, stream, a); }
#else
    a.ph_lo = 0; a.ph_hi = N_PHASES;
    hipLaunchKernelGGL(fwd_kernel, dim3(grid), dim3(NWAVES * 64), LDS_BYTES, stream, a);
#endif
    (void)in_sizes;
}
```
